# Optimizing an MI355X kernel written in HIP

```python
import jax, jax.numpy as jnp
from jax import lax
import numpy as np

D_MODEL = 1024
BATCH = 1
SEQ = 16384
DEPTH = 2

ROPE_THETA = 500000.0
EPS = 1e-6
NEG = -1e30
Q_BLOCK = 128

GROUP_WIDTH = D_MODEL // 4
D_MIX = 4 * GROUP_WIDTH

MLA_HEADS = 4
MLA_NOPE = 64
MLA_ROPE = 32
MLA_QK = MLA_NOPE + MLA_ROPE
MLA_V = GROUP_WIDTH // MLA_HEADS
MLA_Q_RANK = 256
MLA_KV_RANK = 128

CONV_WIDTH = 3

SG_CHUNK = 128
SG_GROUPS = 4
SG_GDIM = GROUP_WIDTH // SG_GROUPS

MOBA_HEADS = 4
MOBA_HD = GROUP_WIDTH // MOBA_HEADS
MOBA_ROT = MOBA_HD // 4
MOBA_BLOCK = 256
MOBA_TOPK = 3

SPLIT_SIZES = (
    MLA_Q_RANK, MLA_KV_RANK, MLA_ROPE, GROUP_WIDTH,
    GROUP_WIDTH, GROUP_WIDTH, GROUP_WIDTH, GROUP_WIDTH,
    GROUP_WIDTH, GROUP_WIDTH, GROUP_WIDTH,
    GROUP_WIDTH, GROUP_WIDTH, GROUP_WIDTH, GROUP_WIDTH,
)
D_IN = 3488

kernel_name = "hybrid_parallel_mla_conv_sgmlp_moba"


def rmsnorm(x, g):
    xf = x.astype(jnp.float32)
    y = xf * lax.rsqrt(jnp.mean(xf * xf, axis=-1, keepdims=True) + EPS)
    return (y * g).astype(x.dtype)


def layernorm(x, g, b):
    xf = x.astype(jnp.float32)
    mu = jnp.mean(xf, axis=-1, keepdims=True)
    var = jnp.mean(jnp.square(xf - mu), axis=-1, keepdims=True)
    y = (xf - mu) * lax.rsqrt(var + EPS)
    return (y * g + b).astype(x.dtype)


def rope(x, pos):
    rd = x.shape[-1]
    half = rd // 2
    inv = jnp.power(ROPE_THETA, -jnp.arange(half, dtype=jnp.float32) * 2.0 / rd)
    ang = pos.astype(jnp.float32)[..., None] * inv
    cos = jnp.cos(ang)[:, :, None, :]
    sin = jnp.sin(ang)[:, :, None, :]
    xf = x.astype(jnp.float32)
    x1, x2 = xf[..., :half], xf[..., half:]
    return jnp.concatenate([x1 * cos - x2 * sin, x2 * cos + x1 * sin], axis=-1).astype(x.dtype)


def causal_attention_blocks(q, k, v, scale):
    B, S, H, D = q.shape
    nq = S // Q_BLOCK
    qb = q.reshape(B, nq, Q_BLOCK, H, D).swapaxes(0, 1)
    kpos = jnp.arange(S)

    def one(args):
        qblk, i = args
        s = jnp.einsum('bqhd,bkhd->bhqk', qblk, k, preferred_element_type=jnp.float32) * scale
        qpos = i * Q_BLOCK + jnp.arange(Q_BLOCK)
        s = jnp.where(kpos[None, :] <= qpos[:, None], s, NEG)
        p = jax.nn.softmax(s, axis=-1)
        return jnp.einsum('bhqk,bkhd->bqhd', p.astype(v.dtype), v)

    out = lax.map(one, (qb, jnp.arange(nq)))
    return out.swapaxes(0, 1).reshape(B, S, H, v.shape[-1])


def moba_attention(q, k, v, scale):
    B, S, H, D = q.shape
    nb = -(-S // MOBA_BLOCK)
    Sp = nb * MOBA_BLOCK
    kk = min(MOBA_TOPK, nb)
    pad = ((0, 0), (0, Sp - S), (0, 0), (0, 0))
    kb = jnp.pad(k, pad).reshape(B, nb, MOBA_BLOCK, H, D).transpose(0, 3, 1, 2, 4)
    vb = jnp.pad(v, pad).reshape(B, nb, MOBA_BLOCK, H, D).transpose(0, 3, 1, 2, 4)
    kmean = jnp.mean(kb.astype(jnp.float32), axis=3)
    gate = jnp.einsum('bshd,bhnd->bhsn', q.astype(jnp.float32), kmean)
    qblk = jnp.arange(S) // MOBA_BLOCK
    past = jnp.arange(nb)[None, :] < qblk[:, None]
    gate = jnp.where(past, gate, NEG)
    _, idx = lax.top_k(gate, kk)
    valid = jnp.arange(kk)[None, :] < qblk[:, None]

    nq = S // Q_BLOCK
    qc = q.reshape(B, nq, Q_BLOCK, H, D).transpose(1, 0, 3, 2, 4)
    idxc = idx.reshape(B, H, nq, Q_BLOCK, kk).transpose(2, 0, 1, 3, 4)
    validc = valid.reshape(nq, Q_BLOCK, kk)
    bi = jnp.arange(B)[:, None, None, None]
    hi = jnp.arange(H)[None, :, None, None]
    n_sel = kk * MOBA_BLOCK

    def one(args):
        qx, ix, vx, i = args
        kg = kb[bi, hi, ix]
        vg = vb[bi, hi, ix]
        s_sel = jnp.einsum('bhqd,bhqrkd->bhqrk', qx, kg, preferred_element_type=jnp.float32) * scale
        s_sel = jnp.where(vx[None, None, :, :, None], s_sel, NEG).reshape(B, H, Q_BLOCK, n_sel)
        qpos = i * Q_BLOCK + jnp.arange(Q_BLOCK)
        own = (i * Q_BLOCK) // MOBA_BLOCK
        ko = lax.dynamic_index_in_dim(kb, own, axis=2, keepdims=False)
        vo = lax.dynamic_index_in_dim(vb, own, axis=2, keepdims=False)
        s_own = jnp.einsum('bhqd,bhkd->bhqk', qx, ko, preferred_element_type=jnp.float32) * scale
        kpos = own * MOBA_BLOCK + jnp.arange(MOBA_BLOCK)
        s_own = jnp.where(kpos[None, :] <= qpos[:, None], s_own, NEG)
        p = jax.nn.softmax(jnp.concatenate([s_sel, s_own], axis=-1), axis=-1).astype(v.dtype)
        p_sel = p[..., :n_sel].reshape(B, H, Q_BLOCK, kk, MOBA_BLOCK)
        p_own = p[..., n_sel:]
        return (jnp.einsum('bhqrk,bhqrkd->bhqd', p_sel, vg)
                + jnp.einsum('bhqk,bhkd->bhqd', p_own, vo))

    out = lax.map(one, (qc, idxc, validc, jnp.arange(nq)))
    return out.transpose(1, 0, 3, 2, 4).reshape(B, S, H, D)


def short_conv(z, w):
    C = z.shape[-1]
    return lax.conv_general_dilated(
        z, w[:, None, :].astype(z.dtype), window_strides=(1,), padding=[(CONV_WIDTH - 1, 0)],
        dimension_numbers=('NWC', 'WIO', 'NWC'), feature_group_count=C)


def spatial_gate(u, v, ln_g, ln_b, w_s, b_s):
    B, S, C = v.shape
    nc = S // SG_CHUNK
    vn = layernorm(v, ln_g, ln_b).reshape(B, nc, SG_CHUNK, SG_GROUPS, SG_GDIM)
    mask = jnp.tril(jnp.ones((SG_CHUNK, SG_CHUNK), dtype=bool))
    ws = jnp.where(mask[None], w_s, jnp.zeros_like(w_s))
    mixed = jnp.einsum('gts,bcsgd->bctgd', ws, vn) + b_s.T[None, None, :, :, None]
    return u * mixed.reshape(B, S, C)


def hybrid_layer(x, positions, norm_g, w_in, mla_q_norm_g, mla_w_uq, mla_kv_norm_g, mla_w_ukv,
                 mla_q_g, mla_k_nope_g, mla_k_rope_g, conv_w, sg_ln_g, sg_ln_b, sg_w, sg_b,
                 moba_q_g, moba_k_g, w_out):
    B, S, _ = x.shape
    h = rmsnorm(x, norm_g)
    p = h @ w_in
    offs = np.cumsum(np.array(SPLIT_SIZES))[:-1].tolist()
    (cq, ckv, kr, g_a, c_h, c_b, c_c, g_b, sg_u, sg_v, g_c, mq, mk, mv, g_d) = jnp.split(p, offs, axis=-1)

    q = (rmsnorm(cq, mla_q_norm_g) @ mla_w_uq).reshape(B, S, MLA_HEADS, MLA_QK)
    kv = (rmsnorm(ckv, mla_kv_norm_g) @ mla_w_ukv).reshape(B, S, MLA_HEADS, MLA_NOPE + MLA_V)
    k_nope, v_a = kv[..., :MLA_NOPE], kv[..., MLA_NOPE:]
    q = rmsnorm(q, mla_q_g)
    q = jnp.concatenate([q[..., :MLA_NOPE], rope(q[..., MLA_NOPE:], positions)], axis=-1)
    k_nope = rmsnorm(k_nope, mla_k_nope_g)
    k_rope = rope(rmsnorm(kr, mla_k_rope_g)[:, :, None, :], positions)
    k = jnp.concatenate([k_nope, jnp.broadcast_to(k_rope, (B, S, MLA_HEADS, MLA_ROPE))], axis=-1)
    o_a = causal_attention_blocks(q, k, v_a, MLA_QK ** -0.5).reshape(B, S, GROUP_WIDTH)

    o_b = c_b * short_conv(c_c * c_h, conv_w)

    o_c = spatial_gate(sg_u, sg_v, sg_ln_g, sg_ln_b, sg_w, sg_b)

    qd = rmsnorm(mq.reshape(B, S, MOBA_HEADS, MOBA_HD), moba_q_g)
    kd = rmsnorm(mk.reshape(B, S, MOBA_HEADS, MOBA_HD), moba_k_g)
    vd = mv.reshape(B, S, MOBA_HEADS, MOBA_HD)
    qd = jnp.concatenate([rope(qd[..., :MOBA_ROT], positions), qd[..., MOBA_ROT:]], axis=-1)
    kd = jnp.concatenate([rope(kd[..., :MOBA_ROT], positions), kd[..., MOBA_ROT:]], axis=-1)
    o_d = moba_attention(qd, kd, vd, MOBA_HD ** -0.5).reshape(B, S, GROUP_WIDTH)

    y = jnp.concatenate([o_a * jax.nn.silu(g_a), o_b * jax.nn.silu(g_b),
                         o_c * jax.nn.silu(g_c), o_d * jax.nn.silu(g_d)], axis=-1)
    return y @ w_out


def setup_inputs(seed: int = 0) -> dict:
    key = jax.random.key(seed)
    ks = jax.random.split(key, 24)
    L, D, GW = DEPTH, D_MODEL, GROUP_WIDTH
    f32 = jnp.float32

    def nrm(k, shape, scale):
        return jax.random.normal(k, shape, f32) * scale

    def gain(k, shape):
        return 1.0 + 0.05 * jax.random.normal(k, shape, f32)

    x = jax.random.normal(ks[0], (BATCH, SEQ, D), f32)
    offset = jax.random.randint(ks[1], (BATCH, 1), 0, 4096, dtype=jnp.int32)
    positions = (offset + jnp.arange(SEQ, dtype=jnp.int32)[None, :]).astype(jnp.int32)
    return {
        "x": x,
        "positions": positions,
        "norm_g": gain(ks[2], (L, D)),
        "w_in": nrm(ks[3], (L, D, D_IN), D ** -0.5),
        "mla_q_norm_g": gain(ks[4], (L, MLA_Q_RANK)),
        "mla_w_uq": nrm(ks[5], (L, MLA_Q_RANK, MLA_HEADS * MLA_QK), MLA_Q_RANK ** -0.5),
        "mla_kv_norm_g": gain(ks[6], (L, MLA_KV_RANK)),
        "mla_w_ukv": nrm(ks[7], (L, MLA_KV_RANK, MLA_HEADS * (MLA_NOPE + MLA_V)), MLA_KV_RANK ** -0.5),
        "mla_q_g": gain(ks[8], (L, MLA_QK)),
        "mla_k_nope_g": gain(ks[9], (L, MLA_NOPE)),
        "mla_k_rope_g": gain(ks[10], (L, MLA_ROPE)),
        "conv_w": nrm(ks[11], (L, CONV_WIDTH, GW), CONV_WIDTH ** -0.5),
        "sg_ln_g": gain(ks[12], (L, GW)),
        "sg_ln_b": nrm(ks[13], (L, GW), 0.02),
        "sg_w": nrm(ks[14], (L, SG_GROUPS, SG_CHUNK, SG_CHUNK), SG_CHUNK ** -0.5),
        "sg_b": 1.0 + nrm(ks[15], (L, SG_GROUPS, SG_CHUNK), 0.1),
        "moba_q_g": gain(ks[16], (L, MOBA_HD)),
        "moba_k_g": gain(ks[17], (L, MOBA_HD)),
        "w_out": nrm(ks[18], (L, D_MIX, D), D_MIX ** -0.5),
    }


def reference(x, positions, norm_g, w_in, mla_q_norm_g, mla_w_uq, mla_kv_norm_g, mla_w_ukv,
              mla_q_g, mla_k_nope_g, mla_k_rope_g, conv_w, sg_ln_g, sg_ln_b, sg_w, sg_b,
              moba_q_g, moba_k_g, w_out):
    for l in range(DEPTH):
        x = x + hybrid_layer(x, positions, norm_g[l], w_in[l], mla_q_norm_g[l], mla_w_uq[l],
                             mla_kv_norm_g[l], mla_w_ukv[l], mla_q_g[l], mla_k_nope_g[l],
                             mla_k_rope_g[l], conv_w[l], sg_ln_g[l], sg_ln_b[l], sg_w[l], sg_b[l],
                             moba_q_g[l], moba_k_g[l], w_out[l])
    return x
```

```cpp
#include <hip/hip_runtime.h>
#include <hip/hip_cooperative_groups.h>
#include <stdint.h>
#include <cstdio>
namespace cg = cooperative_groups;

constexpr int S = 16384, DM = 1024, NP = 3584, DEPTH = 2, DIN = 3488;
constexpr int NT = 512;
constexpr float EPS = 1e-6f;
constexpr float LOG2E = 1.4426950408889634f;
constexpr int C_CQ = 0, C_CKV = 256, C_KR = 384, C_GA = 512, C_CH = 768, C_CB = 1024, C_CC = 1280, C_GB = 1536,
              C_SU = 1792, C_SV = 2048, C_GC = 2304, C_MQ = 2560, C_MK = 2816, C_MV = 3072, C_GD = 3328;

typedef unsigned short bf16_t;
__device__ __forceinline__ int otid() { int t = __builtin_amdgcn_workitem_id_x(); asm volatile("" : "+v"(t)); return t; }
__device__ __forceinline__ int obid() { int b = __builtin_amdgcn_workgroup_id_x(); asm volatile("" : "+s"(b)); return b; }
__device__ __forceinline__ float bf2f(bf16_t v) { return __uint_as_float(((unsigned)v) << 16); }
__device__ __forceinline__ unsigned f2bf(float f) { unsigned u = __float_as_uint(f); return (u + 0x7fffu + ((u >> 16) & 1u)) >> 16; }
__device__ __forceinline__ unsigned pk2(float lo, float hi) { return f2bf(lo) | (f2bf(hi) << 16); }
__device__ __forceinline__ float lo16(unsigned u) { return __uint_as_float(u << 16); }
__device__ __forceinline__ float hi16(unsigned u) { return __uint_as_float(u & 0xffff0000u); }
__device__ __forceinline__ float wave_sum(float v) {
#pragma unroll
    for (int o = 1; o < 64; o <<= 1) v += __shfl_xor(v, o);
    return v;
}
__device__ __forceinline__ float wave_max(float v) {
#pragma unroll
    for (int o = 1; o < 64; o <<= 1) v = fmaxf(v, __shfl_xor(v, o));
    return v;
}
__device__ __forceinline__ float silu(float g) { return g / (1.f + __expf(-g)); }

constexpr size_t al256(size_t x) { return (x + 255) & ~(size_t)255; }
constexpr size_t OFF_CTRL = 0;
constexpr size_t OFF_WINT = 65536;
constexpr size_t OFF_WOUTT = OFF_WINT + (size_t)DEPTH * NP * DM * 2;
constexpr size_t OFF_WUQT = OFF_WOUTT + (size_t)DEPTH * DM * DM * 2;
constexpr size_t OFF_WUKVT = OFF_WUQT + (size_t)DEPTH * 384 * 256 * 2;
constexpr size_t OFF_SGW = OFF_WUKVT + (size_t)DEPTH * 512 * 128 * 2;
constexpr size_t OFF_COSA = OFF_SGW + (size_t)DEPTH * 4 * 128 * 128 * 2;
constexpr size_t OFF_SINA = OFF_COSA + (size_t)S * 16 * 4;
constexpr size_t OFF_COSD = OFF_SINA + (size_t)S * 16 * 4;
constexpr size_t OFF_SIND = OFF_COSD + (size_t)S * 8 * 4;
constexpr size_t OFF_RSTD = OFF_SIND + (size_t)S * 8 * 4;
constexpr size_t OFF_KMEAN = OFF_RSTD + (size_t)S * 4;
constexpr size_t OFF_SEL = OFF_KMEAN + (size_t)4 * 64 * 64 * 4;
constexpr size_t OFF_XB = OFF_SEL + (size_t)4 * S * 4 * 4;
constexpr size_t OFF_P = OFF_XB + (size_t)S * DM * 2;
constexpr size_t OFF_QA = OFF_P + (size_t)S * NP * 2;
constexpr size_t OFF_KA = OFF_QA + (size_t)4 * S * 96 * 2;
constexpr size_t OFF_VA = OFF_KA + (size_t)4 * S * 96 * 2;
constexpr size_t OFF_END = OFF_VA + (size_t)4 * S * 64 * 2;
static_assert(OFF_END <= 268435456, "workspace map exceeds 256 MiB");
static_assert((OFF_XB % 256) == 0 && (OFF_P % 256) == 0 && (OFF_QA % 256) == 0, "alignment");

constexpr int LDS_BYTES = 147456;

struct Params {
    const float* x; const int* pos; const float* norm_g; const float* w_in; const float* qn_g; const float* w_uq;
    const float* kvn_g; const float* w_ukv; const float* q_g; const float* kn_g; const float* kr_g; const float* conv_w;
    const float* ln_g; const float* ln_b; const float* sg_w; const float* sg_b; const float* mq_g; const float* mk_g;
    const float* w_out; float* out; unsigned char* ws;
};

__device__ __forceinline__ void transpose_tiles(const float* __restrict__ src, int K, int Nsrc, const float* __restrict__ gk,
                                bf16_t* __restrict__ dst, int Ndst, int gap_at, int gap_len, float* lds) {
    float (*t)[33] = (float (*)[33])lds;
    const int tid = otid(), a = tid >> 5, b = tid & 31;
    const int tilesN = Ndst / 32, tilesK = K / 32;
    for (int tile = obid(); tile < tilesN * tilesK; tile += gridDim.x) {
        const int tn = tile % tilesN, tk = tile / tilesN, n0 = tn * 32, k0 = tk * 32;
        __syncthreads();
#pragma unroll
        for (int i = 0; i < 2; ++i) {
            const int kk = a + 16 * i, np = n0 + b;
            const bool z = (np >= gap_at && np < gap_at + gap_len);
            const int n = np < gap_at ? np : np - gap_len;
            float v = z ? 0.f : src[(size_t)(k0 + kk) * Nsrc + n];
            if (gk) v *= gk[k0 + kk];
            t[kk][b] = v;
        }
        __syncthreads();
#pragma unroll
        for (int i = 0; i < 2; ++i) {
            const int nn = a + 16 * i;
            dst[(size_t)(n0 + nn) * K + k0 + b] = (bf16_t)f2bf(t[b][nn]);
        }
    }
}

__device__ __forceinline__ void rows_prep(const float* __restrict__ xsrc, bf16_t* __restrict__ Xb, float* __restrict__ rstd) {
    const int wave = otid() >> 6, lane = otid() & 63;
    const int gw = obid() * (NT / 64) + wave, NGW = gridDim.x * (NT / 64);
    for (int m = gw; m < S; m += NGW) {
        const float4* xr = (const float4*)(xsrc + (size_t)m * DM) + lane;
        float4 v[4]; float s = 0.f;
#pragma unroll
        for (int j = 0; j < 4; ++j) { v[j] = xr[64 * j]; s += (v[j].x * v[j].x + v[j].y * v[j].y) + (v[j].z * v[j].z + v[j].w * v[j].w); }
        s = wave_sum(s);
        const float r = 1.0f / sqrtf(s * (1.0f / DM) + EPS);
        if (lane == 0) rstd[m] = r;
        uint2* o = (uint2*)(Xb + (size_t)m * DM) + lane;
#pragma unroll
        for (int j = 0; j < 4; ++j) o[64 * j] = make_uint2(pk2(v[j].x, v[j].y), pk2(v[j].z, v[j].w));
    }
}

__device__ __forceinline__ void phase_prep(const Params& p, float* lds) {
    unsigned char* ws = p.ws;
    for (int l = 0; l < DEPTH; ++l) {
        transpose_tiles(p.w_in + (size_t)l * DM * DIN, DM, DIN, p.norm_g + l * DM, (bf16_t*)(ws + OFF_WINT) + (size_t)l * NP * DM, NP, 416, 96, lds);
        transpose_tiles(p.w_out + (size_t)l * DM * DM, DM, DM, nullptr, (bf16_t*)(ws + OFF_WOUTT) + (size_t)l * DM * DM, DM, DM, 0, lds);
        transpose_tiles(p.w_uq + (size_t)l * 256 * 384, 256, 384, p.qn_g + l * 256, (bf16_t*)(ws + OFF_WUQT) + (size_t)l * 384 * 256, 384, 384, 0, lds);
        transpose_tiles(p.w_ukv + (size_t)l * 128 * 512, 128, 512, p.kvn_g + l * 128, (bf16_t*)(ws + OFF_WUKVT) + (size_t)l * 512 * 128, 512, 512, 0, lds);
    }
    const int gtid = obid() * NT + otid(), GT = gridDim.x * NT;
    {
        bf16_t* sgw = (bf16_t*)(ws + OFF_SGW);
        for (int i = gtid; i < DEPTH * 4 * 128 * 128; i += GT) {
            const int s_ = i & 127, t_ = (i >> 7) & 127;
            sgw[i] = (bf16_t)f2bf(s_ <= t_ ? p.sg_w[i] : 0.f);
        }
    }
    {
        float* cosA = (float*)(ws + OFF_COSA); float* sinA = (float*)(ws + OFF_SINA);
        float* cosD = (float*)(ws + OFF_COSD); float* sinD = (float*)(ws + OFF_SIND);
        for (int i = gtid; i < S * 24; i += GT) {
            const int s_ = i / 24, j = i % 24;
            const float posf = (float)p.pos[s_];
            float inv;
            if (j < 16) inv = powf(500000.0f, -((float)j * 2.0f / 32.0f));
            else inv = powf(500000.0f, -((float)(j - 16) * 2.0f / 16.0f));
            const float ang = posf * inv;
            const double a = (double)ang;
            const double r = a - rint(a * 0.15915494309189535) * 6.283185307179586;
            const float c = (float)cos(r), sn = (float)sin(r);
            if (j < 16) { cosA[s_ * 16 + j] = c; sinA[s_ * 16 + j] = sn; }
            else { cosD[s_ * 8 + (j - 16)] = c; sinD[s_ * 8 + (j - 16)] = sn; }
        }
    }
    rows_prep(p.x, (bf16_t*)(ws + OFF_XB), (float*)(ws + OFF_RSTD));
}

struct AMapId { __device__ __forceinline__ int operator()(int k0) const { return k0; } };
struct AMapY {
    __device__ __forceinline__ int operator()(int k0) const { const int g = k0 >> 8; const int base = g == 0 ? C_GA : g == 1 ? C_GB : g == 2 ? C_GC : C_GD; return base + (k0 & 255); }
};
template <class AMap, class Epi>
__device__ __forceinline__ void gemm_naive(const bf16_t* __restrict__ A, int lda, AMap amap, const bf16_t* __restrict__ Bt, int K, int M, int N, Epi epi, float* lds) {
    float (*As)[132] = (float (*)[132])lds;
    float (*Bs)[132] = (float (*)[132])(lds + 16 * 132);
    const int tid = otid(), ty = tid >> 5, tx = tid & 31;
    const int lr = tid >> 2, lk = (tid & 3) * 4;
    const int ntm = M / 128, ntn = N / 128;
    for (int tile = obid(); tile < ntm * ntn; tile += gridDim.x) {
        const int tm = tile / ntn, tn = tile % ntn;
        float acc[8][4];
#pragma unroll
        for (int i = 0; i < 8; ++i)
#pragma unroll
            for (int j = 0; j < 4; ++j) acc[i][j] = 0.f;
        for (int k0 = 0; k0 < K; k0 += 16) {
            const uint2 av = *(const uint2*)(A + (size_t)(tm * 128 + lr) * lda + amap(k0) + lk);
            const uint2 bv = *(const uint2*)(Bt + (size_t)(tn * 128 + lr) * K + k0 + lk);
            __syncthreads();
            As[lk + 0][lr] = lo16(av.x); As[lk + 1][lr] = hi16(av.x); As[lk + 2][lr] = lo16(av.y); As[lk + 3][lr] = hi16(av.y);
            Bs[lk + 0][lr] = lo16(bv.x); Bs[lk + 1][lr] = hi16(bv.x); Bs[lk + 2][lr] = lo16(bv.y); Bs[lk + 3][lr] = hi16(bv.y);
            __syncthreads();
#pragma unroll
            for (int kk = 0; kk < 16; ++kk) {
                const float4 a0 = *(const float4*)&As[kk][ty * 8], a1 = *(const float4*)&As[kk][ty * 8 + 4];
                const float4 b = *(const float4*)&Bs[kk][tx * 4];
                const float a[8] = {a0.x, a0.y, a0.z, a0.w, a1.x, a1.y, a1.z, a1.w};
                const float bb[4] = {b.x, b.y, b.z, b.w};
#pragma unroll
                for (int i = 0; i < 8; ++i)
#pragma unroll
                    for (int j = 0; j < 4; ++j) acc[i][j] = fmaf(a[i], bb[j], acc[i][j]);
            }
        }
#pragma unroll
        for (int i = 0; i < 8; ++i) epi(tm * 128 + ty * 8 + i, tn * 128 + tx * 4, acc[i]);
    }
}
struct EpiIn {
    bf16_t* P; const float* rstd;
    __device__ __forceinline__ void operator()(int m, int n, const float (&v)[4]) const {
        const float r = rstd[m];
        *(uint2*)(P + (size_t)m * NP + n) = make_uint2(pk2(v[0] * r, v[1] * r), pk2(v[2] * r, v[3] * r));
    }
};
struct EpiOut {
    const float* xin; float* out;
    __device__ __forceinline__ void operator()(int m, int n, const float (&v)[4]) const {
        const float4 xi = *(const float4*)(xin + (size_t)m * DM + n);
        *(float4*)(out + (size_t)m * DM + n) = make_float4(xi.x + v[0], xi.y + v[1], xi.z + v[2], xi.w + v[3]);
    }
};

constexpr float QSCALE_A = 0.10206207261596577f * LOG2E;
constexpr float QSCALE_D = 0.125f * LOG2E;

__device__ __forceinline__ void post_mla(const Params& p, int l, float* lds) {
    unsigned char* ws = p.ws;
    const bf16_t* P = (const bf16_t*)(ws + OFF_P);
    const bf16_t* WuqT = (const bf16_t*)(ws + OFF_WUQT) + (size_t)l * 384 * 256;
    const bf16_t* WukvT = (const bf16_t*)(ws + OFF_WUKVT) + (size_t)l * 512 * 128;
    bf16_t* Qa = (bf16_t*)(ws + OFF_QA); bf16_t* Ka = (bf16_t*)(ws + OFF_KA); bf16_t* Va = (bf16_t*)(ws + OFF_VA);
    const float* cosA = (const float*)(ws + OFF_COSA); const float* sinA = (const float*)(ws + OFF_SINA);
    const float* q_g = p.q_g + l * 96; const float* kn_g = p.kn_g + l * 64; const float* kr_g = p.kr_g + l * 32;
    float* cq = lds;
    float* ckv = lds + 256;
    float* kr = lds + 384;
    float* qf = lds + 416;
    float* kvf = lds + 800;
    float* st = lds + 1312;
    const int tid = otid(), wave = tid >> 6, lane = tid & 63;
    for (int s = obid(); s < S; s += gridDim.x) {
        __syncthreads();
        if (tid < 416) lds[tid] = bf2f(P[(size_t)s * NP + tid]);
        __syncthreads();
        if (wave == 0) { float a = 0.f; for (int j = 0; j < 4; ++j) { const float v = cq[lane + 64 * j]; a += v * v; } a = wave_sum(a); if (lane == 0) st[0] = 1.0f / sqrtf(a * (1.f / 256.f) + EPS); }
        if (wave == 1) { float a = 0.f; for (int j = 0; j < 2; ++j) { const float v = ckv[lane + 64 * j]; a += v * v; } a = wave_sum(a); if (lane == 0) st[1] = 1.0f / sqrtf(a * (1.f / 128.f) + EPS); }
        if (wave == 2) { float a = 0.f; if (lane < 32) { const float v = kr[lane]; a = v * v; } a = wave_sum(a); if (lane == 0) st[2] = 1.0f / sqrtf(a * (1.f / 32.f) + EPS); }
        __syncthreads();
        if (tid < 384) {
            const uint4* w = (const uint4*)(WuqT + (size_t)tid * 256);
            float a = 0.f;
            for (int c = 0; c < 32; ++c) {
                const uint4 u = w[c]; const float* x = cq + c * 8;
                a += x[0] * lo16(u.x) + x[1] * hi16(u.x) + x[2] * lo16(u.y) + x[3] * hi16(u.y) + x[4] * lo16(u.z) + x[5] * hi16(u.z) + x[6] * lo16(u.w) + x[7] * hi16(u.w);
            }
            qf[tid] = a * st[0];
        }
        {
            const uint4* w = (const uint4*)(WukvT + (size_t)tid * 128);
            float a = 0.f;
            for (int c = 0; c < 16; ++c) {
                const uint4 u = w[c]; const float* x = ckv + c * 8;
                a += x[0] * lo16(u.x) + x[1] * hi16(u.x) + x[2] * lo16(u.y) + x[3] * hi16(u.y) + x[4] * lo16(u.z) + x[5] * hi16(u.z) + x[6] * lo16(u.w) + x[7] * hi16(u.w);
            }
            kvf[tid] = a * st[1];
        }
        __syncthreads();
        if (wave < 4) {
            float a = qf[wave * 96 + lane] * qf[wave * 96 + lane];
            if (lane < 32) { const float v = qf[wave * 96 + 64 + lane]; a += v * v; }
            a = wave_sum(a); if (lane == 0) st[4 + wave] = 1.0f / sqrtf(a * (1.f / 96.f) + EPS);
        } else {
            const int h = wave - 4; const float v = kvf[h * 128 + lane]; float a = wave_sum(v * v);
            if (lane == 0) st[8 + h] = 1.0f / sqrtf(a * (1.f / 64.f) + EPS);
        }
        __syncthreads();
        if (tid < 384) {
            const int h = tid / 96, d = tid % 96;
            float v = qf[tid] * st[4 + h] * q_g[d];
            if (d >= 64) {
                const int i = (d - 64) & 15; const bool first = (d - 64) < 16;
                const int pd = first ? d + 16 : d - 16;
                const float pv = qf[h * 96 + pd] * st[4 + h] * q_g[pd];
                const float c = cosA[s * 16 + i], sn = sinA[s * 16 + i];
                v = first ? v * c - pv * sn : v * c + pv * sn;
            }
            Qa[((size_t)h * S + s) * 96 + d] = (bf16_t)f2bf(v * QSCALE_A);
        }
        if (tid < 256) {
            const int h = tid >> 6, d = tid & 63;
            Ka[((size_t)h * S + s) * 96 + d] = (bf16_t)f2bf(kvf[h * 128 + d] * st[8 + h] * kn_g[d]);
        } else {
            const int t2 = tid - 256, h = t2 >> 6, d = t2 & 63;
            Va[((size_t)h * S + s) * 64 + d] = (bf16_t)f2bf(kvf[h * 128 + 64 + d]);
        }
        if (tid < 32) {
            const int i = tid & 15; const bool first = tid < 16; const int pd = first ? tid + 16 : tid - 16;
            const float v = kr[tid] * st[2] * kr_g[tid], pv = kr[pd] * st[2] * kr_g[pd];
            const float c = cosA[s * 16 + i], sn = sinA[s * 16 + i];
            const bf16_t o = (bf16_t)f2bf(first ? v * c - pv * sn : v * c + pv * sn);
            for (int h = 0; h < 4; ++h) Ka[((size_t)h * S + s) * 96 + 64 + tid] = o;
        }
    }
}

__device__ __forceinline__ void post_conv(const Params& p, int l) {
    bf16_t* P = (bf16_t*)(p.ws + OFF_P);
    const float* cw = p.conv_w + l * 3 * 256;
    const int gtid = obid() * NT + otid(), GT = gridDim.x * NT;
    for (int i = gtid; i < S * 256; i += GT) {
        const int t = i >> 8, c = i & 255;
        const bf16_t* row = P + (size_t)t * NP;
        float z0 = bf2f(row[C_CC + c]) * bf2f(row[C_CH + c]);
        float z1 = 0.f, z2 = 0.f;
        if (t >= 1) { const bf16_t* r1 = row - NP; z1 = bf2f(r1[C_CC + c]) * bf2f(r1[C_CH + c]); }
        if (t >= 2) { const bf16_t* r2 = row - 2 * NP; z2 = bf2f(r2[C_CC + c]) * bf2f(r2[C_CH + c]); }
        const float conv = cw[c] * z2 + cw[256 + c] * z1 + cw[512 + c] * z0;
        const float y = bf2f(row[C_CB + c]) * conv * silu(bf2f(row[C_GB + c]));
        P[(size_t)t * NP + C_GB + c] = (bf16_t)f2bf(y);
    }
}

__device__ __forceinline__ void post_sg(const Params& p, int l, float* lds) {
    bf16_t* P = (bf16_t*)(p.ws + OFF_P);
    const bf16_t* SGW = (const bf16_t*)(p.ws + OFF_SGW) + (size_t)l * 4 * 128 * 128;
    const float* lng = p.ln_g + l * 256; const float* lnb = p.ln_b + l * 256; const float* sgb = p.sg_b + l * 4 * 128;
    float (*vn)[65] = (float (*)[65])lds;
    const int tid = otid(), r = tid >> 2, q4 = tid & 3;
    for (int it = obid(); it < 128 * 4; it += gridDim.x) {
        const int ch = it >> 2, g = it & 3;
        const size_t row = (size_t)ch * 128 + r;
        __syncthreads();
        float xv[64];
        {
            const uint4* src = (const uint4*)(P + row * NP + C_SV + q4 * 64);
#pragma unroll
            for (int c = 0; c < 8; ++c) { const uint4 u = src[c]; xv[c * 8 + 0] = lo16(u.x); xv[c * 8 + 1] = hi16(u.x); xv[c * 8 + 2] = lo16(u.y); xv[c * 8 + 3] = hi16(u.y); xv[c * 8 + 4] = lo16(u.z); xv[c * 8 + 5] = hi16(u.z); xv[c * 8 + 6] = lo16(u.w); xv[c * 8 + 7] = hi16(u.w); }
        }
        float sm = 0.f;
#pragma unroll
        for (int c = 0; c < 64; ++c) sm += xv[c];
        sm += __shfl_xor(sm, 1); sm += __shfl_xor(sm, 2);
        const float mu = sm * (1.f / 256.f);
        float sq = 0.f;
#pragma unroll
        for (int c = 0; c < 64; ++c) { const float d = xv[c] - mu; sq += d * d; }
        sq += __shfl_xor(sq, 1); sq += __shfl_xor(sq, 2);
        const float rs = 1.0f / sqrtf(sq * (1.f / 256.f) + EPS);
        if (q4 == g) {
#pragma unroll
            for (int c = 0; c < 64; ++c) vn[r][c] = (xv[c] - mu) * rs * lng[g * 64 + c] + lnb[g * 64 + c];
        }
        __syncthreads();
        float acc[16];
#pragma unroll
        for (int j = 0; j < 16; ++j) acc[j] = 0.f;
        const bf16_t* wrow = SGW + ((size_t)g * 128 + r) * 128;
        for (int s_ = 0; s_ <= r; ++s_) {
            const float w = bf2f(wrow[s_]);
#pragma unroll
            for (int j = 0; j < 16; ++j) acc[j] = fmaf(w, vn[s_][q4 * 16 + j], acc[j]);
        }
        const float bias = sgb[g * 128 + r];
        bf16_t* prow = P + row * NP;
#pragma unroll
        for (int j = 0; j < 16; ++j) {
            const int c = g * 64 + q4 * 16 + j;
            const float y = bf2f(prow[C_SU + c]) * (acc[j] + bias) * silu(bf2f(prow[C_GC + c]));
            prow[C_GC + c] = (bf16_t)f2bf(y);
        }
    }
}

__device__ __forceinline__ void post_moba(const Params& p, int l, float* lds) {
    bf16_t* P = (bf16_t*)(p.ws + OFF_P);
    float* kmean = (float*)(p.ws + OFF_KMEAN);
    const float* cosD = (const float*)(p.ws + OFF_COSD); const float* sinD = (const float*)(p.ws + OFF_SIND);
    const float* mq_g = p.mq_g + l * 64; const float* mk_g = p.mk_g + l * 64;
    float (*kf)[65] = (float (*)[65])lds;
    const int tid = otid();
    for (int it = obid(); it < 64 * 4; it += gridDim.x) {
        const int n = it >> 2, h = it & 3;
        const bool isq = tid >= 256; const int r = tid & 255;
        const int srow = n * 256 + r;
        bf16_t* ptr = P + (size_t)srow * NP + (isq ? C_MQ : C_MK) + h * 64;
        const float* gg = isq ? mq_g : mk_g;
        float v[64];
        {
            const uint4* src = (const uint4*)ptr;
#pragma unroll
            for (int c = 0; c < 8; ++c) { const uint4 u = src[c]; v[c * 8 + 0] = lo16(u.x); v[c * 8 + 1] = hi16(u.x); v[c * 8 + 2] = lo16(u.y); v[c * 8 + 3] = hi16(u.y); v[c * 8 + 4] = lo16(u.z); v[c * 8 + 5] = hi16(u.z); v[c * 8 + 6] = lo16(u.w); v[c * 8 + 7] = hi16(u.w); }
        }
        float ss = 0.f;
#pragma unroll
        for (int c = 0; c < 64; ++c) ss += v[c] * v[c];
        const float rs = 1.0f / sqrtf(ss * (1.f / 64.f) + EPS);
#pragma unroll
        for (int c = 0; c < 64; ++c) v[c] = v[c] * rs * gg[c];
#pragma unroll
        for (int i = 0; i < 8; ++i) {
            const float c_ = cosD[srow * 8 + i], s_ = sinD[srow * 8 + i];
            const float a = v[i], b = v[i + 8];
            v[i] = a * c_ - b * s_; v[i + 8] = b * c_ + a * s_;
        }
        __syncthreads();
        if (!isq) {
#pragma unroll
            for (int c = 0; c < 64; ++c) kf[r][c] = v[c];
        }
        const float sc = isq ? QSCALE_D : 1.0f;
        {
            uint4* dst = (uint4*)ptr;
#pragma unroll
            for (int c = 0; c < 8; ++c) dst[c] = make_uint4(pk2(v[c * 8] * sc, v[c * 8 + 1] * sc), pk2(v[c * 8 + 2] * sc, v[c * 8 + 3] * sc), pk2(v[c * 8 + 4] * sc, v[c * 8 + 5] * sc), pk2(v[c * 8 + 6] * sc, v[c * 8 + 7] * sc));
        }
        __syncthreads();
        if (tid < 64) {
            float a = 0.f;
            for (int rr = 0; rr < 256; ++rr) a += kf[rr][tid];
            kmean[((size_t)h * 64 + n) * 64 + tid] = a * (1.f / 256.f);
        }
    }
}

__device__ __forceinline__ void phase_gate(const Params& p, int l) {
    const bf16_t* P = (const bf16_t*)(p.ws + OFF_P);
    const float* kmean = (const float*)(p.ws + OFF_KMEAN);
    int* sel = (int*)(p.ws + OFF_SEL);
    const int gtid = obid() * NT + otid(), GT = gridDim.x * NT;
    for (int i = gtid; i < 4 * S; i += GT) {
        const int h = i / S, s = i % S, qb = s >> 8;
        float q[64];
        {
            const uint4* src = (const uint4*)(P + (size_t)s * NP + C_MQ + h * 64);
#pragma unroll
            for (int c = 0; c < 8; ++c) { const uint4 u = src[c]; q[c * 8 + 0] = lo16(u.x); q[c * 8 + 1] = hi16(u.x); q[c * 8 + 2] = lo16(u.y); q[c * 8 + 3] = hi16(u.y); q[c * 8 + 4] = lo16(u.z); q[c * 8 + 5] = hi16(u.z); q[c * 8 + 6] = lo16(u.w); q[c * 8 + 7] = hi16(u.w); }
        }
        float b0 = -3.0e38f, b1 = -3.0e38f, b2 = -3.0e38f; int i0 = -1, i1 = -1, i2 = -1;
        for (int n = 0; n < qb; ++n) {
            const float* km = kmean + ((size_t)h * 64 + n) * 64;
            float g = 0.f;
#pragma unroll
            for (int c = 0; c < 64; ++c) g = fmaf(q[c], km[c], g);
            if (g > b0) { b2 = b1; i2 = i1; b1 = b0; i1 = i0; b0 = g; i0 = n; }
            else if (g > b1) { b2 = b1; i2 = i1; b1 = g; i1 = n; }
            else if (g > b2) { b2 = g; i2 = n; }
        }
        *(int4*)(sel + (size_t)i * 4) = make_int4(i0, i1, i2, qb < 3 ? qb : 3);
    }
}

__device__ __forceinline__ void attn_mla_naive(const Params& p, int l, float* lds) {
    unsigned char* ws = p.ws;
    bf16_t* P = (bf16_t*)(ws + OFF_P);
    const bf16_t* Qa = (const bf16_t*)(ws + OFF_QA); const bf16_t* Ka = (const bf16_t*)(ws + OFF_KA); const bf16_t* Va = (const bf16_t*)(ws + OFF_VA);
    float (*Ks)[100] = (float (*)[100])lds;
    float (*Vs)[68] = (float (*)[68])(lds + 64 * 100);
    float c2;
    {
        float gq = 0.f, gn = 0.f, gr = 0.f;
        for (int d = 0; d < 96; ++d) gq = fmaxf(gq, fabsf(p.q_g[l * 96 + d]));
        for (int d = 0; d < 64; ++d) gn = fmaxf(gn, fabsf(p.kn_g[l * 64 + d]));
        for (int d = 0; d < 32; ++d) gr = fmaxf(gr, fabsf(p.kr_g[l * 32 + d]));
        c2 = gq * sqrtf(64.f * gn * gn + 32.f * gr * gr) * LOG2E * 1.02f;
    }
    const int tid = otid(), qi = tid >> 2, part = tid & 3;
    for (int it = obid(); it < 512; it += gridDim.x) {
        const int pi = it & 255, sec = it >> 8, h = pi >> 6, j = pi & 63, i = sec ? 127 - j : j;
        const int qrow = i * 128 + qi;
        float q[96];
        {
            const uint4* src = (const uint4*)(Qa + ((size_t)h * S + qrow) * 96);
#pragma unroll
            for (int c = 0; c < 12; ++c) { const uint4 u = src[c]; q[c * 8 + 0] = lo16(u.x); q[c * 8 + 1] = hi16(u.x); q[c * 8 + 2] = lo16(u.y); q[c * 8 + 3] = hi16(u.y); q[c * 8 + 4] = lo16(u.z); q[c * 8 + 5] = hi16(u.z); q[c * 8 + 6] = lo16(u.w); q[c * 8 + 7] = hi16(u.w); }
        }
        float o[64];
#pragma unroll
        for (int d = 0; d < 64; ++d) o[d] = 0.f;
        float lsum = 0.f;
        const int ntiles = 2 * (i + 1);
        for (int kt = 0; kt < ntiles; ++kt) {
            __syncthreads();
            for (int c = tid; c < 768; c += NT) {
                const int key = c / 12, chn = c % 12;
                const uint4 u = *(const uint4*)(Ka + ((size_t)h * S + kt * 64 + key) * 96 + chn * 8);
                float* d_ = &Ks[key][chn * 8];
                d_[0] = lo16(u.x); d_[1] = hi16(u.x); d_[2] = lo16(u.y); d_[3] = hi16(u.y); d_[4] = lo16(u.z); d_[5] = hi16(u.z); d_[6] = lo16(u.w); d_[7] = hi16(u.w);
            }
            {
                const int key = tid >> 3, chn = tid & 7;
                const uint4 u = *(const uint4*)(Va + ((size_t)h * S + kt * 64 + key) * 64 + chn * 8);
                float* d_ = &Vs[key][chn * 8];
                d_[0] = lo16(u.x); d_[1] = hi16(u.x); d_[2] = lo16(u.y); d_[3] = hi16(u.y); d_[4] = lo16(u.z); d_[5] = hi16(u.z); d_[6] = lo16(u.w); d_[7] = hi16(u.w);
            }
            __syncthreads();
            for (int kk = 0; kk < 16; ++kk) {
                const int key = part + 4 * kk, kpos = kt * 64 + key;
                float sc = 0.f;
#pragma unroll
                for (int d = 0; d < 96; d += 4) { const float4 kv = *(const float4*)&Ks[key][d]; sc = fmaf(q[d], kv.x, sc); sc = fmaf(q[d + 1], kv.y, sc); sc = fmaf(q[d + 2], kv.z, sc); sc = fmaf(q[d + 3], kv.w, sc); }
                const float pr = (kpos <= qrow) ? exp2f(sc - c2) : 0.f;
                lsum += pr;
#pragma unroll
                for (int d = 0; d < 64; d += 4) { const float4 vv = *(const float4*)&Vs[key][d]; o[d] = fmaf(pr, vv.x, o[d]); o[d + 1] = fmaf(pr, vv.y, o[d + 1]); o[d + 2] = fmaf(pr, vv.z, o[d + 2]); o[d + 3] = fmaf(pr, vv.w, o[d + 3]); }
            }
        }
        lsum += __shfl_xor(lsum, 1); lsum += __shfl_xor(lsum, 2);
        const float inv = 1.0f / lsum;
        bf16_t* prow = P + (size_t)qrow * NP + C_GA + h * 64;
#pragma unroll
        for (int d = 0; d < 64; ++d) {
            float v = o[d]; v += __shfl_xor(v, 1); v += __shfl_xor(v, 2);
            if ((d >> 4) == part) { const float g = bf2f(prow[d]); prow[d] = (bf16_t)f2bf(v * inv * silu(g)); }
        }
    }
}

__device__ __forceinline__ void attn_moba_naive(const Params& p, int l) {
    bf16_t* P = (bf16_t*)(p.ws + OFF_P);
    const int* sel = (const int*)(p.ws + OFF_SEL);
    float c2;
    {
        float gq = 0.f, gk = 0.f;
        for (int d = 0; d < 64; ++d) { gq = fmaxf(gq, fabsf(p.mq_g[l * 64 + d])); gk = fmaxf(gk, fabsf(p.mk_g[l * 64 + d])); }
        c2 = gq * gk * 8.0f * LOG2E * 1.02f;
    }
    const int wave = otid() >> 6, lane = otid() & 63;
    const int gw = obid() * (NT / 64) + wave, NGW = gridDim.x * (NT / 64);
    for (int it = gw; it < 4 * S; it += NGW) {
        const int h = it / S, s = it % S, own = s >> 8;
        float q[64];
        {
            const uint4* src = (const uint4*)(P + (size_t)s * NP + C_MQ + h * 64);
#pragma unroll
            for (int c = 0; c < 8; ++c) { const uint4 u = src[c]; q[c * 8 + 0] = lo16(u.x); q[c * 8 + 1] = hi16(u.x); q[c * 8 + 2] = lo16(u.y); q[c * 8 + 3] = hi16(u.y); q[c * 8 + 4] = lo16(u.z); q[c * 8 + 5] = hi16(u.z); q[c * 8 + 6] = lo16(u.w); q[c * 8 + 7] = hi16(u.w); }
        }
        const int4 sl = *(const int4*)(sel + (size_t)it * 4);
        float o[64];
#pragma unroll
        for (int d = 0; d < 64; ++d) o[d] = 0.f;
        float lsum = 0.f;
        const int nsel = sl.w;
#pragma unroll 1
        for (int bi = 3 - nsel; bi < 4; ++bi) {
            const int sidx = 2 - bi;
            const int blk = bi == 3 ? own : (sidx == 0 ? sl.x : sidx == 1 ? sl.y : sl.z);
#pragma unroll 1
            for (int jj = 0; jj < 4; ++jj) {
                const int kpos = blk * 256 + lane + 64 * jj;
                const uint4* kp = (const uint4*)(P + (size_t)kpos * NP + C_MK + h * 64);
                float sc = 0.f;
#pragma unroll
                for (int c = 0; c < 8; ++c) { const uint4 u = kp[c]; sc += q[c * 8] * lo16(u.x) + q[c * 8 + 1] * hi16(u.x) + q[c * 8 + 2] * lo16(u.y) + q[c * 8 + 3] * hi16(u.y) + q[c * 8 + 4] * lo16(u.z) + q[c * 8 + 5] * hi16(u.z) + q[c * 8 + 6] * lo16(u.w) + q[c * 8 + 7] * hi16(u.w); }
                const bool ok = (bi != 3) || (kpos <= s);
                const float pr = ok ? exp2f(sc - c2) : 0.f;
                lsum += pr;
                const uint4* vp = (const uint4*)(P + (size_t)kpos * NP + C_MV + h * 64);
#pragma unroll
                for (int c = 0; c < 8; ++c) { const uint4 u = vp[c]; o[c * 8] = fmaf(pr, lo16(u.x), o[c * 8]); o[c * 8 + 1] = fmaf(pr, hi16(u.x), o[c * 8 + 1]); o[c * 8 + 2] = fmaf(pr, lo16(u.y), o[c * 8 + 2]); o[c * 8 + 3] = fmaf(pr, hi16(u.y), o[c * 8 + 3]); o[c * 8 + 4] = fmaf(pr, lo16(u.z), o[c * 8 + 4]); o[c * 8 + 5] = fmaf(pr, hi16(u.z), o[c * 8 + 5]); o[c * 8 + 6] = fmaf(pr, lo16(u.w), o[c * 8 + 6]); o[c * 8 + 7] = fmaf(pr, hi16(u.w), o[c * 8 + 7]); }
            }
        }
        lsum = wave_sum(lsum);
        float r32[32], r16[16], r8[8], r4[4], r2[2];
#pragma unroll
        for (int d = 0; d < 32; ++d) { const bool hb = (lane & 32) != 0; const float keep = hb ? o[d + 32] : o[d], send = hb ? o[d] : o[d + 32]; r32[d] = keep + __shfl_xor(send, 32); }
#pragma unroll
        for (int d = 0; d < 16; ++d) { const bool hb = (lane & 16) != 0; const float keep = hb ? r32[d + 16] : r32[d], send = hb ? r32[d] : r32[d + 16]; r16[d] = keep + __shfl_xor(send, 16); }
#pragma unroll
        for (int d = 0; d < 8; ++d) { const bool hb = (lane & 8) != 0; const float keep = hb ? r16[d + 8] : r16[d], send = hb ? r16[d] : r16[d + 8]; r8[d] = keep + __shfl_xor(send, 8); }
#pragma unroll
        for (int d = 0; d < 4; ++d) { const bool hb = (lane & 4) != 0; const float keep = hb ? r8[d + 4] : r8[d], send = hb ? r8[d] : r8[d + 4]; r4[d] = keep + __shfl_xor(send, 4); }
#pragma unroll
        for (int d = 0; d < 2; ++d) { const bool hb = (lane & 2) != 0; const float keep = hb ? r4[d + 2] : r4[d], send = hb ? r4[d] : r4[d + 2]; r2[d] = keep + __shfl_xor(send, 2); }
        float mine;
        { const bool hb = (lane & 1) != 0; const float keep = hb ? r2[1] : r2[0], send = hb ? r2[0] : r2[1]; mine = keep + __shfl_xor(send, 1); }
        bf16_t* gp = P + (size_t)s * NP + C_GD + h * 64 + lane;
        const float g = bf2f(*gp);
        *gp = (bf16_t)f2bf(mine / lsum * silu(g));
    }
}

template <int PH> __device__ __forceinline__ void run_phase(const Params& p, int l, float* lds) {
    unsigned char* ws = p.ws;
    if (PH == 0) phase_prep(p, lds);
    if (PH == 1) gemm_naive((const bf16_t*)(ws + OFF_XB), DM, AMapId{}, (const bf16_t*)(ws + OFF_WINT) + (size_t)l * NP * DM, DM, S, NP,
                            EpiIn{(bf16_t*)(ws + OFF_P), (const float*)(ws + OFF_RSTD)}, lds);
    if (PH == 2) { post_mla(p, l, lds); post_conv(p, l); post_sg(p, l, lds); post_moba(p, l, lds); }
    if (PH == 3) phase_gate(p, l);
    if (PH == 4) { attn_mla_naive(p, l, lds); attn_moba_naive(p, l); }
    if (PH == 5) gemm_naive((const bf16_t*)(ws + OFF_P), NP, AMapY{}, (const bf16_t*)(ws + OFF_WOUTT) + (size_t)l * DM * DM, DM, S, DM,
                            EpiOut{l == 0 ? p.x : p.out, p.out}, lds);
    if (PH == 6) rows_prep(p.out, (bf16_t*)(ws + OFF_XB), (float*)(ws + OFF_RSTD));
}

__global__ void __launch_bounds__(NT) mega_kernel(Params p) {
    extern __shared__ __attribute__((aligned(16))) unsigned char lds_raw[];
    float* lds = (float*)lds_raw;
    cg::grid_group grid = cg::this_grid();
    constexpr int NSTEPS = 1 + 6 + 5;
#pragma unroll 1
    for (int step = 0; step < NSTEPS; ++step) {
        const int l = step >= 7 ? 1 : 0;
        const int ph = step == 0 ? 0 : (step >= 7 ? step - 6 : step);
        switch (ph) {
            case 0: run_phase<0>(p, l, lds); break;
            case 1: run_phase<1>(p, l, lds); break;
            case 2: run_phase<2>(p, l, lds); break;
            case 3: run_phase<3>(p, l, lds); break;
            case 4: run_phase<4>(p, l, lds); break;
            case 5: run_phase<5>(p, l, lds); break;
            default: run_phase<6>(p, l, lds); break;
        }
        if (step + 1 < NSTEPS) grid.sync();
    }
}

extern "C" void kernel_launch(void* const* d_in, const int* in_sizes, int n_in, void* d_out, int out_size, void* d_ws, size_t ws_size, hipStream_t stream) {
    static int grid_blocks = 0;
    if (grid_blocks == 0) {
        int dev = 0, cus = 0, per_cu = 0;
        hipGetDevice(&dev);
        hipDeviceGetAttribute(&cus, hipDeviceAttributeMultiprocessorCount, dev);
        hipFuncSetAttribute((const void*)mega_kernel, hipFuncAttributeMaxDynamicSharedMemorySize, LDS_BYTES);
        hipOccupancyMaxActiveBlocksPerMultiprocessor(&per_cu, (const void*)mega_kernel, NT, LDS_BYTES);
        if (per_cu < 1) { fprintf(stderr, "occupancy query returned %d\n", per_cu); per_cu = 1; }
        if (per_cu > 1) per_cu = 1;
        grid_blocks = cus * per_cu;
        if (ws_size < OFF_END) { fprintf(stderr, "workspace too small: %zu < %zu\n", ws_size, (size_t)OFF_END); grid_blocks = -1; }
    }
    if (grid_blocks < 0) return;
    Params p{};
    p.x = (const float*)d_in[0]; p.pos = (const int*)d_in[1]; p.norm_g = (const float*)d_in[2]; p.w_in = (const float*)d_in[3];
    p.qn_g = (const float*)d_in[4]; p.w_uq = (const float*)d_in[5]; p.kvn_g = (const float*)d_in[6]; p.w_ukv = (const float*)d_in[7];
    p.q_g = (const float*)d_in[8]; p.kn_g = (const float*)d_in[9]; p.kr_g = (const float*)d_in[10]; p.conv_w = (const float*)d_in[11];
    p.ln_g = (const float*)d_in[12]; p.ln_b = (const float*)d_in[13]; p.sg_w = (const float*)d_in[14]; p.sg_b = (const float*)d_in[15];
    p.mq_g = (const float*)d_in[16]; p.mk_g = (const float*)d_in[17]; p.w_out = (const float*)d_in[18];
    p.out = (float*)d_out; p.ws = (unsigned char*)d_ws;
    void* args[] = {&p};
    hipError_t e = hipLaunchCooperativeKernel((const void*)mega_kernel, dim3(grid_blocks), dim3(NT), args, LDS_BYTES, stream);
    if (e != hipSuccess) fprintf(stderr, "cooperative launch failed: %s (grid %d)\n", hipGetErrorString(e), grid_blocks);
}
```

```cpp
#include <hip/hip_runtime.h>
#include <hip/hip_cooperative_groups.h>
#include <stdint.h>
#include <cstdio>
namespace cg = cooperative_groups;

constexpr int S = 16384, DM = 1024, NP = 3584, DEPTH = 2, DIN = 3488;
constexpr int NT = 512;
constexpr float EPS = 1e-6f;
constexpr float LOG2E = 1.4426950408889634f;
constexpr int C_CQ = 0, C_CKV = 256, C_KR = 384, C_GA = 512, C_CH = 768, C_CB = 1024, C_CC = 1280, C_GB = 1536,
              C_SU = 1792, C_SV = 2048, C_GC = 2304, C_MQ = 2560, C_MK = 2816, C_MV = 3072, C_GD = 3328;

typedef unsigned short bf16_t;
struct Ctx { int tid, bid, nb; };
__device__ __forceinline__ float bf2f(bf16_t v) { return __uint_as_float(((unsigned)v) << 16); }
__device__ __forceinline__ unsigned f2bf(float f) { unsigned u = __float_as_uint(f); return (u + 0x7fffu + ((u >> 16) & 1u)) >> 16; }
__device__ __forceinline__ unsigned pk2(float lo, float hi) { return f2bf(lo) | (f2bf(hi) << 16); }
__device__ __forceinline__ float lo16(unsigned u) { return __uint_as_float(u << 16); }
__device__ __forceinline__ float hi16(unsigned u) { return __uint_as_float(u & 0xffff0000u); }
__device__ __forceinline__ float shx(float v, int k, int lane) { return __builtin_bit_cast(float, __builtin_amdgcn_ds_bpermute((lane ^ k) << 2, __builtin_bit_cast(int, v))); }
__device__ __forceinline__ float wave_sum(float v, int lane) {
#pragma unroll
    for (int o = 1; o < 64; o <<= 1) v += shx(v, o, lane);
    return v;
}
__device__ __forceinline__ float silu(float g) { return g / (1.f + __expf(-g)); }

constexpr size_t al256(size_t x) { return (x + 255) & ~(size_t)255; }
constexpr size_t OFF_CTRL = 0;
constexpr size_t OFF_WINT = 65536;
constexpr size_t OFF_WOUTT = OFF_WINT + (size_t)DEPTH * NP * DM * 2;
constexpr size_t OFF_WUQT = OFF_WOUTT + (size_t)DEPTH * DM * DM * 2;
constexpr size_t OFF_WUKVT = OFF_WUQT + (size_t)DEPTH * 384 * 256 * 2;
constexpr size_t OFF_SGW = OFF_WUKVT + (size_t)DEPTH * 512 * 128 * 2;
constexpr size_t OFF_COSA = OFF_SGW + (size_t)DEPTH * 4 * 128 * 128 * 2;
constexpr size_t OFF_SINA = OFF_COSA + (size_t)S * 16 * 4;
constexpr size_t OFF_COSD = OFF_SINA + (size_t)S * 16 * 4;
constexpr size_t OFF_SIND = OFF_COSD + (size_t)S * 8 * 4;
constexpr size_t OFF_RSTD = OFF_SIND + (size_t)S * 8 * 4;
constexpr size_t OFF_KMEAN = OFF_RSTD + (size_t)S * 4;
constexpr size_t OFF_SEL = OFF_KMEAN + (size_t)4 * 64 * 64 * 4;
constexpr size_t OFF_XB = OFF_SEL + (size_t)4 * S * 4 * 4;
constexpr size_t OFF_P = OFF_XB + (size_t)S * DM * 2;
constexpr size_t OFF_QA = OFF_P + (size_t)S * NP * 2;
constexpr size_t OFF_KA = OFF_QA + (size_t)4 * S * 96 * 2;
constexpr size_t OFF_VA = OFF_KA + (size_t)4 * S * 96 * 2;
constexpr size_t OFF_END = OFF_VA + (size_t)4 * S * 64 * 2;
static_assert(OFF_END <= 268435456, "workspace map exceeds 256 MiB");
static_assert((OFF_XB % 256) == 0 && (OFF_P % 256) == 0 && (OFF_QA % 256) == 0, "alignment");

constexpr int LDS_BYTES = 147456;

struct Params {
    const float* x; const int* pos; const float* norm_g; const float* w_in; const float* qn_g; const float* w_uq;
    const float* kvn_g; const float* w_ukv; const float* q_g; const float* kn_g; const float* kr_g; const float* conv_w;
    const float* ln_g; const float* ln_b; const float* sg_w; const float* sg_b; const float* mq_g; const float* mk_g;
    const float* w_out; float* out; unsigned char* ws;
};

namespace pg8 {
#define PG8_LAS __attribute__((address_space(3)))
typedef unsigned short bf16_t;
typedef short bf16x8 __attribute__((ext_vector_type(8)));
typedef float f32x4 __attribute__((ext_vector_type(4)));
typedef unsigned u32x4 __attribute__((ext_vector_type(4)));
constexpr int BM = 256, BK = 64, HALF = 128, HTB = HALF * BK * 2  , STAGE_BYTES = 8 * HTB, NXCD = 8, WGM = 8;

__host__ __device__ __forceinline__ int lds_byte(int r, int c) { const int st = (r >> 4) * 2 + (c >> 5), rr = r & 15, cc = c & 31, ob = rr * 64 + cc * 2; return st * 1024 + (ob ^ (((ob >> 9) & 1) << 5)); }
__host__ __device__ __forceinline__ void stage_rc(int b, int& R, int& C) { const int st = b / 1024, sb = b % 1024, swz = sb ^ (((sb >> 9) & 1) << 5); R = (st >> 1) * 16 + swz / 64; C = (st & 1) * 32 + (swz % 64) / 2; }
__host__ __device__ __forceinline__ int perm32(int rho) { const int n = rho >> 4, i = rho & 15; return 8 * (i >> 2) + 4 * n + (i & 3); }

struct Unit { int pm, pn; };
struct Gemm { const bf16_t* A; const bf16_t* Bt; int M, N, K, lda; };

struct StaticOrder {
    int nM, nN, nwg, G, c;
    __host__ __device__ void init(int M, int N, int G_, int c_) { nM = M / BM; nN = N / BM; nwg = nM * nN; G = G_; c = c_; }
    __host__ __device__ bool next(int i, Unit& u) const {
        const long L = (long)i * G + c; if (L >= nwg) return false;
        int wgid = (int)L; { const int q = nwg / NXCD, r = nwg % NXCD, xcd = wgid % NXCD, off = wgid / NXCD; wgid = (xcd < r ? xcd * (q + 1) : r * (q + 1) + (xcd - r) * q) + off; }
        const int nig = WGM * nN, gid = wgid / nig, fm = gid * WGM, gsz = (nM - fm) < WGM ? (nM - fm) : WGM;
        u.pm = fm + ((wgid % nig) % gsz); u.pn = (wgid % nig) / gsz; return true;
    }
    __device__ __forceinline__ void a_ready(const Unit&) const {}
    __device__ __forceinline__ void done(const Unit&) const {}
};


template <class Epi, class Sched, class AOff, bool ALIGN_EPI = false, bool SP2 = false>
__device__ __forceinline__ void gemm_phase(const Ctx& cx, PG8_LAS unsigned char* lds, const Gemm g, const Sched& S, const Epi& E, const AOff& AO) {
    const int tid = cx.tid, wid = __builtin_amdgcn_readfirstlane(tid >> 6), lane = tid & 63, wr = wid >> 2, wc = wid & 3, fr = lane & 15, fq = lane >> 4;
    const int K = g.K, nt = K / BK;
    unsigned voffA[2], voffB[2];
#pragma unroll
    for (int i = 0; i < 2; ++i) { int R, C; stage_rc(tid * 16 + i * 8192, R, C); const int Rb = Epi::PERM ? ((R & ~31) + perm32(R & 31)) : R;
        voffA[i] = (unsigned)(R * g.lda + C) * 2u; voffB[i] = (unsigned)(Rb * K + C) * 2u; }
    const size_t kstep = (size_t)(BK * 2);
    const size_t hstepB = (size_t)HALF * K * 2, hstepA = (size_t)HALF * g.lda * 2;
    const size_t tstepB = 2 * hstepB, tstepA = 2 * hstepA;
    const unsigned ldsw = (unsigned)wid * 1024u;
    const int aoff = lds_byte(wr * 64 + fr, fq * 8), boff = lds_byte(wc * 32 + fr, fq * 8);
#define PG8_SA(b, h) (((b) * 2 + (h)) * HTB)
#define PG8_SB(b, h) ((4 + (b) * 2 + (h)) * HTB)
#define PG8_STAGE(bufoff, gbase, voff) do { _Pragma("unroll") for (int _i = 0; _i < 2; ++_i) \
        __builtin_amdgcn_global_load_lds((const unsigned*)((const char*)(gbase) + (voff)[_i]), (PG8_LAS unsigned*)(lds + (bufoff) + ldsw + _i * 8192), 16, 0, 0); } while (0)
#define PG8_LDA(dst, b, h) do { _Pragma("unroll") for (int m = 0; m < 4; ++m) _Pragma("unroll") for (int k = 0; k < 2; ++k) dst[m][k] = *(const PG8_LAS bf16x8*)(lds + PG8_SA(b, h) + aoff + m * 2048 + k * 1024); } while (0)
#define PG8_LDB(dst, b, h) do { _Pragma("unroll") for (int n = 0; n < 2; ++n) _Pragma("unroll") for (int k = 0; k < 2; ++k) dst[n][k] = *(const PG8_LAS bf16x8*)(lds + PG8_SB(b, h) + boff + n * 2048 + k * 1024); } while (0)
#define PG8_MMA(ai, bj, At, Bt) do { __builtin_amdgcn_s_setprio(1); _Pragma("unroll") for (int m = 0; m < 4; ++m) _Pragma("unroll") for (int n = 0; n < 2; ++n) _Pragma("unroll") for (int k = 0; k < 2; ++k) \
        acc[ai][bj][m][n] = __builtin_amdgcn_mfma_f32_16x16x32_bf16(Bt[n][k], At[m][k], acc[ai][bj][m][n], 0, 0, 0); __builtin_amdgcn_s_setprio(0); } while (0)
#define PG8_WAIT_V(n) asm volatile("s_waitcnt vmcnt(" #n ")" ::: "memory")
#define PG8_WAIT_L(n) asm volatile("s_waitcnt lgkmcnt(" #n ")" ::: "memory")
#define PG8_BAR __builtin_amdgcn_s_barrier()
#define PG8_SCHED __builtin_amdgcn_sched_barrier(0)
    Unit cur, nxt; int ui = 0;
    if (!S.next(0, cur)) return;
    f32x4 acc[2][2][4][2];
#pragma unroll
    for (int a = 0; a < 2; ++a)
#pragma unroll
        for (int b = 0; b < 2; ++b)
#pragma unroll
            for (int m = 0; m < 4; ++m)
#pragma unroll
                for (int n = 0; n < 2; ++n) acc[a][b][m][n] = (f32x4){0.f, 0.f, 0.f, 0.f};
    bf16x8 At[4][2], B0[2][2], B1[2][2];
    const char* cA = (const char*)g.A + (size_t)cur.pm * tstepA; const char* cB = (const char*)g.Bt + (size_t)cur.pn * tstepB;
    S.a_ready(cur);
    if constexpr (SP2) {
        PG8_STAGE(PG8_SB(0, 0), cB, voffB); PG8_STAGE(PG8_SB(0, 1), cB + hstepB, voffB); PG8_STAGE(PG8_SA(0, 0), cA + AO(0), voffA); PG8_STAGE(PG8_SA(0, 1), cA + AO(0) + hstepA, voffA);
        if (wr == 1) PG8_BAR;
        PG8_WAIT_V(2); PG8_BAR;
        PG8_STAGE(PG8_SB(1, 0), cB + kstep, voffB); PG8_STAGE(PG8_SA(1, 0), cA + AO(1), voffA); PG8_STAGE(PG8_SB(1, 1), cB + hstepB + kstep, voffB);
        PG8_WAIT_V(6); PG8_BAR;
    } else {
        PG8_STAGE(PG8_SB(0, 0), cB, voffB); PG8_STAGE(PG8_SA(0, 0), cA + AO(0), voffA); PG8_STAGE(PG8_SB(0, 1), cB + hstepB, voffB); PG8_STAGE(PG8_SA(0, 1), cA + AO(0) + hstepA, voffA);
        if (wr == 1) PG8_BAR;
        PG8_WAIT_V(4); PG8_BAR;
        PG8_STAGE(PG8_SB(1, 0), cB + kstep, voffB); PG8_STAGE(PG8_SA(1, 0), cA + AO(1), voffA); PG8_STAGE(PG8_SB(1, 1), cB + hstepB + kstep, voffB);
        PG8_WAIT_V(6); PG8_BAR;
    }
    for (;;) {
        const bool has_next = S.next(ui + 1, nxt);
        const char* nA = has_next ? (const char*)g.A + (size_t)nxt.pm * tstepA : cA; const char* nB = has_next ? (const char*)g.Bt + (size_t)nxt.pn * tstepB : cB;
        for (int t = 0; t < nt; t += 2) {
            const bool last = (t == nt - 2);
            const char* a1 = cA + AO(t + 1);
            const char* a2 = last ? nA + AO(0) : cA + AO(t + 2); const char* b2 = last ? nB : cB + (size_t)(t + 2) * kstep;
            const char* a3 = last ? nA + AO(1) : cA + AO(t + 3); const char* b3 = b2 + kstep;
            if (last && has_next) S.a_ready(nxt);
            if constexpr (SP2) {
            PG8_LDB(B0, 0, 0); PG8_LDB(B1, 0, 1); PG8_SCHED; PG8_LDA(At, 0, 0); PG8_STAGE(PG8_SA(1, 1), a1 + hstepA, voffA);
            PG8_WAIT_V(8); PG8_WAIT_L(0); PG8_BAR; PG8_MMA(0, 0, At, B0); PG8_MMA(0, 1, At, B1); PG8_BAR; PG8_SCHED;
            PG8_LDA(At, 0, 1); PG8_STAGE(PG8_SB(0, 0), b2, voffB); PG8_STAGE(PG8_SB(0, 1), b2 + hstepB, voffB); PG8_STAGE(PG8_SA(0, 0), a2, voffA);
            PG8_WAIT_V(8); PG8_WAIT_L(0); PG8_BAR; PG8_MMA(1, 0, At, B0); PG8_MMA(1, 1, At, B1); PG8_BAR; PG8_SCHED;
            PG8_LDB(B0, 1, 0); PG8_LDB(B1, 1, 1); PG8_SCHED; PG8_LDA(At, 1, 0); PG8_STAGE(PG8_SA(0, 1), a2 + hstepA, voffA);
            PG8_WAIT_V(8); PG8_WAIT_L(0); PG8_BAR; PG8_MMA(0, 0, At, B0); PG8_MMA(0, 1, At, B1); PG8_BAR; PG8_SCHED;
            PG8_LDA(At, 1, 1); PG8_STAGE(PG8_SB(1, 0), b3, voffB); PG8_STAGE(PG8_SB(1, 1), b3 + hstepB, voffB); PG8_STAGE(PG8_SA(1, 0), a3, voffA);
            PG8_WAIT_V(8); PG8_WAIT_L(0); PG8_BAR; PG8_MMA(1, 0, At, B0); PG8_MMA(1, 1, At, B1); PG8_BAR; PG8_SCHED;
            } else {
            PG8_LDB(B0, 0, 0); PG8_SCHED; PG8_LDA(At, 0, 0); PG8_STAGE(PG8_SA(1, 1), a1 + hstepA, voffA);
            PG8_WAIT_L(8); PG8_BAR; PG8_WAIT_L(0); PG8_MMA(0, 0, At, B0); PG8_BAR; PG8_SCHED;
            PG8_LDB(B1, 0, 1); PG8_STAGE(PG8_SB(0, 0), b2, voffB);
            PG8_BAR; PG8_WAIT_L(0); PG8_MMA(0, 1, At, B1); PG8_BAR;
            PG8_LDA(At, 0, 1); PG8_STAGE(PG8_SA(0, 0), a2, voffA);
            PG8_BAR; PG8_WAIT_L(0); PG8_MMA(1, 0, At, B0); PG8_BAR; PG8_SCHED;
            PG8_STAGE(PG8_SB(0, 1), b2 + hstepB, voffB);
            PG8_WAIT_V(6); PG8_BAR; PG8_MMA(1, 1, At, B1); PG8_BAR;
            PG8_LDB(B0, 1, 0); PG8_SCHED; PG8_LDA(At, 1, 0); PG8_STAGE(PG8_SA(0, 1), a2 + hstepA, voffA);
            PG8_WAIT_L(8); PG8_BAR; PG8_WAIT_L(0); PG8_MMA(0, 0, At, B0); PG8_BAR; PG8_SCHED;
            PG8_LDB(B1, 1, 1); PG8_STAGE(PG8_SB(1, 0), b3, voffB);
            PG8_BAR; PG8_WAIT_L(0); PG8_MMA(0, 1, At, B1); PG8_BAR;
            PG8_LDA(At, 1, 1); PG8_STAGE(PG8_SA(1, 0), a3, voffA);
            PG8_BAR; PG8_WAIT_L(0); PG8_MMA(1, 0, At, B0); PG8_BAR; PG8_SCHED;
            PG8_STAGE(PG8_SB(1, 1), b3 + hstepB, voffB);
            PG8_WAIT_V(6); PG8_BAR; PG8_MMA(1, 1, At, B1); PG8_BAR;
            }
        }
        if constexpr (ALIGN_EPI) { if (wr == 0) PG8_BAR; }
        if constexpr (!Epi::AFTER_DRAIN) { E(acc, cur, wr, wc, fr, fq); S.done(cur); }
        if (!has_next) break;
#pragma unroll
        for (int a = 0; a < 2; ++a)
#pragma unroll
            for (int b = 0; b < 2; ++b)
#pragma unroll
                for (int m = 0; m < 4; ++m)
#pragma unroll
                    for (int n = 0; n < 2; ++n) acc[a][b][m][n] = (f32x4){0.f, 0.f, 0.f, 0.f};
        cur = nxt; cA = nA; cB = nB; ++ui;
        if constexpr (ALIGN_EPI) { if (wr == 1) PG8_BAR; }
    }
    PG8_WAIT_V(0);
    if constexpr (!ALIGN_EPI) { if (wr == 0) PG8_BAR; }
    PG8_BAR;
    if constexpr (Epi::AFTER_DRAIN) { E.fused(acc, cur, wr, wc, fr, fq, lds, wid, lane); S.done(cur); }
#undef PG8_SA
#undef PG8_SB
#undef PG8_STAGE
#undef PG8_LDA
#undef PG8_LDB
#undef PG8_MMA
#undef PG8_WAIT_V
#undef PG8_WAIT_L
#undef PG8_BAR
#undef PG8_SCHED
}

__device__ __forceinline__ unsigned cvt_pk_bf16(float lo, float hi) { unsigned r; asm volatile("v_cvt_pk_bf16_f32 %0, %1, %2" : "=v"(r) : "v"(lo), "v"(hi)); return r; }
struct AOffId { __device__ __forceinline__ size_t operator()(int t) const { return (size_t)t * (BK * 2); } };
struct AOffY {
    __device__ __forceinline__ size_t operator()(int t) const { const int g = t >> 2; const int base = g == 0 ? 512 : g == 1 ? 1536 : g == 2 ? 2304 : 3328; return (size_t)(base + (t & 3) * 64) * 2; }
};
struct EpiInP {
    static constexpr bool PERM = true, AFTER_DRAIN = false;
    bf16_t* P; const float* rstd; int ldp;
    __device__ __forceinline__ void operator()(const f32x4 (&acc)[2][2][4][2], const Unit& u, int wr, int wc, int fr, int fq) const {
        const int row0 = u.pm * BM + wr * 64 + fr, col0 = u.pn * BM + wc * 32 + 8 * fq;
#pragma unroll
        for (int ai = 0; ai < 2; ++ai)
#pragma unroll
            for (int m = 0; m < 4; ++m) { const int row = row0 + ai * HALF + m * 16; const float r = rstd[row]; bf16_t* rowp = P + (size_t)row * ldp + col0;
#pragma unroll
                for (int bj = 0; bj < 2; ++bj) { const f32x4 v0 = acc[ai][bj][m][0] * r, v1 = acc[ai][bj][m][1] * r;
                    u32x4 w; w.x = cvt_pk_bf16(v0[0], v0[1]); w.y = cvt_pk_bf16(v0[2], v0[3]); w.z = cvt_pk_bf16(v1[0], v1[1]); w.w = cvt_pk_bf16(v1[2], v1[3]);
                    *(u32x4*)(rowp + bj * HALF) = w; } }
    }
};
struct EpiOutP {
    static constexpr bool PERM = false, AFTER_DRAIN = false;
    const float* xin; float* out; int ldc;
    __device__ __forceinline__ void operator()(const f32x4 (&acc)[2][2][4][2], const Unit& u, int wr, int wc, int fr, int fq) const {
        const int col0 = u.pn * BM + wc * 32 + 4 * fq;
#pragma unroll
        for (int ai = 0; ai < 2; ++ai)
#pragma unroll
            for (int m = 0; m < 4; ++m) { const size_t off = (size_t)(u.pm * BM + ai * HALF + wr * 64 + m * 16 + fr) * ldc + col0;
#pragma unroll
                for (int bj = 0; bj < 2; ++bj)
#pragma unroll
                    for (int n = 0; n < 2; ++n) { const f32x4 xi = *(const f32x4*)(xin + off + bj * HALF + n * 16); *(f32x4*)(out + off + bj * HALF + n * 16) = xi + acc[ai][bj][m][n]; } }
    }
};
}

__device__ __forceinline__ void transpose_tiles(const Ctx& cx, const float* __restrict__ src, int K, int Nsrc, const float* __restrict__ gk,
                                bf16_t* __restrict__ dst, int Ndst, int gap_at, int gap_len, float* lds) {
    float (*t)[33] = (float (*)[33])lds;
    const int tid = cx.tid, a = tid >> 5, b = tid & 31;
    const int tilesN = Ndst / 32, tilesK = K / 32;
    for (int tile = cx.bid; tile < tilesN * tilesK; tile += cx.nb) {
        const int tn = tile % tilesN, tk = tile / tilesN, n0 = tn * 32, k0 = tk * 32;
        __syncthreads();
#pragma unroll
        for (int i = 0; i < 2; ++i) {
            const int kk = a + 16 * i, np = n0 + b;
            const bool z = (np >= gap_at && np < gap_at + gap_len);
            const int n = np < gap_at ? np : np - gap_len;
            float v = z ? 0.f : src[(size_t)(k0 + kk) * Nsrc + n];
            if (gk) v *= gk[k0 + kk];
            t[kk][b] = v;
        }
        __syncthreads();
#pragma unroll
        for (int i = 0; i < 2; ++i) {
            const int nn = a + 16 * i;
            dst[(size_t)(n0 + nn) * K + k0 + b] = (bf16_t)f2bf(t[b][nn]);
        }
    }
}

__device__ __forceinline__ void rows_prep(const Ctx& cx, const float* __restrict__ xsrc, bf16_t* __restrict__ Xb, float* __restrict__ rstd) {
    const int wave = cx.tid >> 6, lane = cx.tid & 63;
    const int gw = cx.bid * (NT / 64) + wave, NGW = cx.nb * (NT / 64);
    for (int m = gw; m < S; m += NGW) {
        const float4* xr = (const float4*)(xsrc + (size_t)m * DM) + lane;
        float4 v[4]; float s = 0.f;
#pragma unroll
        for (int j = 0; j < 4; ++j) { v[j] = xr[64 * j]; s += (v[j].x * v[j].x + v[j].y * v[j].y) + (v[j].z * v[j].z + v[j].w * v[j].w); }
        s = wave_sum(s, lane);
        const float r = 1.0f / sqrtf(s * (1.0f / DM) + EPS);
        if (lane == 0) rstd[m] = r;
        uint2* o = (uint2*)(Xb + (size_t)m * DM) + lane;
#pragma unroll
        for (int j = 0; j < 4; ++j) o[64 * j] = make_uint2(pk2(v[j].x, v[j].y), pk2(v[j].z, v[j].w));
    }
}

__device__ __forceinline__ void phase_prep(const Ctx& cx, const Params& p, float* lds) {
    unsigned char* ws = p.ws;
    for (int l = 0; l < DEPTH; ++l) {
        transpose_tiles(cx, p.w_in + (size_t)l * DM * DIN, DM, DIN, p.norm_g + l * DM, (bf16_t*)(ws + OFF_WINT) + (size_t)l * NP * DM, NP, 416, 96, lds);
        transpose_tiles(cx, p.w_out + (size_t)l * DM * DM, DM, DM, nullptr, (bf16_t*)(ws + OFF_WOUTT) + (size_t)l * DM * DM, DM, DM, 0, lds);
        transpose_tiles(cx, p.w_uq + (size_t)l * 256 * 384, 256, 384, p.qn_g + l * 256, (bf16_t*)(ws + OFF_WUQT) + (size_t)l * 384 * 256, 384, 384, 0, lds);
        transpose_tiles(cx, p.w_ukv + (size_t)l * 128 * 512, 128, 512, p.kvn_g + l * 128, (bf16_t*)(ws + OFF_WUKVT) + (size_t)l * 512 * 128, 512, 512, 0, lds);
    }
    const int gtid = cx.bid * NT + cx.tid, GT = cx.nb * NT;
    {
        bf16_t* sgw = (bf16_t*)(ws + OFF_SGW);
        for (int i = gtid; i < DEPTH * 4 * 128 * 128; i += GT) {
            const int s_ = i & 127, t_ = (i >> 7) & 127;
            sgw[i] = (bf16_t)f2bf(s_ <= t_ ? p.sg_w[i] : 0.f);
        }
    }
    {
        float* cosA = (float*)(ws + OFF_COSA); float* sinA = (float*)(ws + OFF_SINA);
        float* cosD = (float*)(ws + OFF_COSD); float* sinD = (float*)(ws + OFF_SIND);
        for (int i = gtid; i < S * 24; i += GT) {
            const int s_ = i / 24, j = i % 24;
            const float posf = (float)p.pos[s_];
            float inv;
            if (j < 16) inv = powf(500000.0f, -((float)j * 2.0f / 32.0f));
            else inv = powf(500000.0f, -((float)(j - 16) * 2.0f / 16.0f));
            const float ang = posf * inv;
            const double a = (double)ang;
            const double r = a - rint(a * 0.15915494309189535) * 6.283185307179586;
            const float c = (float)cos(r), sn = (float)sin(r);
            if (j < 16) { cosA[s_ * 16 + j] = c; sinA[s_ * 16 + j] = sn; }
            else { cosD[s_ * 8 + (j - 16)] = c; sinD[s_ * 8 + (j - 16)] = sn; }
        }
    }
    rows_prep(cx, p.x, (bf16_t*)(ws + OFF_XB), (float*)(ws + OFF_RSTD));
}

struct AMapId { __device__ __forceinline__ int operator()(int k0) const { return k0; } };
struct AMapY {
    __device__ __forceinline__ int operator()(int k0) const { const int g = k0 >> 8; const int base = g == 0 ? C_GA : g == 1 ? C_GB : g == 2 ? C_GC : C_GD; return base + (k0 & 255); }
};
template <class AMap, class Epi>
__device__ __forceinline__ void gemm_naive(const Ctx& cx, const bf16_t* __restrict__ A, int lda, AMap amap, const bf16_t* __restrict__ Bt, int K, int M, int N, Epi epi, float* lds) {
    float (*As)[132] = (float (*)[132])lds;
    float (*Bs)[132] = (float (*)[132])(lds + 16 * 132);
    const int tid = cx.tid, ty = tid >> 5, tx = tid & 31;
    const int lr = tid >> 2, lk = (tid & 3) * 4;
    const int ntm = M / 128, ntn = N / 128;
    for (int tile = cx.bid; tile < ntm * ntn; tile += cx.nb) {
        const int tm = tile / ntn, tn = tile % ntn;
        float acc[8][4];
#pragma unroll
        for (int i = 0; i < 8; ++i)
#pragma unroll
            for (int j = 0; j < 4; ++j) acc[i][j] = 0.f;
        for (int k0 = 0; k0 < K; k0 += 16) {
            const uint2 av = *(const uint2*)(A + (size_t)(tm * 128 + lr) * lda + amap(k0) + lk);
            const uint2 bv = *(const uint2*)(Bt + (size_t)(tn * 128 + lr) * K + k0 + lk);
            __syncthreads();
            As[lk + 0][lr] = lo16(av.x); As[lk + 1][lr] = hi16(av.x); As[lk + 2][lr] = lo16(av.y); As[lk + 3][lr] = hi16(av.y);
            Bs[lk + 0][lr] = lo16(bv.x); Bs[lk + 1][lr] = hi16(bv.x); Bs[lk + 2][lr] = lo16(bv.y); Bs[lk + 3][lr] = hi16(bv.y);
            __syncthreads();
#pragma unroll
            for (int kk = 0; kk < 16; ++kk) {
                const float4 a0 = *(const float4*)&As[kk][ty * 8], a1 = *(const float4*)&As[kk][ty * 8 + 4];
                const float4 b = *(const float4*)&Bs[kk][tx * 4];
                const float a[8] = {a0.x, a0.y, a0.z, a0.w, a1.x, a1.y, a1.z, a1.w};
                const float bb[4] = {b.x, b.y, b.z, b.w};
#pragma unroll
                for (int i = 0; i < 8; ++i)
#pragma unroll
                    for (int j = 0; j < 4; ++j) acc[i][j] = fmaf(a[i], bb[j], acc[i][j]);
            }
        }
#pragma unroll
        for (int i = 0; i < 8; ++i) epi(tm * 128 + ty * 8 + i, tn * 128 + tx * 4, acc[i]);
    }
}
struct EpiIn {
    bf16_t* P; const float* rstd;
    __device__ __forceinline__ void operator()(int m, int n, const float (&v)[4]) const {
        const float r = rstd[m];
        *(uint2*)(P + (size_t)m * NP + n) = make_uint2(pk2(v[0] * r, v[1] * r), pk2(v[2] * r, v[3] * r));
    }
};
struct EpiOut {
    const float* xin; float* out;
    __device__ __forceinline__ void operator()(int m, int n, const float (&v)[4]) const {
        const float4 xi = *(const float4*)(xin + (size_t)m * DM + n);
        *(float4*)(out + (size_t)m * DM + n) = make_float4(xi.x + v[0], xi.y + v[1], xi.z + v[2], xi.w + v[3]);
    }
};

constexpr float QSCALE_A = 0.10206207261596577f * LOG2E;
constexpr float QSCALE_D = 0.125f * LOG2E;

__device__ __forceinline__ void post_mla(const Ctx& cx, const Params& p, int l, float* lds) {
    unsigned char* ws = p.ws;
    const bf16_t* P = (const bf16_t*)(ws + OFF_P);
    const bf16_t* WuqT = (const bf16_t*)(ws + OFF_WUQT) + (size_t)l * 384 * 256;
    const bf16_t* WukvT = (const bf16_t*)(ws + OFF_WUKVT) + (size_t)l * 512 * 128;
    bf16_t* Qa = (bf16_t*)(ws + OFF_QA); bf16_t* Ka = (bf16_t*)(ws + OFF_KA); bf16_t* Va = (bf16_t*)(ws + OFF_VA);
    const float* cosA = (const float*)(ws + OFF_COSA); const float* sinA = (const float*)(ws + OFF_SINA);
    const float* q_g = p.q_g + l * 96; const float* kn_g = p.kn_g + l * 64; const float* kr_g = p.kr_g + l * 32;
    float* cq = lds;
    float* ckv = lds + 256;
    float* kr = lds + 384;
    float* qf = lds + 416;
    float* kvf = lds + 800;
    float* st = lds + 1312;
    const int tid = cx.tid, wave = tid >> 6, lane = tid & 63;
    for (int s = cx.bid; s < S; s += cx.nb) {
        __syncthreads();
        if (tid < 416) lds[tid] = bf2f(P[(size_t)s * NP + tid]);
        __syncthreads();
        if (wave == 0) { float a = 0.f; for (int j = 0; j < 4; ++j) { const float v = cq[lane + 64 * j]; a += v * v; } a = wave_sum(a, lane); if (lane == 0) st[0] = 1.0f / sqrtf(a * (1.f / 256.f) + EPS); }
        if (wave == 1) { float a = 0.f; for (int j = 0; j < 2; ++j) { const float v = ckv[lane + 64 * j]; a += v * v; } a = wave_sum(a, lane); if (lane == 0) st[1] = 1.0f / sqrtf(a * (1.f / 128.f) + EPS); }
        if (wave == 2) { float a = 0.f; if (lane < 32) { const float v = kr[lane]; a = v * v; } a = wave_sum(a, lane); if (lane == 0) st[2] = 1.0f / sqrtf(a * (1.f / 32.f) + EPS); }
        __syncthreads();
        if (tid < 384) {
            const uint4* w = (const uint4*)(WuqT + (size_t)tid * 256);
            float a = 0.f;
            for (int c = 0; c < 32; ++c) {
                const uint4 u = w[c]; const float* x = cq + c * 8;
                a += x[0] * lo16(u.x) + x[1] * hi16(u.x) + x[2] * lo16(u.y) + x[3] * hi16(u.y) + x[4] * lo16(u.z) + x[5] * hi16(u.z) + x[6] * lo16(u.w) + x[7] * hi16(u.w);
            }
            qf[tid] = a * st[0];
        }
        {
            const uint4* w = (const uint4*)(WukvT + (size_t)tid * 128);
            float a = 0.f;
            for (int c = 0; c < 16; ++c) {
                const uint4 u = w[c]; const float* x = ckv + c * 8;
                a += x[0] * lo16(u.x) + x[1] * hi16(u.x) + x[2] * lo16(u.y) + x[3] * hi16(u.y) + x[4] * lo16(u.z) + x[5] * hi16(u.z) + x[6] * lo16(u.w) + x[7] * hi16(u.w);
            }
            kvf[tid] = a * st[1];
        }
        __syncthreads();
        if (wave < 4) {
            float a = qf[wave * 96 + lane] * qf[wave * 96 + lane];
            if (lane < 32) { const float v = qf[wave * 96 + 64 + lane]; a += v * v; }
            a = wave_sum(a, lane); if (lane == 0) st[4 + wave] = 1.0f / sqrtf(a * (1.f / 96.f) + EPS);
        } else {
            const int h = wave - 4; const float v = kvf[h * 128 + lane]; float a = wave_sum(v * v, lane);
            if (lane == 0) st[8 + h] = 1.0f / sqrtf(a * (1.f / 64.f) + EPS);
        }
        __syncthreads();
        if (tid < 384) {
            const int h = tid / 96, d = tid % 96;
            float v = qf[tid] * st[4 + h] * q_g[d];
            if (d >= 64) {
                const int i = (d - 64) & 15; const bool first = (d - 64) < 16;
                const int pd = first ? d + 16 : d - 16;
                const float pv = qf[h * 96 + pd] * st[4 + h] * q_g[pd];
                const float c = cosA[s * 16 + i], sn = sinA[s * 16 + i];
                v = first ? v * c - pv * sn : v * c + pv * sn;
            }
            Qa[((size_t)h * S + s) * 96 + d] = (bf16_t)f2bf(v * QSCALE_A);
        }
        if (tid < 256) {
            const int h = tid >> 6, d = tid & 63;
            Ka[((size_t)h * S + s) * 96 + d] = (bf16_t)f2bf(kvf[h * 128 + d] * st[8 + h] * kn_g[d]);
        } else {
            const int t2 = tid - 256, h = t2 >> 6, d = t2 & 63;
            Va[((size_t)h * S + s) * 64 + d] = (bf16_t)f2bf(kvf[h * 128 + 64 + d]);
        }
        if (tid < 32) {
            const int i = tid & 15; const bool first = tid < 16; const int pd = first ? tid + 16 : tid - 16;
            const float v = kr[tid] * st[2] * kr_g[tid], pv = kr[pd] * st[2] * kr_g[pd];
            const float c = cosA[s * 16 + i], sn = sinA[s * 16 + i];
            const bf16_t o = (bf16_t)f2bf(first ? v * c - pv * sn : v * c + pv * sn);
            for (int h = 0; h < 4; ++h) Ka[((size_t)h * S + s) * 96 + 64 + tid] = o;
        }
    }
}

__device__ __forceinline__ void post_conv(const Ctx& cx, const Params& p, int l) {
    bf16_t* P = (bf16_t*)(p.ws + OFF_P);
    const float* cw = p.conv_w + l * 3 * 256;
    const int gtid = cx.bid * NT + cx.tid, GT = cx.nb * NT;
    for (int i = gtid; i < S * 256; i += GT) {
        const int t = i >> 8, c = i & 255;
        const bf16_t* row = P + (size_t)t * NP;
        float z0 = bf2f(row[C_CC + c]) * bf2f(row[C_CH + c]);
        float z1 = 0.f, z2 = 0.f;
        if (t >= 1) { const bf16_t* r1 = row - NP; z1 = bf2f(r1[C_CC + c]) * bf2f(r1[C_CH + c]); }
        if (t >= 2) { const bf16_t* r2 = row - 2 * NP; z2 = bf2f(r2[C_CC + c]) * bf2f(r2[C_CH + c]); }
        const float conv = cw[c] * z2 + cw[256 + c] * z1 + cw[512 + c] * z0;
        const float y = bf2f(row[C_CB + c]) * conv * silu(bf2f(row[C_GB + c]));
        P[(size_t)t * NP + C_GB + c] = (bf16_t)f2bf(y);
    }
}

__device__ __forceinline__ void post_sg(const Ctx& cx, const Params& p, int l, float* lds) {
    bf16_t* P = (bf16_t*)(p.ws + OFF_P);
    const bf16_t* SGW = (const bf16_t*)(p.ws + OFF_SGW) + (size_t)l * 4 * 128 * 128;
    const float* lng = p.ln_g + l * 256; const float* lnb = p.ln_b + l * 256; const float* sgb = p.sg_b + l * 4 * 128;
    float (*vn)[65] = (float (*)[65])lds;
    const int tid = cx.tid, r = tid >> 2, q4 = tid & 3, lane = tid & 63;
    for (int it = cx.bid; it < 128 * 4; it += cx.nb) {
        const int ch = it >> 2, g = it & 3;
        const size_t row = (size_t)ch * 128 + r;
        __syncthreads();
        float xv[64];
        {
            const uint4* src = (const uint4*)(P + row * NP + C_SV + q4 * 64);
#pragma unroll
            for (int c = 0; c < 8; ++c) { const uint4 u = src[c]; xv[c * 8 + 0] = lo16(u.x); xv[c * 8 + 1] = hi16(u.x); xv[c * 8 + 2] = lo16(u.y); xv[c * 8 + 3] = hi16(u.y); xv[c * 8 + 4] = lo16(u.z); xv[c * 8 + 5] = hi16(u.z); xv[c * 8 + 6] = lo16(u.w); xv[c * 8 + 7] = hi16(u.w); }
        }
        float sm = 0.f;
#pragma unroll
        for (int c = 0; c < 64; ++c) sm += xv[c];
        sm += shx(sm, 1, lane); sm += shx(sm, 2, lane);
        const float mu = sm * (1.f / 256.f);
        float sq = 0.f;
#pragma unroll
        for (int c = 0; c < 64; ++c) { const float d = xv[c] - mu; sq += d * d; }
        sq += shx(sq, 1, lane); sq += shx(sq, 2, lane);
        const float rs = 1.0f / sqrtf(sq * (1.f / 256.f) + EPS);
        if (q4 == g) {
#pragma unroll
            for (int c = 0; c < 64; ++c) vn[r][c] = (xv[c] - mu) * rs * lng[g * 64 + c] + lnb[g * 64 + c];
        }
        __syncthreads();
        float acc[16];
#pragma unroll
        for (int j = 0; j < 16; ++j) acc[j] = 0.f;
        const bf16_t* wrow = SGW + ((size_t)g * 128 + r) * 128;
        for (int s_ = 0; s_ <= r; ++s_) {
            const float w = bf2f(wrow[s_]);
#pragma unroll
            for (int j = 0; j < 16; ++j) acc[j] = fmaf(w, vn[s_][q4 * 16 + j], acc[j]);
        }
        const float bias = sgb[g * 128 + r];
        bf16_t* prow = P + row * NP;
#pragma unroll
        for (int j = 0; j < 16; ++j) {
            const int c = g * 64 + q4 * 16 + j;
            const float y = bf2f(prow[C_SU + c]) * (acc[j] + bias) * silu(bf2f(prow[C_GC + c]));
            prow[C_GC + c] = (bf16_t)f2bf(y);
        }
    }
}

__device__ __forceinline__ void post_moba(const Ctx& cx, const Params& p, int l, float* lds) {
    bf16_t* P = (bf16_t*)(p.ws + OFF_P);
    float* kmean = (float*)(p.ws + OFF_KMEAN);
    const float* cosD = (const float*)(p.ws + OFF_COSD); const float* sinD = (const float*)(p.ws + OFF_SIND);
    const float* mq_g = p.mq_g + l * 64; const float* mk_g = p.mk_g + l * 64;
    float (*kf)[65] = (float (*)[65])lds;
    const int tid = cx.tid;
    for (int it = cx.bid; it < 64 * 4; it += cx.nb) {
        const int n = it >> 2, h = it & 3;
        const bool isq = tid >= 256; const int r = tid & 255;
        const int srow = n * 256 + r;
        bf16_t* ptr = P + (size_t)srow * NP + (isq ? C_MQ : C_MK) + h * 64;
        const float* gg = isq ? mq_g : mk_g;
        float v[64];
        {
            const uint4* src = (const uint4*)ptr;
#pragma unroll
            for (int c = 0; c < 8; ++c) { const uint4 u = src[c]; v[c * 8 + 0] = lo16(u.x); v[c * 8 + 1] = hi16(u.x); v[c * 8 + 2] = lo16(u.y); v[c * 8 + 3] = hi16(u.y); v[c * 8 + 4] = lo16(u.z); v[c * 8 + 5] = hi16(u.z); v[c * 8 + 6] = lo16(u.w); v[c * 8 + 7] = hi16(u.w); }
        }
        float ss = 0.f;
#pragma unroll
        for (int c = 0; c < 64; ++c) ss += v[c] * v[c];
        const float rs = 1.0f / sqrtf(ss * (1.f / 64.f) + EPS);
#pragma unroll
        for (int c = 0; c < 64; ++c) v[c] = v[c] * rs * gg[c];
#pragma unroll
        for (int i = 0; i < 8; ++i) {
            const float c_ = cosD[srow * 8 + i], s_ = sinD[srow * 8 + i];
            const float a = v[i], b = v[i + 8];
            v[i] = a * c_ - b * s_; v[i + 8] = b * c_ + a * s_;
        }
        __syncthreads();
        if (!isq) {
#pragma unroll
            for (int c = 0; c < 64; ++c) kf[r][c] = v[c];
        }
        const float sc = isq ? QSCALE_D : 1.0f;
        {
            uint4* dst = (uint4*)ptr;
#pragma unroll
            for (int c = 0; c < 8; ++c) dst[c] = make_uint4(pk2(v[c * 8] * sc, v[c * 8 + 1] * sc), pk2(v[c * 8 + 2] * sc, v[c * 8 + 3] * sc), pk2(v[c * 8 + 4] * sc, v[c * 8 + 5] * sc), pk2(v[c * 8 + 6] * sc, v[c * 8 + 7] * sc));
        }
        __syncthreads();
        if (tid < 64) {
            float a = 0.f;
            for (int rr = 0; rr < 256; ++rr) a += kf[rr][tid];
            kmean[((size_t)h * 64 + n) * 64 + tid] = a * (1.f / 256.f);
        }
    }
}

__device__ __forceinline__ void phase_gate(const Ctx& cx, const Params& p, int l) {
    const bf16_t* P = (const bf16_t*)(p.ws + OFF_P);
    const float* kmean = (const float*)(p.ws + OFF_KMEAN);
    int* sel = (int*)(p.ws + OFF_SEL);
    const int gtid = cx.bid * NT + cx.tid, GT = cx.nb * NT;
    for (int i = gtid; i < 4 * S; i += GT) {
        const int h = i / S, s = i % S, qb = s >> 8;
        float q[64];
        {
            const uint4* src = (const uint4*)(P + (size_t)s * NP + C_MQ + h * 64);
#pragma unroll
            for (int c = 0; c < 8; ++c) { const uint4 u = src[c]; q[c * 8 + 0] = lo16(u.x); q[c * 8 + 1] = hi16(u.x); q[c * 8 + 2] = lo16(u.y); q[c * 8 + 3] = hi16(u.y); q[c * 8 + 4] = lo16(u.z); q[c * 8 + 5] = hi16(u.z); q[c * 8 + 6] = lo16(u.w); q[c * 8 + 7] = hi16(u.w); }
        }
        float b0 = -3.0e38f, b1 = -3.0e38f, b2 = -3.0e38f; int i0 = -1, i1 = -1, i2 = -1;
        for (int n = 0; n < qb; ++n) {
            const float* km = kmean + ((size_t)h * 64 + n) * 64;
            float g = 0.f;
#pragma unroll
            for (int c = 0; c < 64; ++c) g = fmaf(q[c], km[c], g);
            if (g > b0) { b2 = b1; i2 = i1; b1 = b0; i1 = i0; b0 = g; i0 = n; }
            else if (g > b1) { b2 = b1; i2 = i1; b1 = g; i1 = n; }
            else if (g > b2) { b2 = g; i2 = n; }
        }
        *(int4*)(sel + (size_t)i * 4) = make_int4(i0, i1, i2, qb < 3 ? qb : 3);
    }
}

__device__ __forceinline__ void attn_mla_naive(const Ctx& cx, const Params& p, int l, float* lds) {
    unsigned char* ws = p.ws;
    bf16_t* P = (bf16_t*)(ws + OFF_P);
    const bf16_t* Qa = (const bf16_t*)(ws + OFF_QA); const bf16_t* Ka = (const bf16_t*)(ws + OFF_KA); const bf16_t* Va = (const bf16_t*)(ws + OFF_VA);
    float (*Ks)[100] = (float (*)[100])lds;
    float (*Vs)[68] = (float (*)[68])(lds + 64 * 100);
    float c2;
    {
        float gq = 0.f, gn = 0.f, gr = 0.f;
        for (int d = 0; d < 96; ++d) gq = fmaxf(gq, fabsf(p.q_g[l * 96 + d]));
        for (int d = 0; d < 64; ++d) gn = fmaxf(gn, fabsf(p.kn_g[l * 64 + d]));
        for (int d = 0; d < 32; ++d) gr = fmaxf(gr, fabsf(p.kr_g[l * 32 + d]));
        c2 = gq * sqrtf(64.f * gn * gn + 32.f * gr * gr) * LOG2E * 1.02f;
    }
    const int tid = cx.tid, qi = tid >> 2, part = tid & 3, lane = tid & 63;
    for (int it = cx.bid; it < 512; it += cx.nb) {
        const int pi = it & 255, sec = it >> 8, h = pi >> 6, j = pi & 63, i = sec ? 127 - j : j;
        const int qrow = i * 128 + qi;
        float q[96];
        {
            const uint4* src = (const uint4*)(Qa + ((size_t)h * S + qrow) * 96);
#pragma unroll
            for (int c = 0; c < 12; ++c) { const uint4 u = src[c]; q[c * 8 + 0] = lo16(u.x); q[c * 8 + 1] = hi16(u.x); q[c * 8 + 2] = lo16(u.y); q[c * 8 + 3] = hi16(u.y); q[c * 8 + 4] = lo16(u.z); q[c * 8 + 5] = hi16(u.z); q[c * 8 + 6] = lo16(u.w); q[c * 8 + 7] = hi16(u.w); }
        }
        float o[64];
#pragma unroll
        for (int d = 0; d < 64; ++d) o[d] = 0.f;
        float lsum = 0.f;
        const int ntiles = 2 * (i + 1);
        for (int kt = 0; kt < ntiles; ++kt) {
            __syncthreads();
            for (int c = tid; c < 768; c += NT) {
                const int key = c / 12, chn = c % 12;
                const uint4 u = *(const uint4*)(Ka + ((size_t)h * S + kt * 64 + key) * 96 + chn * 8);
                float* d_ = &Ks[key][chn * 8];
                d_[0] = lo16(u.x); d_[1] = hi16(u.x); d_[2] = lo16(u.y); d_[3] = hi16(u.y); d_[4] = lo16(u.z); d_[5] = hi16(u.z); d_[6] = lo16(u.w); d_[7] = hi16(u.w);
            }
            {
                const int key = tid >> 3, chn = tid & 7;
                const uint4 u = *(const uint4*)(Va + ((size_t)h * S + kt * 64 + key) * 64 + chn * 8);
                float* d_ = &Vs[key][chn * 8];
                d_[0] = lo16(u.x); d_[1] = hi16(u.x); d_[2] = lo16(u.y); d_[3] = hi16(u.y); d_[4] = lo16(u.z); d_[5] = hi16(u.z); d_[6] = lo16(u.w); d_[7] = hi16(u.w);
            }
            __syncthreads();
            for (int kk = 0; kk < 16; ++kk) {
                const int key = part + 4 * kk, kpos = kt * 64 + key;
                float sc = 0.f;
#pragma unroll
                for (int d = 0; d < 96; d += 4) { const float4 kv = *(const float4*)&Ks[key][d]; sc = fmaf(q[d], kv.x, sc); sc = fmaf(q[d + 1], kv.y, sc); sc = fmaf(q[d + 2], kv.z, sc); sc = fmaf(q[d + 3], kv.w, sc); }
                const float pr = (kpos <= qrow) ? exp2f(sc - c2) : 0.f;
                lsum += pr;
#pragma unroll
                for (int d = 0; d < 64; d += 4) { const float4 vv = *(const float4*)&Vs[key][d]; o[d] = fmaf(pr, vv.x, o[d]); o[d + 1] = fmaf(pr, vv.y, o[d + 1]); o[d + 2] = fmaf(pr, vv.z, o[d + 2]); o[d + 3] = fmaf(pr, vv.w, o[d + 3]); }
            }
        }
        lsum += shx(lsum, 1, lane); lsum += shx(lsum, 2, lane);
        const float inv = 1.0f / lsum;
        bf16_t* prow = P + (size_t)qrow * NP + C_GA + h * 64;
#pragma unroll
        for (int d = 0; d < 64; ++d) {
            float v = o[d]; v += shx(v, 1, lane); v += shx(v, 2, lane);
            if ((d >> 4) == part) { const float g = bf2f(prow[d]); prow[d] = (bf16_t)f2bf(v * inv * silu(g)); }
        }
    }
}

__device__ __forceinline__ void attn_moba_naive(const Ctx& cx, const Params& p, int l) {
    bf16_t* P = (bf16_t*)(p.ws + OFF_P);
    const int* sel = (const int*)(p.ws + OFF_SEL);
    float c2;
    {
        float gq = 0.f, gk = 0.f;
        for (int d = 0; d < 64; ++d) { gq = fmaxf(gq, fabsf(p.mq_g[l * 64 + d])); gk = fmaxf(gk, fabsf(p.mk_g[l * 64 + d])); }
        c2 = gq * gk * 8.0f * LOG2E * 1.02f;
    }
    const int wave = cx.tid >> 6, lane = cx.tid & 63;
    const int gw = cx.bid * (NT / 64) + wave, NGW = cx.nb * (NT / 64);
    for (int it = gw; it < 4 * S; it += NGW) {
        const int h = it / S, s = it % S, own = s >> 8;
        float q[64];
        {
            const uint4* src = (const uint4*)(P + (size_t)s * NP + C_MQ + h * 64);
#pragma unroll
            for (int c = 0; c < 8; ++c) { const uint4 u = src[c]; q[c * 8 + 0] = lo16(u.x); q[c * 8 + 1] = hi16(u.x); q[c * 8 + 2] = lo16(u.y); q[c * 8 + 3] = hi16(u.y); q[c * 8 + 4] = lo16(u.z); q[c * 8 + 5] = hi16(u.z); q[c * 8 + 6] = lo16(u.w); q[c * 8 + 7] = hi16(u.w); }
        }
        const int4 sl = *(const int4*)(sel + (size_t)it * 4);
        float o[64];
#pragma unroll
        for (int d = 0; d < 64; ++d) o[d] = 0.f;
        float lsum = 0.f;
        const int nsel = sl.w;
#pragma unroll 1
        for (int bi = 3 - nsel; bi < 4; ++bi) {
            const int sidx = 2 - bi;
            const int blk = bi == 3 ? own : (sidx == 0 ? sl.x : sidx == 1 ? sl.y : sl.z);
#pragma unroll 1
            for (int jj = 0; jj < 4; ++jj) {
                const int kpos = blk * 256 + lane + 64 * jj;
                const uint4* kp = (const uint4*)(P + (size_t)kpos * NP + C_MK + h * 64);
                float sc = 0.f;
#pragma unroll
                for (int c = 0; c < 8; ++c) { const uint4 u = kp[c]; sc += q[c * 8] * lo16(u.x) + q[c * 8 + 1] * hi16(u.x) + q[c * 8 + 2] * lo16(u.y) + q[c * 8 + 3] * hi16(u.y) + q[c * 8 + 4] * lo16(u.z) + q[c * 8 + 5] * hi16(u.z) + q[c * 8 + 6] * lo16(u.w) + q[c * 8 + 7] * hi16(u.w); }
                const bool ok = (bi != 3) || (kpos <= s);
                const float pr = ok ? exp2f(sc - c2) : 0.f;
                lsum += pr;
                const uint4* vp = (const uint4*)(P + (size_t)kpos * NP + C_MV + h * 64);
#pragma unroll
                for (int c = 0; c < 8; ++c) { const uint4 u = vp[c]; o[c * 8] = fmaf(pr, lo16(u.x), o[c * 8]); o[c * 8 + 1] = fmaf(pr, hi16(u.x), o[c * 8 + 1]); o[c * 8 + 2] = fmaf(pr, lo16(u.y), o[c * 8 + 2]); o[c * 8 + 3] = fmaf(pr, hi16(u.y), o[c * 8 + 3]); o[c * 8 + 4] = fmaf(pr, lo16(u.z), o[c * 8 + 4]); o[c * 8 + 5] = fmaf(pr, hi16(u.z), o[c * 8 + 5]); o[c * 8 + 6] = fmaf(pr, lo16(u.w), o[c * 8 + 6]); o[c * 8 + 7] = fmaf(pr, hi16(u.w), o[c * 8 + 7]); }
            }
        }
        lsum = wave_sum(lsum, lane);
        float r32[32], r16[16], r8[8], r4[4], r2[2];
#pragma unroll
        for (int d = 0; d < 32; ++d) { const bool hb = (lane & 32) != 0; const float keep = hb ? o[d + 32] : o[d], send = hb ? o[d] : o[d + 32]; r32[d] = keep + shx(send, 32, lane); }
#pragma unroll
        for (int d = 0; d < 16; ++d) { const bool hb = (lane & 16) != 0; const float keep = hb ? r32[d + 16] : r32[d], send = hb ? r32[d] : r32[d + 16]; r16[d] = keep + shx(send, 16, lane); }
#pragma unroll
        for (int d = 0; d < 8; ++d) { const bool hb = (lane & 8) != 0; const float keep = hb ? r16[d + 8] : r16[d], send = hb ? r16[d] : r16[d + 8]; r8[d] = keep + shx(send, 8, lane); }
#pragma unroll
        for (int d = 0; d < 4; ++d) { const bool hb = (lane & 4) != 0; const float keep = hb ? r8[d + 4] : r8[d], send = hb ? r8[d] : r8[d + 4]; r4[d] = keep + shx(send, 4, lane); }
#pragma unroll
        for (int d = 0; d < 2; ++d) { const bool hb = (lane & 2) != 0; const float keep = hb ? r4[d + 2] : r4[d], send = hb ? r4[d] : r4[d + 2]; r2[d] = keep + shx(send, 2, lane); }
        float mine;
        { const bool hb = (lane & 1) != 0; const float keep = hb ? r2[1] : r2[0], send = hb ? r2[0] : r2[1]; mine = keep + shx(send, 1, lane); }
        bf16_t* gp = P + (size_t)s * NP + C_GD + h * 64 + lane;
        const float g = bf2f(*gp);
        *gp = (bf16_t)f2bf(mine / lsum * silu(g));
    }
}


namespace mla {
typedef short bf16x8 __attribute__((ext_vector_type(8)));
typedef short s16x4 __attribute__((ext_vector_type(4)));
typedef float f32x16 __attribute__((ext_vector_type(16)));
typedef unsigned u32x4 __attribute__((ext_vector_type(4)));
#define LAS3 __attribute__((address_space(3)))
constexpr int KT_BYTES = 12288, VT_BYTES = 8192, STAGE_BYTES = 2 * KT_BYTES + 2 * VT_BYTES;
constexpr int OFF_OCOMB = 2 * STAGE_BYTES, OFF_LCOMB = OFF_OCOMB + 32768, OFF_WSF = OFF_LCOMB + 512, OFF_OST = OFF_WSF + 512, MLA_LDS_END = OFF_OST + 16384;
static_assert(MLA_LDS_END <= LDS_BYTES, "mla lds");
__device__ __forceinline__ int crow(int r, int hi) { return (r & 3) + 8 * (r >> 2) + 4 * hi; }
__device__ __forceinline__ s16x4 vtr(const LAS3 unsigned char* p) { typedef short v4i16_t __attribute__((ext_vector_type(4))); return __builtin_bit_cast(s16x4, __builtin_amdgcn_ds_read_tr16_b64_v4i16((LAS3 v4i16_t*)p)); }
__device__ __forceinline__ unsigned cvtpk(float lo, float hi) { typedef float f32x2_t __attribute__((ext_vector_type(2))); typedef __bf16 bf16x2_t __attribute__((ext_vector_type(2))); f32x2_t v = {lo, hi}; bf16x2_t b = __builtin_convertvector(v, bf16x2_t); return __builtin_bit_cast(unsigned, b); }

__device__ __forceinline__ void attn_mla_fast(const Ctx& cx, const Params& p, int l, unsigned char* lds_generic) {
    unsigned char* ws = p.ws;
    bf16_t* P = (bf16_t*)(ws + OFF_P);
    const bf16_t* Qa = (const bf16_t*)(ws + OFF_QA); const bf16_t* Ka = (const bf16_t*)(ws + OFF_KA); const bf16_t* Va = (const bf16_t*)(ws + OFF_VA);
    LAS3 unsigned char* lds = (LAS3 unsigned char*)lds_generic;
    float c2;
    {
        float gq = 0.f, gn = 0.f, gr = 0.f;
        for (int d = 0; d < 96; ++d) gq = fmaxf(gq, fabsf(p.q_g[l * 96 + d]));
        for (int d = 0; d < 64; ++d) gn = fmaxf(gn, fabsf(p.kn_g[l * 64 + d]));
        for (int d = 0; d < 32; ++d) gr = fmaxf(gr, fabsf(p.kr_g[l * 32 + d]));
        c2 = gq * sqrtf(64.f * gn * gn + 32.f * gr * gr) * LOG2E * 1.02f;
    }
    const int tid = cx.tid, lane = tid & 63, r32 = lane & 31, hi = lane >> 5;
    const int wave = __builtin_amdgcn_readfirstlane(tid >> 6), grp = wave >> 2, w = wave & 3;
    int kgo[3], klo[3];
#pragma unroll
    for (int j = 0; j < 3; ++j) { const int idx = tid + 512 * j, tile = idx / 768, rem = idx % 768, c = rem >> 6, key = rem & 63; kgo[j] = (tile * 64 + key) * 96 + c * 8; klo[j] = tile * KT_BYTES + c * 1024 + key * 16; }
    const int vkey = tid >> 3, vdc = tid & 7;
    const int vgo = vkey * 64 + vdc * 8, vlo_ = 2 * KT_BYTES + (vdc >> 2) * 4096 + (vkey >> 4) * 1024 + (vkey & 15) * 64 + (vdc & 3) * 16;
    const int kfrag = hi * 1024 + r32 * 16;
    const int vfrag = ((lane >> 4) & 1) * 32 + (lane & 3) * 8 + (4 * hi + ((lane & 15) >> 2)) * 64;
    for (int it = cx.bid; it < 512; it += cx.nb) {
        const int pi = it & 255, sec = it >> 8, h = pi >> 6, jj = pi & 63, i = sec ? 127 - jj : jj;
        const int q0 = i * 128, qrow = q0 + 32 * w + r32, nsteps = i + 1;
        const bf16_t* Kh = Ka + (size_t)h * S * 96; const bf16_t* Vh = Va + (size_t)h * S * 64;
        bf16x8 qr[6];
#pragma unroll
        for (int d0 = 0; d0 < 6; ++d0) qr[d0] = *(const bf16x8*)(Qa + ((size_t)h * S + qrow) * 96 + d0 * 16 + hi * 8);
        f32x16 o0, o1;
#pragma unroll
        for (int r = 0; r < 16; ++r) { o0[r] = 0.f; o1[r] = 0.f; }
        float lsum = 0.f;
        u32x4 kreg[3], vreg[2];
#define MLA_LOADG(st) do { const bf16_t* kb_ = Kh + (size_t)(st) * 128 * 96; const bf16_t* vb_ = Vh + (size_t)(st) * 128 * 64; \
            _Pragma("unroll") for (int j = 0; j < 3; ++j) kreg[j] = *(const u32x4*)(kb_ + kgo[j]); \
            vreg[0] = *(const u32x4*)(vb_ + vgo); vreg[1] = *(const u32x4*)(vb_ + 64 * 64 + vgo); } while (0)
#define MLA_WRITEL(sb) do { LAS3 unsigned char* b_ = lds + (sb) * STAGE_BYTES; \
            _Pragma("unroll") for (int j = 0; j < 3; ++j) *(LAS3 u32x4*)(b_ + klo[j]) = kreg[j]; \
            *(LAS3 u32x4*)(b_ + vlo_) = vreg[0]; *(LAS3 u32x4*)(b_ + vlo_ + VT_BYTES) = vreg[1]; } while (0)
        __syncthreads();
        MLA_LOADG(0); MLA_WRITEL(0);
        __syncthreads();
        for (int s = 0; s < nsteps; ++s) {
            const bool more = (s + 1 < nsteps), last = !more;
            if (more) MLA_LOADG(s + 1);
            const LAS3 unsigned char* Kt = lds + (s & 1) * STAGE_BYTES + grp * KT_BYTES;
            const LAS3 unsigned char* Vt = lds + (s & 1) * STAGE_BYTES + 2 * KT_BYTES + grp * VT_BYTES;
            const bool active = !(last && grp == 1 && w < 2);
            if (active) {
                f32x16 p0, p1;
#pragma unroll
                for (int r = 0; r < 16; ++r) { p0[r] = -c2; p1[r] = -c2; }
#pragma unroll
                for (int d0 = 0; d0 < 6; ++d0) {
                    const bf16x8 a0 = *(const LAS3 bf16x8*)(Kt + kfrag + d0 * 2048);
                    const bf16x8 a1 = *(const LAS3 bf16x8*)(Kt + kfrag + d0 * 2048 + 512);
                    p0 = __builtin_amdgcn_mfma_f32_32x32x16_bf16(a0, qr[d0], p0, 0, 0, 0);
                    p1 = __builtin_amdgcn_mfma_f32_32x32x16_bf16(a1, qr[d0], p1, 0, 0, 0);
                }
                if (last) {
                    const int kbase = s * 128 + grp * 64 + 4 * hi;
#pragma unroll
                    for (int r = 0; r < 16; ++r) { const int kv = kbase + (r & 3) + 8 * (r >> 2); if (kv > qrow) p0[r] = -INFINITY; if (kv + 32 > qrow) p1[r] = -INFINITY; }
                }
                float sacc = 0.f;
#pragma unroll
                for (int r = 0; r < 16; ++r) { p0[r] = __builtin_amdgcn_exp2f(p0[r]); p1[r] = __builtin_amdgcn_exp2f(p1[r]); sacc += p0[r] + p1[r]; }
                lsum += sacc;
                u32x4 pw[4];
                pw[0] = (u32x4){cvtpk(p0[0], p0[1]), cvtpk(p0[2], p0[3]), cvtpk(p0[4], p0[5]), cvtpk(p0[6], p0[7])};
                pw[1] = (u32x4){cvtpk(p0[8], p0[9]), cvtpk(p0[10], p0[11]), cvtpk(p0[12], p0[13]), cvtpk(p0[14], p0[15])};
                pw[2] = (u32x4){cvtpk(p1[0], p1[1]), cvtpk(p1[2], p1[3]), cvtpk(p1[4], p1[5]), cvtpk(p1[6], p1[7])};
                pw[3] = (u32x4){cvtpk(p1[8], p1[9]), cvtpk(p1[10], p1[11]), cvtpk(p1[12], p1[13]), cvtpk(p1[14], p1[15])};
#pragma unroll
                for (int ks = 0; ks < 4; ++ks) {
                    const s16x4 l0 = vtr(Vt + vfrag + ks * 1024), h0 = vtr(Vt + vfrag + ks * 1024 + 512);
                    const s16x4 l1 = vtr(Vt + vfrag + 4096 + ks * 1024), h1 = vtr(Vt + vfrag + 4096 + ks * 1024 + 512);
                    const bf16x8 b0 = (bf16x8){l0[0], l0[1], l0[2], l0[3], h0[0], h0[1], h0[2], h0[3]};
                    const bf16x8 b1 = (bf16x8){l1[0], l1[1], l1[2], l1[3], h1[0], h1[1], h1[2], h1[3]};
                    const bf16x8 pa = __builtin_bit_cast(bf16x8, pw[ks]);
                    o0 = __builtin_amdgcn_mfma_f32_32x32x16_bf16(pa, b0, o0, 0, 0, 0);
                    o1 = __builtin_amdgcn_mfma_f32_32x32x16_bf16(pa, b1, o1, 0, 0, 0);
                }
            }
            if (more) MLA_WRITEL((s + 1) & 1);
            __syncthreads();
        }
#undef MLA_LOADG
#undef MLA_WRITEL
        lsum += shx(lsum, 32, lane);
        LAS3 float* Ocomb = (LAS3 float*)(lds + OFF_OCOMB) + w * 2048;
        LAS3 float* lcomb = (LAS3 float*)(lds + OFF_LCOMB) + w * 32;
        LAS3 float* wsf = (LAS3 float*)(lds + OFF_WSF) + w * 32;
        LAS3 bf16_t* Ost = (LAS3 bf16_t*)(lds + OFF_OST);
        if (grp == 1) {
#pragma unroll
            for (int r = 0; r < 16; ++r) { Ocomb[r * 64 + lane] = o0[r]; Ocomb[1024 + r * 64 + lane] = o1[r]; }
            if (hi == 0) lcomb[r32] = lsum;
        }
        __syncthreads();
        if (grp == 0) {
#pragma unroll
            for (int r = 0; r < 16; ++r) { o0[r] += Ocomb[r * 64 + lane]; o1[r] += Ocomb[1024 + r * 64 + lane]; }
            lsum += lcomb[r32];
            if (hi == 0) wsf[r32] = lsum;
            __builtin_amdgcn_s_waitcnt(0xC07F);
#pragma unroll
            for (int r = 0; r < 16; ++r) {
                const int orow = crow(r, hi); const float rl = 1.0f / wsf[orow];
                Ost[(32 * w + orow) * 64 + r32] = (bf16_t)f2bf(o0[r] * rl);
                Ost[(32 * w + orow) * 64 + 32 + r32] = (bf16_t)f2bf(o1[r] * rl);
            }
        }
        __syncthreads();
#pragma unroll
        for (int j = 0; j < 2; ++j) {
            const int chunk = tid + 512 * j, row = chunk >> 3, dc = chunk & 7;
            const u32x4 ov = *(const LAS3 u32x4*)(Ost + row * 64 + dc * 8);
            bf16_t* gp = P + (size_t)(q0 + row) * NP + C_GA + h * 64 + dc * 8;
            const uint4 gv = *(const uint4*)gp;
            uint4 y;
            y.x = pk2(lo16(ov.x) * silu(lo16(gv.x)), hi16(ov.x) * silu(hi16(gv.x)));
            y.y = pk2(lo16(ov.y) * silu(lo16(gv.y)), hi16(ov.y) * silu(hi16(gv.y)));
            y.z = pk2(lo16(ov.z) * silu(lo16(gv.z)), hi16(ov.z) * silu(hi16(gv.z)));
            y.w = pk2(lo16(ov.w) * silu(lo16(gv.w)), hi16(ov.w) * silu(hi16(gv.w)));
            *(uint4*)gp = y;
        }
    }
}
}

#define AS4 __attribute__((address_space(4)))
__device__ __forceinline__ Params load_params() {
    const AS4 unsigned char* k = (const AS4 unsigned char*)__builtin_amdgcn_kernarg_segment_ptr();
    asm volatile("" : "+s"(k));
    Params q;
#define LDP(field, T) q.field = *(T const AS4*)(k + __builtin_offsetof(Params, field))
    LDP(x, const float*); LDP(pos, const int*); LDP(norm_g, const float*); LDP(w_in, const float*); LDP(qn_g, const float*); LDP(w_uq, const float*);
    LDP(kvn_g, const float*); LDP(w_ukv, const float*); LDP(q_g, const float*); LDP(kn_g, const float*); LDP(kr_g, const float*); LDP(conv_w, const float*);
    LDP(ln_g, const float*); LDP(ln_b, const float*); LDP(sg_w, const float*); LDP(sg_b, const float*); LDP(mq_g, const float*); LDP(mk_g, const float*);
    LDP(w_out, const float*); LDP(out, float*); LDP(ws, unsigned char*);
#undef LDP
    return q;
}
template <int PH> __device__ __forceinline__ void run_phase(int wave_s, int l, float* lds) {
    const Params p = load_params();
    Ctx cx;
    { int w = wave_s; asm volatile("" : "+s"(w)); int ln; asm volatile("v_mbcnt_lo_u32_b32 %0, -1, 0\n\tv_mbcnt_hi_u32_b32 %0, -1, %0" : "=v"(ln)); cx.tid = w * 64 + ln; asm volatile("" : "+v"(cx.tid)); }
    { int b = __builtin_amdgcn_workgroup_id_x(); asm volatile("" : "+s"(b)); cx.bid = b; }
    { int nbk = (int)__builtin_amdgcn_grid_size_x() / NT; asm volatile("" : "+s"(nbk)); cx.nb = nbk; }
    unsigned char* ws = p.ws;
    if (PH == 0) phase_prep(cx, p, lds);
    if (PH == 1) {
        pg8::Gemm g{(const bf16_t*)(ws + OFF_XB), (const bf16_t*)(ws + OFF_WINT) + (size_t)l * NP * DM, S, NP, DM, DM};
        pg8::StaticOrder So; So.init(S, NP, cx.nb, cx.bid);
        pg8::EpiInP E{(bf16_t*)(ws + OFF_P), (const float*)(ws + OFF_RSTD), NP};
        pg8::gemm_phase<pg8::EpiInP, pg8::StaticOrder, pg8::AOffId, true, true>(cx, (PG8_LAS unsigned char*)lds, g, So, E, pg8::AOffId{});
    }
    if (PH == 2) { post_mla(cx, p, l, lds); post_conv(cx, p, l); post_sg(cx, p, l, lds); post_moba(cx, p, l, lds); }
    if (PH == 3) phase_gate(cx, p, l);
    if (PH == 4) { mla::attn_mla_fast(cx, p, l, (unsigned char*)lds); attn_moba_naive(cx, p, l); }
    if (PH == 5) {
        pg8::Gemm g{(const bf16_t*)(ws + OFF_P), (const bf16_t*)(ws + OFF_WOUTT) + (size_t)l * DM * DM, S, DM, DM, NP};
        pg8::StaticOrder So; So.init(S, DM, cx.nb, cx.bid);
        pg8::EpiOutP E{l == 0 ? p.x : p.out, p.out, DM};
        pg8::gemm_phase<pg8::EpiOutP, pg8::StaticOrder, pg8::AOffY, false, true>(cx, (PG8_LAS unsigned char*)lds, g, So, E, pg8::AOffY{});
    }
    if (PH == 6) rows_prep(cx, p.out, (bf16_t*)(ws + OFF_XB), (float*)(ws + OFF_RSTD));
}

__global__ void __launch_bounds__(NT) mega_kernel(Params p) {
    extern __shared__ __attribute__((aligned(16))) unsigned char lds_raw[];
    float* lds = (float*)lds_raw;
    cg::grid_group grid = cg::this_grid();
    const int wave_s = __builtin_amdgcn_readfirstlane((int)(threadIdx.x >> 6));
    run_phase<0>(wave_s, 0, lds); grid.sync();
    run_phase<1>(wave_s, 0, lds); grid.sync();
    run_phase<2>(wave_s, 0, lds); grid.sync();
    run_phase<3>(wave_s, 0, lds); grid.sync();
    run_phase<4>(wave_s, 0, lds); grid.sync();
    run_phase<5>(wave_s, 0, lds); grid.sync();
    run_phase<6>(wave_s, 0, lds); grid.sync();
    run_phase<1>(wave_s, 1, lds); grid.sync();
    run_phase<2>(wave_s, 1, lds); grid.sync();
    run_phase<3>(wave_s, 1, lds); grid.sync();
    run_phase<4>(wave_s, 1, lds); grid.sync();
    run_phase<5>(wave_s, 1, lds);
}

extern "C" void kernel_launch(void* const* d_in, const int* in_sizes, int n_in, void* d_out, int out_size, void* d_ws, size_t ws_size, hipStream_t stream) {
    static int grid_blocks = 0;
    if (grid_blocks == 0) {
        int dev = 0, cus = 0, per_cu = 0;
        hipGetDevice(&dev);
        hipDeviceGetAttribute(&cus, hipDeviceAttributeMultiprocessorCount, dev);
        hipFuncSetAttribute((const void*)mega_kernel, hipFuncAttributeMaxDynamicSharedMemorySize, LDS_BYTES);
        hipOccupancyMaxActiveBlocksPerMultiprocessor(&per_cu, (const void*)mega_kernel, NT, LDS_BYTES);
        if (per_cu < 1) { fprintf(stderr, "occupancy query returned %d\n", per_cu); per_cu = 1; }
        if (per_cu > 1) per_cu = 1;
        grid_blocks = cus * per_cu;
        if (ws_size < OFF_END) { fprintf(stderr, "workspace too small: %zu < %zu\n", ws_size, (size_t)OFF_END); grid_blocks = -1; }
    }
    if (grid_blocks < 0) return;
    Params p{};
    p.x = (const float*)d_in[0]; p.pos = (const int*)d_in[1]; p.norm_g = (const float*)d_in[2]; p.w_in = (const float*)d_in[3];
    p.qn_g = (const float*)d_in[4]; p.w_uq = (const float*)d_in[5]; p.kvn_g = (const float*)d_in[6]; p.w_ukv = (const float*)d_in[7];
    p.q_g = (const float*)d_in[8]; p.kn_g = (const float*)d_in[9]; p.kr_g = (const float*)d_in[10]; p.conv_w = (const float*)d_in[11];
    p.ln_g = (const float*)d_in[12]; p.ln_b = (const float*)d_in[13]; p.sg_w = (const float*)d_in[14]; p.sg_b = (const float*)d_in[15];
    p.mq_g = (const float*)d_in[16]; p.mk_g = (const float*)d_in[17]; p.w_out = (const float*)d_in[18];
    p.out = (float*)d_out; p.ws = (unsigned char*)d_ws;
    void* args[] = {&p};
    hipError_t e = hipLaunchCooperativeKernel((const void*)mega_kernel, dim3(grid_blocks), dim3(NT), args, LDS_BYTES, stream);
    if (e != hipSuccess) fprintf(stderr, "cooperative launch failed: %s (grid %d)\n", hipGetErrorString(e), grid_blocks);
}
```

```cpp
#include <hip/hip_runtime.h>
#include <hip/hip_cooperative_groups.h>
#include <stdint.h>
#include <cstdio>
namespace cg = cooperative_groups;

constexpr int S = 16384, DM = 1024, NP = 3584, DEPTH = 2, DIN = 3488;
constexpr int NT = 512;
constexpr float EPS = 1e-6f;
constexpr float LOG2E = 1.4426950408889634f;
constexpr int C_CQ = 0, C_CKV = 256, C_KR = 384, C_GA = 512, C_CH = 768, C_CB = 1024, C_CC = 1280, C_GB = 1536,
              C_SU = 1792, C_SV = 2048, C_GC = 2304, C_MQ = 2560, C_MK = 2816, C_MV = 3072, C_GD = 3328;

typedef unsigned short bf16_t;
struct Ctx { int tid, bid, nb; };
__device__ __forceinline__ float bf2f(bf16_t v) { return __uint_as_float(((unsigned)v) << 16); }
__device__ __forceinline__ unsigned f2bf(float f) { unsigned u = __float_as_uint(f); return (u + 0x7fffu + ((u >> 16) & 1u)) >> 16; }
__device__ __forceinline__ unsigned pk2(float lo, float hi) { return f2bf(lo) | (f2bf(hi) << 16); }
__device__ __forceinline__ float lo16(unsigned u) { return __uint_as_float(u << 16); }
__device__ __forceinline__ float hi16(unsigned u) { return __uint_as_float(u & 0xffff0000u); }
__device__ __forceinline__ float shx(float v, int k, int lane) { return __builtin_bit_cast(float, __builtin_amdgcn_ds_bpermute((lane ^ k) << 2, __builtin_bit_cast(int, v))); }
__device__ __forceinline__ float wave_sum(float v, int lane) {
#pragma unroll
    for (int o = 1; o < 64; o <<= 1) v += shx(v, o, lane);
    return v;
}
__device__ __forceinline__ float silu(float g) { return g / (1.f + __expf(-g)); }

constexpr size_t al256(size_t x) { return (x + 255) & ~(size_t)255; }
constexpr size_t OFF_CTRL = 0;
constexpr size_t OFF_WINT = 65536;
constexpr size_t OFF_WOUTT = OFF_WINT + (size_t)DEPTH * NP * DM * 2;
constexpr size_t OFF_WUQT = OFF_WOUTT + (size_t)DEPTH * DM * DM * 2;
constexpr size_t OFF_WUKVT = OFF_WUQT + (size_t)DEPTH * 384 * 256 * 2;
constexpr size_t OFF_SGW = OFF_WUKVT + (size_t)DEPTH * 512 * 128 * 2;
constexpr size_t OFF_COSA = OFF_SGW + (size_t)DEPTH * 4 * 128 * 128 * 2;
constexpr size_t OFF_SINA = OFF_COSA + (size_t)S * 16 * 4;
constexpr size_t OFF_COSD = OFF_SINA + (size_t)S * 16 * 4;
constexpr size_t OFF_SIND = OFF_COSD + (size_t)S * 8 * 4;
constexpr size_t OFF_RSTD = OFF_SIND + (size_t)S * 8 * 4;
constexpr size_t OFF_KMEAN = OFF_RSTD + (size_t)S * 4;
constexpr size_t OFF_SEL = OFF_KMEAN + (size_t)4 * 64 * 64 * 4;
constexpr size_t OFF_XB = OFF_SEL + (size_t)4 * S * 4 * 4;
constexpr size_t OFF_P = OFF_XB + (size_t)S * DM * 2;
constexpr size_t OFF_QA = OFF_P + (size_t)S * NP * 2;
constexpr size_t OFF_KA = OFF_QA + (size_t)4 * S * 96 * 2;
constexpr size_t OFF_VA = OFF_KA + (size_t)4 * S * 96 * 2;
constexpr size_t OFF_LIST = OFF_VA + (size_t)4 * S * 64 * 2;
constexpr int LIST_PER_HEAD = 256 * 2016;
constexpr size_t OFF_LPART = OFF_LIST + (size_t)4 * LIST_PER_HEAD * 4;
constexpr size_t OFF_END = OFF_LPART + (size_t)4 * S * 3 * 4;
constexpr size_t OFF_PART = OFF_XB;
constexpr size_t OFF_MCNT = 2048;
static_assert((size_t)4 * S * 3 * 64 * 2 <= (size_t)S * DM * 2, "partials must fit in Xb");
static_assert(OFF_END <= 268435456, "workspace map exceeds 256 MiB");
static_assert((OFF_XB % 256) == 0 && (OFF_P % 256) == 0 && (OFF_QA % 256) == 0, "alignment");

constexpr int LDS_BYTES = 147456;

struct Params {
    const float* x; const int* pos; const float* norm_g; const float* w_in; const float* qn_g; const float* w_uq;
    const float* kvn_g; const float* w_ukv; const float* q_g; const float* kn_g; const float* kr_g; const float* conv_w;
    const float* ln_g; const float* ln_b; const float* sg_w; const float* sg_b; const float* mq_g; const float* mk_g;
    const float* w_out; float* out; unsigned char* ws;
};

namespace pg8 {
#define PG8_LAS __attribute__((address_space(3)))
typedef unsigned short bf16_t;
typedef short bf16x8 __attribute__((ext_vector_type(8)));
typedef float f32x4 __attribute__((ext_vector_type(4)));
typedef unsigned u32x4 __attribute__((ext_vector_type(4)));
constexpr int BM = 256, BK = 64, HALF = 128, HTB = HALF * BK * 2  , STAGE_BYTES = 8 * HTB, NXCD = 8, WGM = 8;

__host__ __device__ __forceinline__ int lds_byte(int r, int c) { const int st = (r >> 4) * 2 + (c >> 5), rr = r & 15, cc = c & 31, ob = rr * 64 + cc * 2; return st * 1024 + (ob ^ (((ob >> 9) & 1) << 5)); }
__host__ __device__ __forceinline__ void stage_rc(int b, int& R, int& C) { const int st = b / 1024, sb = b % 1024, swz = sb ^ (((sb >> 9) & 1) << 5); R = (st >> 1) * 16 + swz / 64; C = (st & 1) * 32 + (swz % 64) / 2; }
__host__ __device__ __forceinline__ int perm32(int rho) { const int n = rho >> 4, i = rho & 15; return 8 * (i >> 2) + 4 * n + (i & 3); }

struct Unit { int pm, pn; };
struct Gemm { const bf16_t* A; const bf16_t* Bt; int M, N, K, lda; };

struct StaticOrder {
    int nM, nN, nwg, G, c;
    __host__ __device__ void init(int M, int N, int G_, int c_) { nM = M / BM; nN = N / BM; nwg = nM * nN; G = G_; c = c_; }
    __host__ __device__ bool next(int i, Unit& u) const {
        const long L = (long)i * G + c; if (L >= nwg) return false;
        int wgid = (int)L; { const int q = nwg / NXCD, r = nwg % NXCD, xcd = wgid % NXCD, off = wgid / NXCD; wgid = (xcd < r ? xcd * (q + 1) : r * (q + 1) + (xcd - r) * q) + off; }
        const int nig = WGM * nN, gid = wgid / nig, fm = gid * WGM, gsz = (nM - fm) < WGM ? (nM - fm) : WGM;
        u.pm = fm + ((wgid % nig) % gsz); u.pn = (wgid % nig) / gsz; return true;
    }
    __device__ __forceinline__ void a_ready(const Unit&) const {}
    __device__ __forceinline__ void done(const Unit&) const {}
};


template <class Epi, class Sched, class AOff, bool ALIGN_EPI = false, bool SP2 = false>
__device__ __forceinline__ void gemm_phase(const Ctx& cx, PG8_LAS unsigned char* lds, const Gemm g, const Sched& S, const Epi& E, const AOff& AO) {
    const int tid = cx.tid, wid = __builtin_amdgcn_readfirstlane(tid >> 6), lane = tid & 63, wr = wid >> 2, wc = wid & 3, fr = lane & 15, fq = lane >> 4;
    const int K = g.K, nt = K / BK;
    unsigned voffA[2], voffB[2];
#pragma unroll
    for (int i = 0; i < 2; ++i) { int R, C; stage_rc(tid * 16 + i * 8192, R, C); const int Rb = Epi::PERM ? ((R & ~31) + perm32(R & 31)) : R;
        voffA[i] = (unsigned)(R * g.lda + C) * 2u; voffB[i] = (unsigned)(Rb * K + C) * 2u; }
    const size_t kstep = (size_t)(BK * 2);
    const size_t hstepB = (size_t)HALF * K * 2, hstepA = (size_t)HALF * g.lda * 2;
    const size_t tstepB = 2 * hstepB, tstepA = 2 * hstepA;
    const unsigned ldsw = (unsigned)wid * 1024u;
    const int aoff = lds_byte(wr * 64 + fr, fq * 8), boff = lds_byte(wc * 32 + fr, fq * 8);
#define PG8_SA(b, h) (((b) * 2 + (h)) * HTB)
#define PG8_SB(b, h) ((4 + (b) * 2 + (h)) * HTB)
#define PG8_STAGE(bufoff, gbase, voff) do { _Pragma("unroll") for (int _i = 0; _i < 2; ++_i) \
        __builtin_amdgcn_global_load_lds((const unsigned*)((const char*)(gbase) + (voff)[_i]), (PG8_LAS unsigned*)(lds + (bufoff) + ldsw + _i * 8192), 16, 0, 0); } while (0)
#define PG8_LDA(dst, b, h) do { _Pragma("unroll") for (int m = 0; m < 4; ++m) _Pragma("unroll") for (int k = 0; k < 2; ++k) dst[m][k] = *(const PG8_LAS bf16x8*)(lds + PG8_SA(b, h) + aoff + m * 2048 + k * 1024); } while (0)
#define PG8_LDB(dst, b, h) do { _Pragma("unroll") for (int n = 0; n < 2; ++n) _Pragma("unroll") for (int k = 0; k < 2; ++k) dst[n][k] = *(const PG8_LAS bf16x8*)(lds + PG8_SB(b, h) + boff + n * 2048 + k * 1024); } while (0)
#define PG8_MMA(ai, bj, At, Bt) do { __builtin_amdgcn_s_setprio(1); _Pragma("unroll") for (int m = 0; m < 4; ++m) _Pragma("unroll") for (int n = 0; n < 2; ++n) _Pragma("unroll") for (int k = 0; k < 2; ++k) \
        acc[ai][bj][m][n] = __builtin_amdgcn_mfma_f32_16x16x32_bf16(Bt[n][k], At[m][k], acc[ai][bj][m][n], 0, 0, 0); __builtin_amdgcn_s_setprio(0); } while (0)
#define PG8_WAIT_V(n) asm volatile("s_waitcnt vmcnt(" #n ")" ::: "memory")
#define PG8_WAIT_L(n) asm volatile("s_waitcnt lgkmcnt(" #n ")" ::: "memory")
#define PG8_BAR __builtin_amdgcn_s_barrier()
#define PG8_SCHED __builtin_amdgcn_sched_barrier(0)
    Unit cur, nxt; int ui = 0;
    if (!S.next(0, cur)) return;
    f32x4 acc[2][2][4][2];
#pragma unroll
    for (int a = 0; a < 2; ++a)
#pragma unroll
        for (int b = 0; b < 2; ++b)
#pragma unroll
            for (int m = 0; m < 4; ++m)
#pragma unroll
                for (int n = 0; n < 2; ++n) acc[a][b][m][n] = (f32x4){0.f, 0.f, 0.f, 0.f};
    bf16x8 At[4][2], B0[2][2], B1[2][2];
    const char* cA = (const char*)g.A + (size_t)cur.pm * tstepA; const char* cB = (const char*)g.Bt + (size_t)cur.pn * tstepB;
    S.a_ready(cur);
    if constexpr (SP2) {
        PG8_STAGE(PG8_SB(0, 0), cB, voffB); PG8_STAGE(PG8_SB(0, 1), cB + hstepB, voffB); PG8_STAGE(PG8_SA(0, 0), cA + AO(0), voffA); PG8_STAGE(PG8_SA(0, 1), cA + AO(0) + hstepA, voffA);
        if (wr == 1) PG8_BAR;
        PG8_WAIT_V(2); PG8_BAR;
        PG8_STAGE(PG8_SB(1, 0), cB + kstep, voffB); PG8_STAGE(PG8_SA(1, 0), cA + AO(1), voffA); PG8_STAGE(PG8_SB(1, 1), cB + hstepB + kstep, voffB);
        PG8_WAIT_V(6); PG8_BAR;
    } else {
        PG8_STAGE(PG8_SB(0, 0), cB, voffB); PG8_STAGE(PG8_SA(0, 0), cA + AO(0), voffA); PG8_STAGE(PG8_SB(0, 1), cB + hstepB, voffB); PG8_STAGE(PG8_SA(0, 1), cA + AO(0) + hstepA, voffA);
        if (wr == 1) PG8_BAR;
        PG8_WAIT_V(4); PG8_BAR;
        PG8_STAGE(PG8_SB(1, 0), cB + kstep, voffB); PG8_STAGE(PG8_SA(1, 0), cA + AO(1), voffA); PG8_STAGE(PG8_SB(1, 1), cB + hstepB + kstep, voffB);
        PG8_WAIT_V(6); PG8_BAR;
    }
    for (;;) {
        const bool has_next = S.next(ui + 1, nxt);
        const char* nA = has_next ? (const char*)g.A + (size_t)nxt.pm * tstepA : cA; const char* nB = has_next ? (const char*)g.Bt + (size_t)nxt.pn * tstepB : cB;
        for (int t = 0; t < nt; t += 2) {
            const bool last = (t == nt - 2);
            const char* a1 = cA + AO(t + 1);
            const char* a2 = last ? nA + AO(0) : cA + AO(t + 2); const char* b2 = last ? nB : cB + (size_t)(t + 2) * kstep;
            const char* a3 = last ? nA + AO(1) : cA + AO(t + 3); const char* b3 = b2 + kstep;
            if (last && has_next) S.a_ready(nxt);
            if constexpr (SP2) {
            PG8_LDB(B0, 0, 0); PG8_LDB(B1, 0, 1); PG8_SCHED; PG8_LDA(At, 0, 0); PG8_STAGE(PG8_SA(1, 1), a1 + hstepA, voffA);
            PG8_WAIT_V(8); PG8_WAIT_L(0); PG8_BAR; PG8_MMA(0, 0, At, B0); PG8_MMA(0, 1, At, B1); PG8_BAR; PG8_SCHED;
            PG8_LDA(At, 0, 1); PG8_STAGE(PG8_SB(0, 0), b2, voffB); PG8_STAGE(PG8_SB(0, 1), b2 + hstepB, voffB); PG8_STAGE(PG8_SA(0, 0), a2, voffA);
            PG8_WAIT_V(8); PG8_WAIT_L(0); PG8_BAR; PG8_MMA(1, 0, At, B0); PG8_MMA(1, 1, At, B1); PG8_BAR; PG8_SCHED;
            PG8_LDB(B0, 1, 0); PG8_LDB(B1, 1, 1); PG8_SCHED; PG8_LDA(At, 1, 0); PG8_STAGE(PG8_SA(0, 1), a2 + hstepA, voffA);
            PG8_WAIT_V(8); PG8_WAIT_L(0); PG8_BAR; PG8_MMA(0, 0, At, B0); PG8_MMA(0, 1, At, B1); PG8_BAR; PG8_SCHED;
            PG8_LDA(At, 1, 1); PG8_STAGE(PG8_SB(1, 0), b3, voffB); PG8_STAGE(PG8_SB(1, 1), b3 + hstepB, voffB); PG8_STAGE(PG8_SA(1, 0), a3, voffA);
            PG8_WAIT_V(8); PG8_WAIT_L(0); PG8_BAR; PG8_MMA(1, 0, At, B0); PG8_MMA(1, 1, At, B1); PG8_BAR; PG8_SCHED;
            } else {
            PG8_LDB(B0, 0, 0); PG8_SCHED; PG8_LDA(At, 0, 0); PG8_STAGE(PG8_SA(1, 1), a1 + hstepA, voffA);
            PG8_WAIT_L(8); PG8_BAR; PG8_WAIT_L(0); PG8_MMA(0, 0, At, B0); PG8_BAR; PG8_SCHED;
            PG8_LDB(B1, 0, 1); PG8_STAGE(PG8_SB(0, 0), b2, voffB);
            PG8_BAR; PG8_WAIT_L(0); PG8_MMA(0, 1, At, B1); PG8_BAR;
            PG8_LDA(At, 0, 1); PG8_STAGE(PG8_SA(0, 0), a2, voffA);
            PG8_BAR; PG8_WAIT_L(0); PG8_MMA(1, 0, At, B0); PG8_BAR; PG8_SCHED;
            PG8_STAGE(PG8_SB(0, 1), b2 + hstepB, voffB);
            PG8_WAIT_V(6); PG8_BAR; PG8_MMA(1, 1, At, B1); PG8_BAR;
            PG8_LDB(B0, 1, 0); PG8_SCHED; PG8_LDA(At, 1, 0); PG8_STAGE(PG8_SA(0, 1), a2 + hstepA, voffA);
            PG8_WAIT_L(8); PG8_BAR; PG8_WAIT_L(0); PG8_MMA(0, 0, At, B0); PG8_BAR; PG8_SCHED;
            PG8_LDB(B1, 1, 1); PG8_STAGE(PG8_SB(1, 0), b3, voffB);
            PG8_BAR; PG8_WAIT_L(0); PG8_MMA(0, 1, At, B1); PG8_BAR;
            PG8_LDA(At, 1, 1); PG8_STAGE(PG8_SA(1, 0), a3, voffA);
            PG8_BAR; PG8_WAIT_L(0); PG8_MMA(1, 0, At, B0); PG8_BAR; PG8_SCHED;
            PG8_STAGE(PG8_SB(1, 1), b3 + hstepB, voffB);
            PG8_WAIT_V(6); PG8_BAR; PG8_MMA(1, 1, At, B1); PG8_BAR;
            }
        }
        if constexpr (ALIGN_EPI) { if (wr == 0) PG8_BAR; }
        if constexpr (!Epi::AFTER_DRAIN) { E(acc, cur, wr, wc, fr, fq); S.done(cur); }
        if (!has_next) break;
#pragma unroll
        for (int a = 0; a < 2; ++a)
#pragma unroll
            for (int b = 0; b < 2; ++b)
#pragma unroll
                for (int m = 0; m < 4; ++m)
#pragma unroll
                    for (int n = 0; n < 2; ++n) acc[a][b][m][n] = (f32x4){0.f, 0.f, 0.f, 0.f};
        cur = nxt; cA = nA; cB = nB; ++ui;
        if constexpr (ALIGN_EPI) { if (wr == 1) PG8_BAR; }
    }
    PG8_WAIT_V(0);
    if constexpr (!ALIGN_EPI) { if (wr == 0) PG8_BAR; }
    PG8_BAR;
    if constexpr (Epi::AFTER_DRAIN) { E.fused(acc, cur, wr, wc, fr, fq, lds, wid, lane); S.done(cur); }
#undef PG8_SA
#undef PG8_SB
#undef PG8_STAGE
#undef PG8_LDA
#undef PG8_LDB
#undef PG8_MMA
#undef PG8_WAIT_V
#undef PG8_WAIT_L
#undef PG8_BAR
#undef PG8_SCHED
}

__device__ __forceinline__ unsigned cvt_pk_bf16(float lo, float hi) { unsigned r; asm volatile("v_cvt_pk_bf16_f32 %0, %1, %2" : "=v"(r) : "v"(lo), "v"(hi)); return r; }
struct AOffId { __device__ __forceinline__ size_t operator()(int t) const { return (size_t)t * (BK * 2); } };
struct AOffY {
    __device__ __forceinline__ size_t operator()(int t) const { const int g = t >> 2; const int base = g == 0 ? 512 : g == 1 ? 1536 : g == 2 ? 2304 : 3328; return (size_t)(base + (t & 3) * 64) * 2; }
};
struct EpiInP {
    static constexpr bool PERM = true, AFTER_DRAIN = false;
    bf16_t* P; const float* rstd; int ldp;
    __device__ __forceinline__ void operator()(const f32x4 (&acc)[2][2][4][2], const Unit& u, int wr, int wc, int fr, int fq) const {
        const int row0 = u.pm * BM + wr * 64 + fr, col0 = u.pn * BM + wc * 32 + 8 * fq;
#pragma unroll
        for (int ai = 0; ai < 2; ++ai)
#pragma unroll
            for (int m = 0; m < 4; ++m) { const int row = row0 + ai * HALF + m * 16; const float r = rstd[row]; bf16_t* rowp = P + (size_t)row * ldp + col0;
#pragma unroll
                for (int bj = 0; bj < 2; ++bj) { const f32x4 v0 = acc[ai][bj][m][0] * r, v1 = acc[ai][bj][m][1] * r;
                    u32x4 w; w.x = cvt_pk_bf16(v0[0], v0[1]); w.y = cvt_pk_bf16(v0[2], v0[3]); w.z = cvt_pk_bf16(v1[0], v1[1]); w.w = cvt_pk_bf16(v1[2], v1[3]);
                    *(u32x4*)(rowp + bj * HALF) = w; } }
    }
};
struct EpiOutP {
    static constexpr bool PERM = false, AFTER_DRAIN = false;
    const float* xin; float* out; int ldc;
    __device__ __forceinline__ void operator()(const f32x4 (&acc)[2][2][4][2], const Unit& u, int wr, int wc, int fr, int fq) const {
        const int col0 = u.pn * BM + wc * 32 + 4 * fq;
#pragma unroll
        for (int ai = 0; ai < 2; ++ai)
#pragma unroll
            for (int m = 0; m < 4; ++m) { const size_t off = (size_t)(u.pm * BM + ai * HALF + wr * 64 + m * 16 + fr) * ldc + col0;
#pragma unroll
                for (int bj = 0; bj < 2; ++bj)
#pragma unroll
                    for (int n = 0; n < 2; ++n) { const f32x4 xi = *(const f32x4*)(xin + off + bj * HALF + n * 16); *(f32x4*)(out + off + bj * HALF + n * 16) = xi + acc[ai][bj][m][n]; } }
    }
};
}

__device__ __forceinline__ void transpose_tiles(const Ctx& cx, const float* __restrict__ src, int K, int Nsrc, const float* __restrict__ gk,
                                bf16_t* __restrict__ dst, int Ndst, int gap_at, int gap_len, float* lds) {
    float (*t)[33] = (float (*)[33])lds;
    const int tid = cx.tid, a = tid >> 5, b = tid & 31;
    const int tilesN = Ndst / 32, tilesK = K / 32;
    for (int tile = cx.bid; tile < tilesN * tilesK; tile += cx.nb) {
        const int tn = tile % tilesN, tk = tile / tilesN, n0 = tn * 32, k0 = tk * 32;
        __syncthreads();
#pragma unroll
        for (int i = 0; i < 2; ++i) {
            const int kk = a + 16 * i, np = n0 + b;
            const bool z = (np >= gap_at && np < gap_at + gap_len);
            const int n = np < gap_at ? np : np - gap_len;
            float v = z ? 0.f : src[(size_t)(k0 + kk) * Nsrc + n];
            if (gk) v *= gk[k0 + kk];
            t[kk][b] = v;
        }
        __syncthreads();
#pragma unroll
        for (int i = 0; i < 2; ++i) {
            const int nn = a + 16 * i;
            dst[(size_t)(n0 + nn) * K + k0 + b] = (bf16_t)f2bf(t[b][nn]);
        }
    }
}

__device__ __forceinline__ void rows_prep(const Ctx& cx, const float* __restrict__ xsrc, bf16_t* __restrict__ Xb, float* __restrict__ rstd) {
    const int wave = cx.tid >> 6, lane = cx.tid & 63;
    const int gw = cx.bid * (NT / 64) + wave, NGW = cx.nb * (NT / 64);
    for (int m = gw; m < S; m += NGW) {
        const float4* xr = (const float4*)(xsrc + (size_t)m * DM) + lane;
        float4 v[4]; float s = 0.f;
#pragma unroll
        for (int j = 0; j < 4; ++j) { v[j] = xr[64 * j]; s += (v[j].x * v[j].x + v[j].y * v[j].y) + (v[j].z * v[j].z + v[j].w * v[j].w); }
        s = wave_sum(s, lane);
        const float r = 1.0f / sqrtf(s * (1.0f / DM) + EPS);
        if (lane == 0) rstd[m] = r;
        uint2* o = (uint2*)(Xb + (size_t)m * DM) + lane;
#pragma unroll
        for (int j = 0; j < 4; ++j) o[64 * j] = make_uint2(pk2(v[j].x, v[j].y), pk2(v[j].z, v[j].w));
    }
}

__device__ __forceinline__ void phase_prep(const Ctx& cx, const Params& p, float* lds) {
    unsigned char* ws = p.ws;
    for (int l = 0; l < DEPTH; ++l) {
        transpose_tiles(cx, p.w_in + (size_t)l * DM * DIN, DM, DIN, p.norm_g + l * DM, (bf16_t*)(ws + OFF_WINT) + (size_t)l * NP * DM, NP, 416, 96, lds);
        transpose_tiles(cx, p.w_out + (size_t)l * DM * DM, DM, DM, nullptr, (bf16_t*)(ws + OFF_WOUTT) + (size_t)l * DM * DM, DM, DM, 0, lds);
        transpose_tiles(cx, p.w_uq + (size_t)l * 256 * 384, 256, 384, p.qn_g + l * 256, (bf16_t*)(ws + OFF_WUQT) + (size_t)l * 384 * 256, 384, 384, 0, lds);
        transpose_tiles(cx, p.w_ukv + (size_t)l * 128 * 512, 128, 512, p.kvn_g + l * 128, (bf16_t*)(ws + OFF_WUKVT) + (size_t)l * 512 * 128, 512, 512, 0, lds);
    }
    const int gtid = cx.bid * NT + cx.tid, GT = cx.nb * NT;
    {
        bf16_t* sgw = (bf16_t*)(ws + OFF_SGW);
        for (int i = gtid; i < DEPTH * 4 * 128 * 128; i += GT) {
            const int s_ = i & 127, t_ = (i >> 7) & 127;
            sgw[i] = (bf16_t)f2bf(s_ <= t_ ? p.sg_w[i] : 0.f);
        }
    }
    {
        float* cosA = (float*)(ws + OFF_COSA); float* sinA = (float*)(ws + OFF_SINA);
        float* cosD = (float*)(ws + OFF_COSD); float* sinD = (float*)(ws + OFF_SIND);
        for (int i = gtid; i < S * 24; i += GT) {
            const int s_ = i / 24, j = i % 24;
            const float posf = (float)p.pos[s_];
            float inv;
            if (j < 16) inv = powf(500000.0f, -((float)j * 2.0f / 32.0f));
            else inv = powf(500000.0f, -((float)(j - 16) * 2.0f / 16.0f));
            const float ang = posf * inv;
            const double a = (double)ang;
            const double r = a - rint(a * 0.15915494309189535) * 6.283185307179586;
            const float c = (float)cos(r), sn = (float)sin(r);
            if (j < 16) { cosA[s_ * 16 + j] = c; sinA[s_ * 16 + j] = sn; }
            else { cosD[s_ * 8 + (j - 16)] = c; sinD[s_ * 8 + (j - 16)] = sn; }
        }
    }
    rows_prep(cx, p.x, (bf16_t*)(ws + OFF_XB), (float*)(ws + OFF_RSTD));
}

struct AMapId { __device__ __forceinline__ int operator()(int k0) const { return k0; } };
struct AMapY {
    __device__ __forceinline__ int operator()(int k0) const { const int g = k0 >> 8; const int base = g == 0 ? C_GA : g == 1 ? C_GB : g == 2 ? C_GC : C_GD; return base + (k0 & 255); }
};
template <class AMap, class Epi>
__device__ __forceinline__ void gemm_naive(const Ctx& cx, const bf16_t* __restrict__ A, int lda, AMap amap, const bf16_t* __restrict__ Bt, int K, int M, int N, Epi epi, float* lds) {
    float (*As)[132] = (float (*)[132])lds;
    float (*Bs)[132] = (float (*)[132])(lds + 16 * 132);
    const int tid = cx.tid, ty = tid >> 5, tx = tid & 31;
    const int lr = tid >> 2, lk = (tid & 3) * 4;
    const int ntm = M / 128, ntn = N / 128;
    for (int tile = cx.bid; tile < ntm * ntn; tile += cx.nb) {
        const int tm = tile / ntn, tn = tile % ntn;
        float acc[8][4];
#pragma unroll
        for (int i = 0; i < 8; ++i)
#pragma unroll
            for (int j = 0; j < 4; ++j) acc[i][j] = 0.f;
        for (int k0 = 0; k0 < K; k0 += 16) {
            const uint2 av = *(const uint2*)(A + (size_t)(tm * 128 + lr) * lda + amap(k0) + lk);
            const uint2 bv = *(const uint2*)(Bt + (size_t)(tn * 128 + lr) * K + k0 + lk);
            __syncthreads();
            As[lk + 0][lr] = lo16(av.x); As[lk + 1][lr] = hi16(av.x); As[lk + 2][lr] = lo16(av.y); As[lk + 3][lr] = hi16(av.y);
            Bs[lk + 0][lr] = lo16(bv.x); Bs[lk + 1][lr] = hi16(bv.x); Bs[lk + 2][lr] = lo16(bv.y); Bs[lk + 3][lr] = hi16(bv.y);
            __syncthreads();
#pragma unroll
            for (int kk = 0; kk < 16; ++kk) {
                const float4 a0 = *(const float4*)&As[kk][ty * 8], a1 = *(const float4*)&As[kk][ty * 8 + 4];
                const float4 b = *(const float4*)&Bs[kk][tx * 4];
                const float a[8] = {a0.x, a0.y, a0.z, a0.w, a1.x, a1.y, a1.z, a1.w};
                const float bb[4] = {b.x, b.y, b.z, b.w};
#pragma unroll
                for (int i = 0; i < 8; ++i)
#pragma unroll
                    for (int j = 0; j < 4; ++j) acc[i][j] = fmaf(a[i], bb[j], acc[i][j]);
            }
        }
#pragma unroll
        for (int i = 0; i < 8; ++i) epi(tm * 128 + ty * 8 + i, tn * 128 + tx * 4, acc[i]);
    }
}
struct EpiIn {
    bf16_t* P; const float* rstd;
    __device__ __forceinline__ void operator()(int m, int n, const float (&v)[4]) const {
        const float r = rstd[m];
        *(uint2*)(P + (size_t)m * NP + n) = make_uint2(pk2(v[0] * r, v[1] * r), pk2(v[2] * r, v[3] * r));
    }
};
struct EpiOut {
    const float* xin; float* out;
    __device__ __forceinline__ void operator()(int m, int n, const float (&v)[4]) const {
        const float4 xi = *(const float4*)(xin + (size_t)m * DM + n);
        *(float4*)(out + (size_t)m * DM + n) = make_float4(xi.x + v[0], xi.y + v[1], xi.z + v[2], xi.w + v[3]);
    }
};

constexpr float QSCALE_A = 0.10206207261596577f * LOG2E;
constexpr float QSCALE_D = 0.125f * LOG2E;

__device__ __forceinline__ void post_mla(const Ctx& cx, const Params& p, int l, float* lds) {
    unsigned char* ws = p.ws;
    const bf16_t* P = (const bf16_t*)(ws + OFF_P);
    const bf16_t* WuqT = (const bf16_t*)(ws + OFF_WUQT) + (size_t)l * 384 * 256;
    const bf16_t* WukvT = (const bf16_t*)(ws + OFF_WUKVT) + (size_t)l * 512 * 128;
    bf16_t* Qa = (bf16_t*)(ws + OFF_QA); bf16_t* Ka = (bf16_t*)(ws + OFF_KA); bf16_t* Va = (bf16_t*)(ws + OFF_VA);
    const float* cosA = (const float*)(ws + OFF_COSA); const float* sinA = (const float*)(ws + OFF_SINA);
    const float* q_g = p.q_g + l * 96; const float* kn_g = p.kn_g + l * 64; const float* kr_g = p.kr_g + l * 32;
    float* cq = lds;
    float* ckv = lds + 256;
    float* kr = lds + 384;
    float* qf = lds + 416;
    float* kvf = lds + 800;
    float* st = lds + 1312;
    const int tid = cx.tid, wave = tid >> 6, lane = tid & 63;
    for (int s = cx.bid; s < S; s += cx.nb) {
        __syncthreads();
        if (tid < 416) lds[tid] = bf2f(P[(size_t)s * NP + tid]);
        __syncthreads();
        if (wave == 0) { float a = 0.f; for (int j = 0; j < 4; ++j) { const float v = cq[lane + 64 * j]; a += v * v; } a = wave_sum(a, lane); if (lane == 0) st[0] = 1.0f / sqrtf(a * (1.f / 256.f) + EPS); }
        if (wave == 1) { float a = 0.f; for (int j = 0; j < 2; ++j) { const float v = ckv[lane + 64 * j]; a += v * v; } a = wave_sum(a, lane); if (lane == 0) st[1] = 1.0f / sqrtf(a * (1.f / 128.f) + EPS); }
        if (wave == 2) { float a = 0.f; if (lane < 32) { const float v = kr[lane]; a = v * v; } a = wave_sum(a, lane); if (lane == 0) st[2] = 1.0f / sqrtf(a * (1.f / 32.f) + EPS); }
        __syncthreads();
        if (tid < 384) {
            const uint4* w = (const uint4*)(WuqT + (size_t)tid * 256);
            float a = 0.f;
            for (int c = 0; c < 32; ++c) {
                const uint4 u = w[c]; const float* x = cq + c * 8;
                a += x[0] * lo16(u.x) + x[1] * hi16(u.x) + x[2] * lo16(u.y) + x[3] * hi16(u.y) + x[4] * lo16(u.z) + x[5] * hi16(u.z) + x[6] * lo16(u.w) + x[7] * hi16(u.w);
            }
            qf[tid] = a * st[0];
        }
        {
            const uint4* w = (const uint4*)(WukvT + (size_t)tid * 128);
            float a = 0.f;
            for (int c = 0; c < 16; ++c) {
                const uint4 u = w[c]; const float* x = ckv + c * 8;
                a += x[0] * lo16(u.x) + x[1] * hi16(u.x) + x[2] * lo16(u.y) + x[3] * hi16(u.y) + x[4] * lo16(u.z) + x[5] * hi16(u.z) + x[6] * lo16(u.w) + x[7] * hi16(u.w);
            }
            kvf[tid] = a * st[1];
        }
        __syncthreads();
        if (wave < 4) {
            float a = qf[wave * 96 + lane] * qf[wave * 96 + lane];
            if (lane < 32) { const float v = qf[wave * 96 + 64 + lane]; a += v * v; }
            a = wave_sum(a, lane); if (lane == 0) st[4 + wave] = 1.0f / sqrtf(a * (1.f / 96.f) + EPS);
        } else {
            const int h = wave - 4; const float v = kvf[h * 128 + lane]; float a = wave_sum(v * v, lane);
            if (lane == 0) st[8 + h] = 1.0f / sqrtf(a * (1.f / 64.f) + EPS);
        }
        __syncthreads();
        if (tid < 384) {
            const int h = tid / 96, d = tid % 96;
            float v = qf[tid] * st[4 + h] * q_g[d];
            if (d >= 64) {
                const int i = (d - 64) & 15; const bool first = (d - 64) < 16;
                const int pd = first ? d + 16 : d - 16;
                const float pv = qf[h * 96 + pd] * st[4 + h] * q_g[pd];
                const float c = cosA[s * 16 + i], sn = sinA[s * 16 + i];
                v = first ? v * c - pv * sn : v * c + pv * sn;
            }
            Qa[((size_t)h * S + s) * 96 + d] = (bf16_t)f2bf(v * QSCALE_A);
        }
        if (tid < 256) {
            const int h = tid >> 6, d = tid & 63;
            Ka[((size_t)h * S + s) * 96 + d] = (bf16_t)f2bf(kvf[h * 128 + d] * st[8 + h] * kn_g[d]);
        } else {
            const int t2 = tid - 256, h = t2 >> 6, d = t2 & 63;
            Va[((size_t)h * S + s) * 64 + d] = (bf16_t)f2bf(kvf[h * 128 + 64 + d]);
        }
        if (tid < 32) {
            const int i = tid & 15; const bool first = tid < 16; const int pd = first ? tid + 16 : tid - 16;
            const float v = kr[tid] * st[2] * kr_g[tid], pv = kr[pd] * st[2] * kr_g[pd];
            const float c = cosA[s * 16 + i], sn = sinA[s * 16 + i];
            const bf16_t o = (bf16_t)f2bf(first ? v * c - pv * sn : v * c + pv * sn);
            for (int h = 0; h < 4; ++h) Ka[((size_t)h * S + s) * 96 + 64 + tid] = o;
        }
    }
}

__device__ __forceinline__ void post_conv(const Ctx& cx, const Params& p, int l) {
    bf16_t* P = (bf16_t*)(p.ws + OFF_P);
    const float* cw = p.conv_w + l * 3 * 256;
    const int gtid = cx.bid * NT + cx.tid, GT = cx.nb * NT;
    for (int i = gtid; i < S * 256; i += GT) {
        const int t = i >> 8, c = i & 255;
        const bf16_t* row = P + (size_t)t * NP;
        float z0 = bf2f(row[C_CC + c]) * bf2f(row[C_CH + c]);
        float z1 = 0.f, z2 = 0.f;
        if (t >= 1) { const bf16_t* r1 = row - NP; z1 = bf2f(r1[C_CC + c]) * bf2f(r1[C_CH + c]); }
        if (t >= 2) { const bf16_t* r2 = row - 2 * NP; z2 = bf2f(r2[C_CC + c]) * bf2f(r2[C_CH + c]); }
        const float conv = cw[c] * z2 + cw[256 + c] * z1 + cw[512 + c] * z0;
        const float y = bf2f(row[C_CB + c]) * conv * silu(bf2f(row[C_GB + c]));
        P[(size_t)t * NP + C_GB + c] = (bf16_t)f2bf(y);
    }
}

__device__ __forceinline__ void post_sg(const Ctx& cx, const Params& p, int l, float* lds) {
    bf16_t* P = (bf16_t*)(p.ws + OFF_P);
    const bf16_t* SGW = (const bf16_t*)(p.ws + OFF_SGW) + (size_t)l * 4 * 128 * 128;
    const float* lng = p.ln_g + l * 256; const float* lnb = p.ln_b + l * 256; const float* sgb = p.sg_b + l * 4 * 128;
    float (*vn)[65] = (float (*)[65])lds;
    const int tid = cx.tid, r = tid >> 2, q4 = tid & 3, lane = tid & 63;
    for (int it = cx.bid; it < 128 * 4; it += cx.nb) {
        const int ch = it >> 2, g = it & 3;
        const size_t row = (size_t)ch * 128 + r;
        __syncthreads();
        float xv[64];
        {
            const uint4* src = (const uint4*)(P + row * NP + C_SV + q4 * 64);
#pragma unroll
            for (int c = 0; c < 8; ++c) { const uint4 u = src[c]; xv[c * 8 + 0] = lo16(u.x); xv[c * 8 + 1] = hi16(u.x); xv[c * 8 + 2] = lo16(u.y); xv[c * 8 + 3] = hi16(u.y); xv[c * 8 + 4] = lo16(u.z); xv[c * 8 + 5] = hi16(u.z); xv[c * 8 + 6] = lo16(u.w); xv[c * 8 + 7] = hi16(u.w); }
        }
        float sm = 0.f;
#pragma unroll
        for (int c = 0; c < 64; ++c) sm += xv[c];
        sm += shx(sm, 1, lane); sm += shx(sm, 2, lane);
        const float mu = sm * (1.f / 256.f);
        float sq = 0.f;
#pragma unroll
        for (int c = 0; c < 64; ++c) { const float d = xv[c] - mu; sq += d * d; }
        sq += shx(sq, 1, lane); sq += shx(sq, 2, lane);
        const float rs = 1.0f / sqrtf(sq * (1.f / 256.f) + EPS);
        if (q4 == g) {
#pragma unroll
            for (int c = 0; c < 64; ++c) vn[r][c] = (xv[c] - mu) * rs * lng[g * 64 + c] + lnb[g * 64 + c];
        }
        __syncthreads();
        float acc[16];
#pragma unroll
        for (int j = 0; j < 16; ++j) acc[j] = 0.f;
        const bf16_t* wrow = SGW + ((size_t)g * 128 + r) * 128;
        for (int s_ = 0; s_ <= r; ++s_) {
            const float w = bf2f(wrow[s_]);
#pragma unroll
            for (int j = 0; j < 16; ++j) acc[j] = fmaf(w, vn[s_][q4 * 16 + j], acc[j]);
        }
        const float bias = sgb[g * 128 + r];
        bf16_t* prow = P + row * NP;
#pragma unroll
        for (int j = 0; j < 16; ++j) {
            const int c = g * 64 + q4 * 16 + j;
            const float y = bf2f(prow[C_SU + c]) * (acc[j] + bias) * silu(bf2f(prow[C_GC + c]));
            prow[C_GC + c] = (bf16_t)f2bf(y);
        }
    }
}

__device__ __forceinline__ void post_moba(const Ctx& cx, const Params& p, int l, float* lds) {
    bf16_t* P = (bf16_t*)(p.ws + OFF_P);
    float* kmean = (float*)(p.ws + OFF_KMEAN);
    const float* cosD = (const float*)(p.ws + OFF_COSD); const float* sinD = (const float*)(p.ws + OFF_SIND);
    const float* mq_g = p.mq_g + l * 64; const float* mk_g = p.mk_g + l * 64;
    float (*kf)[65] = (float (*)[65])lds;
    const int tid = cx.tid;
    for (int it = cx.bid; it < 64 * 4; it += cx.nb) {
        const int n = it >> 2, h = it & 3;
        const bool isq = tid >= 256; const int r = tid & 255;
        const int srow = n * 256 + r;
        bf16_t* ptr = P + (size_t)srow * NP + (isq ? C_MQ : C_MK) + h * 64;
        const float* gg = isq ? mq_g : mk_g;
        float v[64];
        {
            const uint4* src = (const uint4*)ptr;
#pragma unroll
            for (int c = 0; c < 8; ++c) { const uint4 u = src[c]; v[c * 8 + 0] = lo16(u.x); v[c * 8 + 1] = hi16(u.x); v[c * 8 + 2] = lo16(u.y); v[c * 8 + 3] = hi16(u.y); v[c * 8 + 4] = lo16(u.z); v[c * 8 + 5] = hi16(u.z); v[c * 8 + 6] = lo16(u.w); v[c * 8 + 7] = hi16(u.w); }
        }
        float ss = 0.f;
#pragma unroll
        for (int c = 0; c < 64; ++c) ss += v[c] * v[c];
        const float rs = 1.0f / sqrtf(ss * (1.f / 64.f) + EPS);
#pragma unroll
        for (int c = 0; c < 64; ++c) v[c] = v[c] * rs * gg[c];
#pragma unroll
        for (int i = 0; i < 8; ++i) {
            const float c_ = cosD[srow * 8 + i], s_ = sinD[srow * 8 + i];
            const float a = v[i], b = v[i + 8];
            v[i] = a * c_ - b * s_; v[i + 8] = b * c_ + a * s_;
        }
        __syncthreads();
        if (!isq) {
#pragma unroll
            for (int c = 0; c < 64; ++c) kf[r][c] = v[c];
        }
        const float sc = isq ? QSCALE_D : 1.0f;
        {
            uint4* dst = (uint4*)ptr;
#pragma unroll
            for (int c = 0; c < 8; ++c) dst[c] = make_uint4(pk2(v[c * 8] * sc, v[c * 8 + 1] * sc), pk2(v[c * 8 + 2] * sc, v[c * 8 + 3] * sc), pk2(v[c * 8 + 4] * sc, v[c * 8 + 5] * sc), pk2(v[c * 8 + 6] * sc, v[c * 8 + 7] * sc));
        }
        __syncthreads();
        if (tid < 64) {
            float a = 0.f;
            for (int rr = 0; rr < 256; ++rr) a += kf[rr][tid];
            kmean[((size_t)h * 64 + n) * 64 + tid] = a * (1.f / 256.f);
        }
    }
}

__device__ __forceinline__ void phase_gate(const Ctx& cx, const Params& p, int l) {
    const bf16_t* P = (const bf16_t*)(p.ws + OFF_P);
    const float* kmean = (const float*)(p.ws + OFF_KMEAN);
    int* sel = (int*)(p.ws + OFF_SEL); int* mcnt = (int*)(p.ws + OFF_MCNT); int* mlist = (int*)(p.ws + OFF_LIST);
    const int gtid = cx.bid * NT + cx.tid, GT = cx.nb * NT;
    for (int i = gtid; i < 4 * S; i += GT) {
        const int h = i / S, s = i % S, qb = s >> 8;
        float q[64];
        {
            const uint4* src = (const uint4*)(P + (size_t)s * NP + C_MQ + h * 64);
#pragma unroll
            for (int c = 0; c < 8; ++c) { const uint4 u = src[c]; q[c * 8 + 0] = lo16(u.x); q[c * 8 + 1] = hi16(u.x); q[c * 8 + 2] = lo16(u.y); q[c * 8 + 3] = hi16(u.y); q[c * 8 + 4] = lo16(u.z); q[c * 8 + 5] = hi16(u.z); q[c * 8 + 6] = lo16(u.w); q[c * 8 + 7] = hi16(u.w); }
        }
        float b0 = -3.0e38f, b1 = -3.0e38f, b2 = -3.0e38f; int i0 = -1, i1 = -1, i2 = -1;
        for (int n = 0; n < qb; ++n) {
            const float* km = kmean + ((size_t)h * 64 + n) * 64;
            float g = 0.f;
#pragma unroll
            for (int c = 0; c < 64; ++c) g = fmaf(q[c], km[c], g);
            if (g > b0) { b2 = b1; i2 = i1; b1 = b0; i1 = i0; b0 = g; i0 = n; }
            else if (g > b1) { b2 = b1; i2 = i1; b1 = g; i1 = n; }
            else if (g > b2) { b2 = g; i2 = n; }
        }
        const int nv = qb < 3 ? qb : 3;
        *(int4*)(sel + (size_t)i * 4) = make_int4(i0, i1, i2, nv);
        const int lane = cx.tid & 63;
#pragma unroll 1
        for (int j = 0; j < 3; ++j) {
            const int n = j == 0 ? i0 : j == 1 ? i1 : i2; const bool valid = j < nv;
            unsigned long long todo = __ballot(valid);
            while (todo) {
                const int leader = __builtin_ctzll(todo);
                const int n0 = __builtin_amdgcn_readlane(n, leader);
                const bool mine = valid && n == n0;
                const unsigned long long m = __ballot(mine);
                const int rank = __builtin_popcountll(m & ((1ull << lane) - 1ull));
                int base = 0;
                if (lane == leader) base = atomicAdd(mcnt + h * 64 + n0, __builtin_popcountll(m));
                base = __builtin_amdgcn_readlane(base, leader);
                if (mine) mlist[(size_t)h * LIST_PER_HEAD + 256 * (63 * n0 - n0 * (n0 - 1) / 2) + base + rank] = (s << 2) | j;
                todo &= ~m;
            }
        }
    }
}

__device__ __forceinline__ void attn_mla_naive(const Ctx& cx, const Params& p, int l, float* lds) {
    unsigned char* ws = p.ws;
    bf16_t* P = (bf16_t*)(ws + OFF_P);
    const bf16_t* Qa = (const bf16_t*)(ws + OFF_QA); const bf16_t* Ka = (const bf16_t*)(ws + OFF_KA); const bf16_t* Va = (const bf16_t*)(ws + OFF_VA);
    float (*Ks)[100] = (float (*)[100])lds;
    float (*Vs)[68] = (float (*)[68])(lds + 64 * 100);
    float c2;
    {
        float gq = 0.f, gn = 0.f, gr = 0.f;
        for (int d = 0; d < 96; ++d) gq = fmaxf(gq, fabsf(p.q_g[l * 96 + d]));
        for (int d = 0; d < 64; ++d) gn = fmaxf(gn, fabsf(p.kn_g[l * 64 + d]));
        for (int d = 0; d < 32; ++d) gr = fmaxf(gr, fabsf(p.kr_g[l * 32 + d]));
        c2 = gq * sqrtf(64.f * gn * gn + 32.f * gr * gr) * LOG2E * 1.02f;
    }
    const int tid = cx.tid, qi = tid >> 2, part = tid & 3, lane = tid & 63;
    for (int it = cx.bid; it < 512; it += cx.nb) {
        const int pi = it & 255, sec = it >> 8, h = pi >> 6, j = pi & 63, i = sec ? 127 - j : j;
        const int qrow = i * 128 + qi;
        float q[96];
        {
            const uint4* src = (const uint4*)(Qa + ((size_t)h * S + qrow) * 96);
#pragma unroll
            for (int c = 0; c < 12; ++c) { const uint4 u = src[c]; q[c * 8 + 0] = lo16(u.x); q[c * 8 + 1] = hi16(u.x); q[c * 8 + 2] = lo16(u.y); q[c * 8 + 3] = hi16(u.y); q[c * 8 + 4] = lo16(u.z); q[c * 8 + 5] = hi16(u.z); q[c * 8 + 6] = lo16(u.w); q[c * 8 + 7] = hi16(u.w); }
        }
        float o[64];
#pragma unroll
        for (int d = 0; d < 64; ++d) o[d] = 0.f;
        float lsum = 0.f;
        const int ntiles = 2 * (i + 1);
        for (int kt = 0; kt < ntiles; ++kt) {
            __syncthreads();
            for (int c = tid; c < 768; c += NT) {
                const int key = c / 12, chn = c % 12;
                const uint4 u = *(const uint4*)(Ka + ((size_t)h * S + kt * 64 + key) * 96 + chn * 8);
                float* d_ = &Ks[key][chn * 8];
                d_[0] = lo16(u.x); d_[1] = hi16(u.x); d_[2] = lo16(u.y); d_[3] = hi16(u.y); d_[4] = lo16(u.z); d_[5] = hi16(u.z); d_[6] = lo16(u.w); d_[7] = hi16(u.w);
            }
            {
                const int key = tid >> 3, chn = tid & 7;
                const uint4 u = *(const uint4*)(Va + ((size_t)h * S + kt * 64 + key) * 64 + chn * 8);
                float* d_ = &Vs[key][chn * 8];
                d_[0] = lo16(u.x); d_[1] = hi16(u.x); d_[2] = lo16(u.y); d_[3] = hi16(u.y); d_[4] = lo16(u.z); d_[5] = hi16(u.z); d_[6] = lo16(u.w); d_[7] = hi16(u.w);
            }
            __syncthreads();
            for (int kk = 0; kk < 16; ++kk) {
                const int key = part + 4 * kk, kpos = kt * 64 + key;
                float sc = 0.f;
#pragma unroll
                for (int d = 0; d < 96; d += 4) { const float4 kv = *(const float4*)&Ks[key][d]; sc = fmaf(q[d], kv.x, sc); sc = fmaf(q[d + 1], kv.y, sc); sc = fmaf(q[d + 2], kv.z, sc); sc = fmaf(q[d + 3], kv.w, sc); }
                const float pr = (kpos <= qrow) ? exp2f(sc - c2) : 0.f;
                lsum += pr;
#pragma unroll
                for (int d = 0; d < 64; d += 4) { const float4 vv = *(const float4*)&Vs[key][d]; o[d] = fmaf(pr, vv.x, o[d]); o[d + 1] = fmaf(pr, vv.y, o[d + 1]); o[d + 2] = fmaf(pr, vv.z, o[d + 2]); o[d + 3] = fmaf(pr, vv.w, o[d + 3]); }
            }
        }
        lsum += shx(lsum, 1, lane); lsum += shx(lsum, 2, lane);
        const float inv = 1.0f / lsum;
        bf16_t* prow = P + (size_t)qrow * NP + C_GA + h * 64;
#pragma unroll
        for (int d = 0; d < 64; ++d) {
            float v = o[d]; v += shx(v, 1, lane); v += shx(v, 2, lane);
            if ((d >> 4) == part) { const float g = bf2f(prow[d]); prow[d] = (bf16_t)f2bf(v * inv * silu(g)); }
        }
    }
}

__device__ __forceinline__ void attn_moba_naive(const Ctx& cx, const Params& p, int l) {
    bf16_t* P = (bf16_t*)(p.ws + OFF_P);
    const int* sel = (const int*)(p.ws + OFF_SEL);
    float c2;
    {
        float gq = 0.f, gk = 0.f;
        for (int d = 0; d < 64; ++d) { gq = fmaxf(gq, fabsf(p.mq_g[l * 64 + d])); gk = fmaxf(gk, fabsf(p.mk_g[l * 64 + d])); }
        c2 = gq * gk * 8.0f * LOG2E * 1.02f;
    }
    const int wave = cx.tid >> 6, lane = cx.tid & 63;
    const int gw = cx.bid * (NT / 64) + wave, NGW = cx.nb * (NT / 64);
    for (int it = gw; it < 4 * S; it += NGW) {
        const int h = it / S, s = it % S, own = s >> 8;
        float q[64];
        {
            const uint4* src = (const uint4*)(P + (size_t)s * NP + C_MQ + h * 64);
#pragma unroll
            for (int c = 0; c < 8; ++c) { const uint4 u = src[c]; q[c * 8 + 0] = lo16(u.x); q[c * 8 + 1] = hi16(u.x); q[c * 8 + 2] = lo16(u.y); q[c * 8 + 3] = hi16(u.y); q[c * 8 + 4] = lo16(u.z); q[c * 8 + 5] = hi16(u.z); q[c * 8 + 6] = lo16(u.w); q[c * 8 + 7] = hi16(u.w); }
        }
        const int4 sl = *(const int4*)(sel + (size_t)it * 4);
        float o[64];
#pragma unroll
        for (int d = 0; d < 64; ++d) o[d] = 0.f;
        float lsum = 0.f;
        const int nsel = sl.w;
#pragma unroll 1
        for (int bi = 3 - nsel; bi < 4; ++bi) {
            const int sidx = 2 - bi;
            const int blk = bi == 3 ? own : (sidx == 0 ? sl.x : sidx == 1 ? sl.y : sl.z);
#pragma unroll 1
            for (int jj = 0; jj < 4; ++jj) {
                const int kpos = blk * 256 + lane + 64 * jj;
                const uint4* kp = (const uint4*)(P + (size_t)kpos * NP + C_MK + h * 64);
                float sc = 0.f;
#pragma unroll
                for (int c = 0; c < 8; ++c) { const uint4 u = kp[c]; sc += q[c * 8] * lo16(u.x) + q[c * 8 + 1] * hi16(u.x) + q[c * 8 + 2] * lo16(u.y) + q[c * 8 + 3] * hi16(u.y) + q[c * 8 + 4] * lo16(u.z) + q[c * 8 + 5] * hi16(u.z) + q[c * 8 + 6] * lo16(u.w) + q[c * 8 + 7] * hi16(u.w); }
                const bool ok = (bi != 3) || (kpos <= s);
                const float pr = ok ? exp2f(sc - c2) : 0.f;
                lsum += pr;
                const uint4* vp = (const uint4*)(P + (size_t)kpos * NP + C_MV + h * 64);
#pragma unroll
                for (int c = 0; c < 8; ++c) { const uint4 u = vp[c]; o[c * 8] = fmaf(pr, lo16(u.x), o[c * 8]); o[c * 8 + 1] = fmaf(pr, hi16(u.x), o[c * 8 + 1]); o[c * 8 + 2] = fmaf(pr, lo16(u.y), o[c * 8 + 2]); o[c * 8 + 3] = fmaf(pr, hi16(u.y), o[c * 8 + 3]); o[c * 8 + 4] = fmaf(pr, lo16(u.z), o[c * 8 + 4]); o[c * 8 + 5] = fmaf(pr, hi16(u.z), o[c * 8 + 5]); o[c * 8 + 6] = fmaf(pr, lo16(u.w), o[c * 8 + 6]); o[c * 8 + 7] = fmaf(pr, hi16(u.w), o[c * 8 + 7]); }
            }
        }
        lsum = wave_sum(lsum, lane);
        float r32[32], r16[16], r8[8], r4[4], r2[2];
#pragma unroll
        for (int d = 0; d < 32; ++d) { const bool hb = (lane & 32) != 0; const float keep = hb ? o[d + 32] : o[d], send = hb ? o[d] : o[d + 32]; r32[d] = keep + shx(send, 32, lane); }
#pragma unroll
        for (int d = 0; d < 16; ++d) { const bool hb = (lane & 16) != 0; const float keep = hb ? r32[d + 16] : r32[d], send = hb ? r32[d] : r32[d + 16]; r16[d] = keep + shx(send, 16, lane); }
#pragma unroll
        for (int d = 0; d < 8; ++d) { const bool hb = (lane & 8) != 0; const float keep = hb ? r16[d + 8] : r16[d], send = hb ? r16[d] : r16[d + 8]; r8[d] = keep + shx(send, 8, lane); }
#pragma unroll
        for (int d = 0; d < 4; ++d) { const bool hb = (lane & 4) != 0; const float keep = hb ? r8[d + 4] : r8[d], send = hb ? r8[d] : r8[d + 4]; r4[d] = keep + shx(send, 4, lane); }
#pragma unroll
        for (int d = 0; d < 2; ++d) { const bool hb = (lane & 2) != 0; const float keep = hb ? r4[d + 2] : r4[d], send = hb ? r4[d] : r4[d + 2]; r2[d] = keep + shx(send, 2, lane); }
        float mine;
        { const bool hb = (lane & 1) != 0; const float keep = hb ? r2[1] : r2[0], send = hb ? r2[0] : r2[1]; mine = keep + shx(send, 1, lane); }
        bf16_t* gp = P + (size_t)s * NP + C_GD + h * 64 + lane;
        const float g = bf2f(*gp);
        *gp = (bf16_t)f2bf(mine / lsum * silu(g));
    }
}


namespace mla {
typedef short bf16x8 __attribute__((ext_vector_type(8)));
typedef short s16x4 __attribute__((ext_vector_type(4)));
typedef float f32x16 __attribute__((ext_vector_type(16)));
typedef unsigned u32x4 __attribute__((ext_vector_type(4)));
#define LAS3 __attribute__((address_space(3)))
constexpr int KT_BYTES = 12288, VT_BYTES = 8192, STAGE_BYTES = 2 * KT_BYTES + 2 * VT_BYTES;
constexpr int OFF_OCOMB = 2 * STAGE_BYTES, OFF_LCOMB = OFF_OCOMB + 32768, OFF_WSF = OFF_LCOMB + 512, OFF_OST = OFF_WSF + 512, MLA_LDS_END = OFF_OST + 16384;
static_assert(MLA_LDS_END <= LDS_BYTES, "mla lds");
__device__ __forceinline__ int crow(int r, int hi) { return (r & 3) + 8 * (r >> 2) + 4 * hi; }
__device__ __forceinline__ s16x4 vtr(const LAS3 unsigned char* p) { typedef short v4i16_t __attribute__((ext_vector_type(4))); return __builtin_bit_cast(s16x4, __builtin_amdgcn_ds_read_tr16_b64_v4i16((LAS3 v4i16_t*)p)); }
__device__ __forceinline__ unsigned cvtpk(float lo, float hi) { typedef float f32x2_t __attribute__((ext_vector_type(2))); typedef __bf16 bf16x2_t __attribute__((ext_vector_type(2))); f32x2_t v = {lo, hi}; bf16x2_t b = __builtin_convertvector(v, bf16x2_t); return __builtin_bit_cast(unsigned, b); }

__device__ __forceinline__ void attn_mla_fast(const Ctx& cx, const Params& p, int l, unsigned char* lds_generic) {
    unsigned char* ws = p.ws;
    bf16_t* P = (bf16_t*)(ws + OFF_P);
    const bf16_t* Qa = (const bf16_t*)(ws + OFF_QA); const bf16_t* Ka = (const bf16_t*)(ws + OFF_KA); const bf16_t* Va = (const bf16_t*)(ws + OFF_VA);
    LAS3 unsigned char* lds = (LAS3 unsigned char*)lds_generic;
    float c2;
    {
        float gq = 0.f, gn = 0.f, gr = 0.f;
        for (int d = 0; d < 96; ++d) gq = fmaxf(gq, fabsf(p.q_g[l * 96 + d]));
        for (int d = 0; d < 64; ++d) gn = fmaxf(gn, fabsf(p.kn_g[l * 64 + d]));
        for (int d = 0; d < 32; ++d) gr = fmaxf(gr, fabsf(p.kr_g[l * 32 + d]));
        c2 = gq * sqrtf(64.f * gn * gn + 32.f * gr * gr) * LOG2E * 1.02f;
    }
    const int tid = cx.tid, lane = tid & 63, r32 = lane & 31, hi = lane >> 5;
    const int wave = __builtin_amdgcn_readfirstlane(tid >> 6), grp = wave >> 2, w = wave & 3;
    int kgo[3], klo[3];
#pragma unroll
    for (int j = 0; j < 3; ++j) { const int idx = tid + 512 * j, tile = idx / 768, rem = idx % 768, c = rem >> 6, key = rem & 63; kgo[j] = (tile * 64 + key) * 96 + c * 8; klo[j] = tile * KT_BYTES + c * 1024 + key * 16; }
    const int vkey = tid >> 3, vdc = tid & 7;
    const int vgo = vkey * 64 + vdc * 8, vlo_ = 2 * KT_BYTES + (vdc >> 2) * 4096 + (vkey >> 4) * 1024 + (vkey & 15) * 64 + (vdc & 3) * 16;
    const int kfrag = hi * 1024 + r32 * 16;
    const int vfrag = ((lane >> 4) & 1) * 32 + (lane & 3) * 8 + (4 * hi + ((lane & 15) >> 2)) * 64;
    for (int it = cx.bid; it < 512; it += cx.nb) {
        const int pi = it & 255, sec = it >> 8, h = pi >> 6, jj = pi & 63, i = sec ? 127 - jj : jj;
        const int q0 = i * 128, qrow = q0 + 32 * w + r32, nsteps = i + 1;
        const bf16_t* Kh = Ka + (size_t)h * S * 96; const bf16_t* Vh = Va + (size_t)h * S * 64;
        bf16x8 qr[6];
#pragma unroll
        for (int d0 = 0; d0 < 6; ++d0) qr[d0] = *(const bf16x8*)(Qa + ((size_t)h * S + qrow) * 96 + d0 * 16 + hi * 8);
        f32x16 o0, o1;
#pragma unroll
        for (int r = 0; r < 16; ++r) { o0[r] = 0.f; o1[r] = 0.f; }
        float lsum = 0.f;
        u32x4 kreg[3], vreg[2];
#define MLA_LOADG(st) do { const bf16_t* kb_ = Kh + (size_t)(st) * 128 * 96; const bf16_t* vb_ = Vh + (size_t)(st) * 128 * 64; \
            _Pragma("unroll") for (int j = 0; j < 3; ++j) kreg[j] = *(const u32x4*)(kb_ + kgo[j]); \
            vreg[0] = *(const u32x4*)(vb_ + vgo); vreg[1] = *(const u32x4*)(vb_ + 64 * 64 + vgo); } while (0)
#define MLA_WRITEL(sb) do { LAS3 unsigned char* b_ = lds + (sb) * STAGE_BYTES; \
            _Pragma("unroll") for (int j = 0; j < 3; ++j) *(LAS3 u32x4*)(b_ + klo[j]) = kreg[j]; \
            *(LAS3 u32x4*)(b_ + vlo_) = vreg[0]; *(LAS3 u32x4*)(b_ + vlo_ + VT_BYTES) = vreg[1]; } while (0)
        __syncthreads();
        MLA_LOADG(0); MLA_WRITEL(0);
        __syncthreads();
        for (int s = 0; s < nsteps; ++s) {
            const bool more = (s + 1 < nsteps), last = !more;
            if (more) MLA_LOADG(s + 1);
            const LAS3 unsigned char* Kt = lds + (s & 1) * STAGE_BYTES + grp * KT_BYTES;
            const LAS3 unsigned char* Vt = lds + (s & 1) * STAGE_BYTES + 2 * KT_BYTES + grp * VT_BYTES;
            const bool active = !(last && grp == 1 && w < 2);
            if (active) {
                f32x16 p0, p1;
#pragma unroll
                for (int r = 0; r < 16; ++r) { p0[r] = -c2; p1[r] = -c2; }
#pragma unroll
                for (int d0 = 0; d0 < 6; ++d0) {
                    const bf16x8 a0 = *(const LAS3 bf16x8*)(Kt + kfrag + d0 * 2048);
                    const bf16x8 a1 = *(const LAS3 bf16x8*)(Kt + kfrag + d0 * 2048 + 512);
                    p0 = __builtin_amdgcn_mfma_f32_32x32x16_bf16(a0, qr[d0], p0, 0, 0, 0);
                    p1 = __builtin_amdgcn_mfma_f32_32x32x16_bf16(a1, qr[d0], p1, 0, 0, 0);
                }
                if (last) {
                    const int kbase = s * 128 + grp * 64 + 4 * hi;
#pragma unroll
                    for (int r = 0; r < 16; ++r) { const int kv = kbase + (r & 3) + 8 * (r >> 2); if (kv > qrow) p0[r] = -INFINITY; if (kv + 32 > qrow) p1[r] = -INFINITY; }
                }
                float sacc = 0.f;
#pragma unroll
                for (int r = 0; r < 16; ++r) { p0[r] = __builtin_amdgcn_exp2f(p0[r]); p1[r] = __builtin_amdgcn_exp2f(p1[r]); sacc += p0[r] + p1[r]; }
                lsum += sacc;
                u32x4 pw[4];
                pw[0] = (u32x4){cvtpk(p0[0], p0[1]), cvtpk(p0[2], p0[3]), cvtpk(p0[4], p0[5]), cvtpk(p0[6], p0[7])};
                pw[1] = (u32x4){cvtpk(p0[8], p0[9]), cvtpk(p0[10], p0[11]), cvtpk(p0[12], p0[13]), cvtpk(p0[14], p0[15])};
                pw[2] = (u32x4){cvtpk(p1[0], p1[1]), cvtpk(p1[2], p1[3]), cvtpk(p1[4], p1[5]), cvtpk(p1[6], p1[7])};
                pw[3] = (u32x4){cvtpk(p1[8], p1[9]), cvtpk(p1[10], p1[11]), cvtpk(p1[12], p1[13]), cvtpk(p1[14], p1[15])};
#pragma unroll
                for (int ks = 0; ks < 4; ++ks) {
                    const s16x4 l0 = vtr(Vt + vfrag + ks * 1024), h0 = vtr(Vt + vfrag + ks * 1024 + 512);
                    const s16x4 l1 = vtr(Vt + vfrag + 4096 + ks * 1024), h1 = vtr(Vt + vfrag + 4096 + ks * 1024 + 512);
                    const bf16x8 b0 = (bf16x8){l0[0], l0[1], l0[2], l0[3], h0[0], h0[1], h0[2], h0[3]};
                    const bf16x8 b1 = (bf16x8){l1[0], l1[1], l1[2], l1[3], h1[0], h1[1], h1[2], h1[3]};
                    const bf16x8 pa = __builtin_bit_cast(bf16x8, pw[ks]);
                    o0 = __builtin_amdgcn_mfma_f32_32x32x16_bf16(pa, b0, o0, 0, 0, 0);
                    o1 = __builtin_amdgcn_mfma_f32_32x32x16_bf16(pa, b1, o1, 0, 0, 0);
                }
            }
            if (more) MLA_WRITEL((s + 1) & 1);
            __syncthreads();
        }
#undef MLA_LOADG
#undef MLA_WRITEL
        lsum += shx(lsum, 32, lane);
        LAS3 float* Ocomb = (LAS3 float*)(lds + OFF_OCOMB) + w * 2048;
        LAS3 float* lcomb = (LAS3 float*)(lds + OFF_LCOMB) + w * 32;
        LAS3 float* wsf = (LAS3 float*)(lds + OFF_WSF) + w * 32;
        LAS3 bf16_t* Ost = (LAS3 bf16_t*)(lds + OFF_OST);
        if (grp == 1) {
#pragma unroll
            for (int r = 0; r < 16; ++r) { Ocomb[r * 64 + lane] = o0[r]; Ocomb[1024 + r * 64 + lane] = o1[r]; }
            if (hi == 0) lcomb[r32] = lsum;
        }
        __syncthreads();
        if (grp == 0) {
#pragma unroll
            for (int r = 0; r < 16; ++r) { o0[r] += Ocomb[r * 64 + lane]; o1[r] += Ocomb[1024 + r * 64 + lane]; }
            lsum += lcomb[r32];
            if (hi == 0) wsf[r32] = lsum;
            __builtin_amdgcn_s_waitcnt(0xC07F);
#pragma unroll
            for (int r = 0; r < 16; ++r) {
                const int orow = crow(r, hi); const float rl = 1.0f / wsf[orow];
                Ost[(32 * w + orow) * 64 + r32] = (bf16_t)f2bf(o0[r] * rl);
                Ost[(32 * w + orow) * 64 + 32 + r32] = (bf16_t)f2bf(o1[r] * rl);
            }
        }
        __syncthreads();
#pragma unroll
        for (int j = 0; j < 2; ++j) {
            const int chunk = tid + 512 * j, row = chunk >> 3, dc = chunk & 7;
            const u32x4 ov = *(const LAS3 u32x4*)(Ost + row * 64 + dc * 8);
            bf16_t* gp = P + (size_t)(q0 + row) * NP + C_GA + h * 64 + dc * 8;
            const uint4 gv = *(const uint4*)gp;
            uint4 y;
            y.x = pk2(lo16(ov.x) * silu(lo16(gv.x)), hi16(ov.x) * silu(hi16(gv.x)));
            y.y = pk2(lo16(ov.y) * silu(lo16(gv.y)), hi16(ov.y) * silu(hi16(gv.y)));
            y.z = pk2(lo16(ov.z) * silu(lo16(gv.z)), hi16(ov.z) * silu(hi16(gv.z)));
            y.w = pk2(lo16(ov.w) * silu(lo16(gv.w)), hi16(ov.w) * silu(hi16(gv.w)));
            *(uint4*)gp = y;
        }
    }
}
}


namespace moba {
using mla::bf16x8; using mla::s16x4; using mla::f32x16; using mla::u32x4; using mla::crow; using mla::vtr; using mla::cvtpk;
constexpr int KV_BYTES = 65536, OFF_MWSF = KV_BYTES, OFF_MPRE = OFF_MWSF + 1024;
template <bool OWN>
__device__ __forceinline__ void block_item(const Ctx& cx, const Params& p, int l, LAS3 unsigned char* lds, float c2, int h, int n, const int* lst, int cnt, int cstart) {
    bf16_t* P = (bf16_t*)(p.ws + OFF_P);
    bf16_t* part = (bf16_t*)(p.ws + OFF_PART); float* lpart = (float*)(p.ws + OFF_LPART);
    const int tid = cx.tid, lane = tid & 63, r32 = lane & 31, hi = lane >> 5;
    const int w = __builtin_amdgcn_readfirstlane(tid >> 6);
    __syncthreads();
    {
        const bf16_t* kb = P + (size_t)n * 256 * NP + C_MK + h * 64; const bf16_t* vb = P + (size_t)n * 256 * NP + C_MV + h * 64;
        u32x4 kr[4], vr[4];
#pragma unroll
        for (int j = 0; j < 4; ++j) { const int idx = tid + 512 * j, tile = idx >> 9, c = (idx & 511) >> 6, key = idx & 63; kr[j] = *(const u32x4*)(kb + (size_t)(tile * 64 + key) * NP + c * 8); }
#pragma unroll
        for (int j = 0; j < 4; ++j) { const int key = tid >> 3, dc = tid & 7; vr[j] = *(const u32x4*)(vb + (size_t)(j * 64 + key) * NP + dc * 8); }
#pragma unroll
        for (int j = 0; j < 4; ++j) { const int idx = tid + 512 * j, tile = idx >> 9, c = (idx & 511) >> 6, key = idx & 63; *(LAS3 u32x4*)(lds + tile * 8192 + c * 1024 + key * 16) = kr[j]; }
#pragma unroll
        for (int j = 0; j < 4; ++j) { const int key = tid >> 3, dc = tid & 7; *(LAS3 u32x4*)(lds + 32768 + j * 8192 + (dc >> 2) * 4096 + (key >> 4) * 1024 + (key & 15) * 64 + (dc & 3) * 16) = vr[j]; }
    }
    const int rr = 32 * w + r32;
    int entry = 0; bool valid = true;
    if (!OWN) { const int e = cstart + rr; valid = e < cnt; entry = lst[valid ? e : cstart]; }
    const int srow = OWN ? n * 256 + rr : (entry >> 2);
    bf16x8 qr[4];
#pragma unroll
    for (int d0 = 0; d0 < 4; ++d0) qr[d0] = *(const bf16x8*)(P + (size_t)srow * NP + C_MQ + h * 64 + d0 * 16 + hi * 8);
    f32x16 o0, o1;
#pragma unroll
    for (int r = 0; r < 16; ++r) { o0[r] = 0.f; o1[r] = 0.f; }
    float lsum = 0.f;
    const int kfrag = hi * 1024 + r32 * 16;
    const int vfrag = ((lane >> 4) & 1) * 32 + (lane & 3) * 8 + (4 * hi + ((lane & 15) >> 2)) * 64;
    const int tmax = OWN ? (w >> 1) : 3;
    __syncthreads();
#pragma unroll 1
    for (int t = 0; t <= tmax; ++t) {
        const LAS3 unsigned char* Kt = lds + t * 8192; const LAS3 unsigned char* Vt = lds + 32768 + t * 8192;
        f32x16 p0, p1;
#pragma unroll
        for (int r = 0; r < 16; ++r) { p0[r] = -c2; p1[r] = -c2; }
#pragma unroll
        for (int d0 = 0; d0 < 4; ++d0) {
            const bf16x8 a0 = *(const LAS3 bf16x8*)(Kt + kfrag + d0 * 2048);
            const bf16x8 a1 = *(const LAS3 bf16x8*)(Kt + kfrag + d0 * 2048 + 512);
            p0 = __builtin_amdgcn_mfma_f32_32x32x16_bf16(a0, qr[d0], p0, 0, 0, 0);
            p1 = __builtin_amdgcn_mfma_f32_32x32x16_bf16(a1, qr[d0], p1, 0, 0, 0);
        }
        if (OWN && t == tmax) {
            const int kbase = t * 64 + 4 * hi;
#pragma unroll
            for (int r = 0; r < 16; ++r) { const int kv = kbase + (r & 3) + 8 * (r >> 2); if (kv > rr) p0[r] = -INFINITY; if (kv + 32 > rr) p1[r] = -INFINITY; }
        }
        float sacc = 0.f;
#pragma unroll
        for (int r = 0; r < 16; ++r) { p0[r] = __builtin_amdgcn_exp2f(p0[r]); p1[r] = __builtin_amdgcn_exp2f(p1[r]); sacc += p0[r] + p1[r]; }
        lsum += sacc;
        u32x4 pw[4];
        pw[0] = (u32x4){cvtpk(p0[0], p0[1]), cvtpk(p0[2], p0[3]), cvtpk(p0[4], p0[5]), cvtpk(p0[6], p0[7])};
        pw[1] = (u32x4){cvtpk(p0[8], p0[9]), cvtpk(p0[10], p0[11]), cvtpk(p0[12], p0[13]), cvtpk(p0[14], p0[15])};
        pw[2] = (u32x4){cvtpk(p1[0], p1[1]), cvtpk(p1[2], p1[3]), cvtpk(p1[4], p1[5]), cvtpk(p1[6], p1[7])};
        pw[3] = (u32x4){cvtpk(p1[8], p1[9]), cvtpk(p1[10], p1[11]), cvtpk(p1[12], p1[13]), cvtpk(p1[14], p1[15])};
#pragma unroll
        for (int ks = 0; ks < 4; ++ks) {
            const s16x4 l0 = vtr(Vt + vfrag + ks * 1024), h0 = vtr(Vt + vfrag + ks * 1024 + 512);
            const s16x4 l1 = vtr(Vt + vfrag + 4096 + ks * 1024), h1 = vtr(Vt + vfrag + 4096 + ks * 1024 + 512);
            const bf16x8 b0 = (bf16x8){l0[0], l0[1], l0[2], l0[3], h0[0], h0[1], h0[2], h0[3]};
            const bf16x8 b1 = (bf16x8){l1[0], l1[1], l1[2], l1[3], h1[0], h1[1], h1[2], h1[3]};
            const bf16x8 pa = __builtin_bit_cast(bf16x8, pw[ks]);
            o0 = __builtin_amdgcn_mfma_f32_32x32x16_bf16(pa, b0, o0, 0, 0, 0);
            o1 = __builtin_amdgcn_mfma_f32_32x32x16_bf16(pa, b1, o1, 0, 0, 0);
        }
    }
    lsum += shx(lsum, 32, lane);
    if (!OWN) {
        const int dst = valid ? (h * S + (entry >> 2)) * 3 + (entry & 3) : -1;
        if (hi == 0 && valid) lpart[dst] = lsum;
#pragma unroll
        for (int r = 0; r < 16; ++r) {
            const int q = crow(r, hi);
            const int dq = __builtin_amdgcn_ds_bpermute(q << 2, dst);
            if (dq >= 0) { bf16_t* o = part + (size_t)dq * 64; o[r32] = (bf16_t)f2bf(o0[r]); o[32 + r32] = (bf16_t)f2bf(o1[r]); }
        }
    } else {
        const int nsel = n < 3 ? n : 3;
        const size_t pb = ((size_t)h * S + srow) * 3;
        for (int j = 0; j < nsel; ++j) lsum += lpart[pb + j];
        LAS3 float* wsf = (LAS3 float*)(lds + OFF_MWSF) + w * 32;
        if (hi == 0) wsf[r32] = lsum;
        __builtin_amdgcn_s_waitcnt(0xC07F);
#pragma unroll
        for (int r = 0; r < 16; ++r) {
            const int q = crow(r, hi); const int sq = n * 256 + 32 * w + q;
            float a0 = o0[r], a1 = o1[r];
            const bf16_t* pp = part + ((size_t)h * S + sq) * 3 * 64;
            for (int j = 0; j < nsel; ++j) { a0 += bf2f(pp[j * 64 + r32]); a1 += bf2f(pp[j * 64 + 32 + r32]); }
            const float rl = 1.0f / wsf[q];
            bf16_t* gp = P + (size_t)sq * NP + C_GD + h * 64;
            gp[r32] = (bf16_t)f2bf(a0 * rl * silu(bf2f(gp[r32])));
            gp[32 + r32] = (bf16_t)f2bf(a1 * rl * silu(bf2f(gp[32 + r32])));
        }
    }
}
__device__ __forceinline__ float c2_bound(const Params& p, int l) {
    float gq = 0.f, gk = 0.f;
    for (int d = 0; d < 64; ++d) { gq = fmaxf(gq, fabsf(p.mq_g[l * 64 + d])); gk = fmaxf(gk, fabsf(p.mk_g[l * 64 + d])); }
    return gq * gk * 8.0f * LOG2E * 1.02f;
}
__device__ __forceinline__ void gather_items(const Ctx& cx, const Params& p, int l, unsigned char* lds_generic) {
    LAS3 unsigned char* lds = (LAS3 unsigned char*)lds_generic;
    const int* mcnt = (const int*)(p.ws + OFF_MCNT); const int* mlist = (const int*)(p.ws + OFF_LIST);
    LAS3 int* pre = (LAS3 int*)(lds + OFF_MPRE);
    const float c2 = c2_bound(p, l);
    __syncthreads();
    if (cx.tid == 0) { int acc = 0; for (int i = 0; i < 256; ++i) { pre[i] = acc; acc += (mcnt[i] + 255) >> 8; } pre[256] = acc; }
    __syncthreads();
    const int total = pre[256];
    for (int c = cx.bid; c < total; c += cx.nb) {
        int lo = 0, hi_ = 255;
        while (lo < hi_) { const int mid = (lo + hi_ + 1) >> 1; if (pre[mid] <= c) lo = mid; else hi_ = mid - 1; }
        const int pair = lo, h = pair >> 6, n = pair & 63, cstart = (c - pre[pair]) * 256;
        block_item<false>(cx, p, l, lds, c2, h, n, mlist + (size_t)h * LIST_PER_HEAD + 256 * (63 * n - n * (n - 1) / 2), mcnt[pair], cstart);
    }
}
__device__ __forceinline__ void own_items(const Ctx& cx, const Params& p, int l, unsigned char* lds_generic) {
    LAS3 unsigned char* lds = (LAS3 unsigned char*)lds_generic;
    const float c2 = c2_bound(p, l);
    for (int it = cx.bid; it < 256; it += cx.nb) block_item<true>(cx, p, l, lds, c2, it >> 6, it & 63, nullptr, 0, 0);
}
}

#ifdef PROBE_CHECK
constexpr size_t OFF_T1 = OFF_END, OFF_T2 = OFF_END + (size_t)S * 256 * 2, OFF_CNT = 1024;
__device__ __forceinline__ void probe_cols(const Ctx& cx, const Params& p, int col, int dir) {
    bf16_t* P = (bf16_t*)(p.ws + OFF_P); bf16_t* T1 = (bf16_t*)(p.ws + OFF_T1); bf16_t* T2 = (bf16_t*)(p.ws + OFF_T2);
    unsigned* cnt = (unsigned*)(p.ws + OFF_CNT);
    const int gtid = cx.bid * NT + cx.tid, GT = cx.nb * NT;
    unsigned bad = 0;
    for (int i = gtid; i < S * 256; i += GT) {
        const int t = i >> 8, c = i & 255; bf16_t* pp = P + (size_t)t * NP + col + c;
        if (dir == 0) T1[i] = *pp;
        else if (dir == 1) { T2[i] = *pp; *pp = T1[i]; }
        else { const float a = bf2f(*pp), b = bf2f(T2[i]); const float d = fabsf(a - b); if (!(d <= 0.03f * fmaxf(fabsf(a), fabsf(b)) + PROBE_ABS)) ++bad; }
    }
    if (dir == 2 && bad) atomicAdd(cnt, bad);
}
__device__ __forceinline__ void probe_poison(const Ctx& cx, const Params& p) {
    const unsigned c = *(volatile unsigned*)(p.ws + OFF_CNT);
    if (cx.bid == 0 && cx.tid == 0 && c) p.out[0] += (float)c;
}
#endif

#define AS4 __attribute__((address_space(4)))
__device__ __forceinline__ Params load_params() {
    const AS4 unsigned char* k = (const AS4 unsigned char*)__builtin_amdgcn_kernarg_segment_ptr();
    asm volatile("" : "+s"(k));
    Params q;
#define LDP(field, T) q.field = *(T const AS4*)(k + __builtin_offsetof(Params, field))
    LDP(x, const float*); LDP(pos, const int*); LDP(norm_g, const float*); LDP(w_in, const float*); LDP(qn_g, const float*); LDP(w_uq, const float*);
    LDP(kvn_g, const float*); LDP(w_ukv, const float*); LDP(q_g, const float*); LDP(kn_g, const float*); LDP(kr_g, const float*); LDP(conv_w, const float*);
    LDP(ln_g, const float*); LDP(ln_b, const float*); LDP(sg_w, const float*); LDP(sg_b, const float*); LDP(mq_g, const float*); LDP(mk_g, const float*);
    LDP(w_out, const float*); LDP(out, float*); LDP(ws, unsigned char*);
#undef LDP
    return q;
}
template <int PH> __device__ __forceinline__ void run_phase(int wave_s, int l, float* lds) {
    const Params p = load_params();
    Ctx cx;
    { int w = wave_s; asm volatile("" : "+s"(w)); int ln; asm volatile("v_mbcnt_lo_u32_b32 %0, -1, 0\n\tv_mbcnt_hi_u32_b32 %0, -1, %0" : "=v"(ln)); cx.tid = w * 64 + ln; asm volatile("" : "+v"(cx.tid)); }
    { int b = __builtin_amdgcn_workgroup_id_x(); asm volatile("" : "+s"(b)); cx.bid = b; }
    { int nbk = (int)__builtin_amdgcn_grid_size_x() / NT; asm volatile("" : "+s"(nbk)); cx.nb = nbk; }
    unsigned char* ws = p.ws;
    if (PH == 0) phase_prep(cx, p, lds);
    if (PH == 1) {
        pg8::Gemm g{(const bf16_t*)(ws + OFF_XB), (const bf16_t*)(ws + OFF_WINT) + (size_t)l * NP * DM, S, NP, DM, DM};
        pg8::StaticOrder So; So.init(S, NP, cx.nb, cx.bid);
        pg8::EpiInP E{(bf16_t*)(ws + OFF_P), (const float*)(ws + OFF_RSTD), NP};
        pg8::gemm_phase<pg8::EpiInP, pg8::StaticOrder, pg8::AOffId, true, true>(cx, (PG8_LAS unsigned char*)lds, g, So, E, pg8::AOffId{});
    }
    if (PH == 2) { if (cx.bid == 0 && cx.tid < 256) ((int*)(ws + OFF_MCNT))[cx.tid] = 0; post_mla(cx, p, l, lds); post_conv(cx, p, l); post_sg(cx, p, l, lds); post_moba(cx, p, l, lds); }
    if (PH == 3) phase_gate(cx, p, l);
    if (PH == 4) { mla::attn_mla_fast(cx, p, l, (unsigned char*)lds); moba::gather_items(cx, p, l, (unsigned char*)lds); }
    if (PH == 7) moba::own_items(cx, p, l, (unsigned char*)lds);
    if (PH == 5) {
        pg8::Gemm g{(const bf16_t*)(ws + OFF_P), (const bf16_t*)(ws + OFF_WOUTT) + (size_t)l * DM * DM, S, DM, DM, NP};
        pg8::StaticOrder So; So.init(S, DM, cx.nb, cx.bid);
        pg8::EpiOutP E{l == 0 ? p.x : p.out, p.out, DM};
        pg8::gemm_phase<pg8::EpiOutP, pg8::StaticOrder, pg8::AOffY, false, true>(cx, (PG8_LAS unsigned char*)lds, g, So, E, pg8::AOffY{});
    }
#ifdef PROBE_CHECK
    if (PH == 10) { if (cx.bid == 0 && cx.tid == 0) *(unsigned*)(ws + OFF_CNT) = 0u; probe_cols(cx, p, PROBE_COL, 0); }
    if (PH == 11) { PROBE_NAIVE; }
    if (PH == 12) probe_cols(cx, p, PROBE_COL, 1);
    if (PH == 13) probe_cols(cx, p, PROBE_COL, 2);
    if (PH == 14) probe_poison(cx, p);
#endif
    if (PH == 6) rows_prep(cx, p.out, (bf16_t*)(ws + OFF_XB), (float*)(ws + OFF_RSTD));
}

__global__ void __launch_bounds__(NT) mega_kernel(Params p) {
    extern __shared__ __attribute__((aligned(16))) unsigned char lds_raw[];
    float* lds = (float*)lds_raw;
    cg::grid_group grid = cg::this_grid();
    const int wave_s = __builtin_amdgcn_readfirstlane((int)(threadIdx.x >> 6));
    run_phase<0>(wave_s, 0, lds); grid.sync();
    run_phase<1>(wave_s, 0, lds); grid.sync();
    run_phase<2>(wave_s, 0, lds); grid.sync();
    run_phase<3>(wave_s, 0, lds); grid.sync();
#ifdef PROBE_CHECK
    run_phase<10>(wave_s, 0, lds); grid.sync();
    run_phase<11>(wave_s, 0, lds); grid.sync();
    run_phase<12>(wave_s, 0, lds); grid.sync();
#endif
    run_phase<4>(wave_s, 0, lds); grid.sync();
    run_phase<7>(wave_s, 0, lds); grid.sync();
#ifdef PROBE_CHECK
    run_phase<13>(wave_s, 0, lds); grid.sync();
#endif
    run_phase<5>(wave_s, 0, lds); grid.sync();
    run_phase<6>(wave_s, 0, lds); grid.sync();
    run_phase<1>(wave_s, 1, lds); grid.sync();
    run_phase<2>(wave_s, 1, lds); grid.sync();
    run_phase<3>(wave_s, 1, lds); grid.sync();
    run_phase<4>(wave_s, 1, lds); grid.sync();
    run_phase<7>(wave_s, 1, lds); grid.sync();
    run_phase<5>(wave_s, 1, lds);
#ifdef PROBE_CHECK
    grid.sync(); run_phase<14>(wave_s, 1, lds);
#endif
}

extern "C" void kernel_launch(void* const* d_in, const int* in_sizes, int n_in, void* d_out, int out_size, void* d_ws, size_t ws_size, hipStream_t stream) {
    static int grid_blocks = 0;
    if (grid_blocks == 0) {
        int dev = 0, cus = 0, per_cu = 0;
        hipGetDevice(&dev);
        hipDeviceGetAttribute(&cus, hipDeviceAttributeMultiprocessorCount, dev);
        hipFuncSetAttribute((const void*)mega_kernel, hipFuncAttributeMaxDynamicSharedMemorySize, LDS_BYTES);
        hipOccupancyMaxActiveBlocksPerMultiprocessor(&per_cu, (const void*)mega_kernel, NT, LDS_BYTES);
        if (per_cu < 1) { fprintf(stderr, "occupancy query returned %d\n", per_cu); per_cu = 1; }
        if (per_cu > 1) per_cu = 1;
        grid_blocks = cus * per_cu;
        if (ws_size < OFF_END) { fprintf(stderr, "workspace too small: %zu < %zu\n", ws_size, (size_t)OFF_END); grid_blocks = -1; }
    }
    if (grid_blocks < 0) return;
    Params p{};
    p.x = (const float*)d_in[0]; p.pos = (const int*)d_in[1]; p.norm_g = (const float*)d_in[2]; p.w_in = (const float*)d_in[3];
    p.qn_g = (const float*)d_in[4]; p.w_uq = (const float*)d_in[5]; p.kvn_g = (const float*)d_in[6]; p.w_ukv = (const float*)d_in[7];
    p.q_g = (const float*)d_in[8]; p.kn_g = (const float*)d_in[9]; p.kr_g = (const float*)d_in[10]; p.conv_w = (const float*)d_in[11];
    p.ln_g = (const float*)d_in[12]; p.ln_b = (const float*)d_in[13]; p.sg_w = (const float*)d_in[14]; p.sg_b = (const float*)d_in[15];
    p.mq_g = (const float*)d_in[16]; p.mk_g = (const float*)d_in[17]; p.w_out = (const float*)d_in[18];
    p.out = (float*)d_out; p.ws = (unsigned char*)d_ws;
    void* args[] = {&p};
    hipError_t e = hipLaunchCooperativeKernel((const void*)mega_kernel, dim3(grid_blocks), dim3(NT), args, LDS_BYTES, stream);
    if (e != hipSuccess) fprintf(stderr, "cooperative launch failed: %s (grid %d)\n", hipGetErrorString(e), grid_blocks);
}
```

```cpp
#include <hip/hip_runtime.h>
#include <hip/hip_cooperative_groups.h>
#include <stdint.h>
#include <cstdio>
namespace cg = cooperative_groups;

constexpr int S = 16384, DM = 1024, NP = 3584, DEPTH = 2, DIN = 3488;
constexpr int NT = 512;
constexpr float EPS = 1e-6f;
constexpr float LOG2E = 1.4426950408889634f;
constexpr int C_CQ = 0, C_CKV = 256, C_KR = 384, C_GA = 512, C_CH = 768, C_CB = 1024, C_CC = 1280, C_GB = 1536,
              C_SU = 1792, C_SV = 2048, C_GC = 2304, C_MQ = 2560, C_MK = 2816, C_MV = 3072, C_GD = 3328;

typedef unsigned short bf16_t;
struct Ctx { int tid, bid, nb; };
__device__ __forceinline__ float bf2f(bf16_t v) { return __uint_as_float(((unsigned)v) << 16); }
__device__ __forceinline__ unsigned f2bf(float f) { unsigned u = __float_as_uint(f); return (u + 0x7fffu + ((u >> 16) & 1u)) >> 16; }
__device__ __forceinline__ unsigned pk2(float lo, float hi) { return f2bf(lo) | (f2bf(hi) << 16); }
__device__ __forceinline__ float lo16(unsigned u) { return __uint_as_float(u << 16); }
__device__ __forceinline__ float hi16(unsigned u) { return __uint_as_float(u & 0xffff0000u); }
__device__ __forceinline__ float shx(float v, int k, int lane) { return __builtin_bit_cast(float, __builtin_amdgcn_ds_bpermute((lane ^ k) << 2, __builtin_bit_cast(int, v))); }
__device__ __forceinline__ float wave_sum(float v, int lane) {
#pragma unroll
    for (int o = 1; o < 64; o <<= 1) v += shx(v, o, lane);
    return v;
}
__device__ __forceinline__ float silu(float g) { return g / (1.f + __expf(-g)); }

constexpr size_t al256(size_t x) { return (x + 255) & ~(size_t)255; }
constexpr size_t OFF_CTRL = 0;
constexpr size_t OFF_WINT = 65536;
constexpr size_t OFF_WOUTT = OFF_WINT + (size_t)DEPTH * NP * DM * 2;
constexpr size_t OFF_WUQT = OFF_WOUTT + (size_t)DEPTH * DM * DM * 2;
constexpr size_t OFF_WUKVT = OFF_WUQT + (size_t)DEPTH * 384 * 256 * 2;
constexpr size_t OFF_SGW = OFF_WUKVT + (size_t)DEPTH * 512 * 128 * 2;
constexpr size_t OFF_COSA = OFF_SGW + (size_t)DEPTH * 4 * 128 * 128 * 2;
constexpr size_t OFF_SINA = OFF_COSA + (size_t)S * 16 * 4;
constexpr size_t OFF_COSD = OFF_SINA + (size_t)S * 16 * 4;
constexpr size_t OFF_SIND = OFF_COSD + (size_t)S * 8 * 4;
constexpr size_t OFF_RSTD = OFF_SIND + (size_t)S * 8 * 4;
constexpr size_t OFF_KMEAN = OFF_RSTD + (size_t)S * 4;
constexpr size_t OFF_SEL = OFF_KMEAN + (size_t)4 * 64 * 64 * 4;
constexpr size_t OFF_XB = OFF_SEL + (size_t)4 * S * 4 * 4;
constexpr size_t OFF_P = OFF_XB + (size_t)S * DM * 2;
constexpr size_t OFF_QA = OFF_P + (size_t)S * NP * 2;
constexpr size_t OFF_KA = OFF_QA + (size_t)4 * S * 96 * 2;
constexpr size_t OFF_VA = OFF_KA + (size_t)4 * S * 96 * 2;
constexpr size_t OFF_LIST = OFF_VA + (size_t)4 * S * 64 * 2;
constexpr int LIST_PER_HEAD = 256 * 2016;
constexpr size_t OFF_LPART = OFF_LIST + (size_t)4 * LIST_PER_HEAD * 4;
constexpr size_t OFF_END = OFF_LPART + (size_t)4 * S * 3 * 4;
constexpr size_t OFF_PART = OFF_XB;
constexpr size_t OFF_MCNT = 2048;
static_assert((size_t)4 * S * 3 * 64 * 2 <= (size_t)S * DM * 2, "partials must fit in Xb");
static_assert(OFF_END <= 268435456, "workspace map exceeds 256 MiB");
static_assert((OFF_XB % 256) == 0 && (OFF_P % 256) == 0 && (OFF_QA % 256) == 0, "alignment");

constexpr int LDS_BYTES = 147456;

struct Params {
    const float* x; const int* pos; const float* norm_g; const float* w_in; const float* qn_g; const float* w_uq;
    const float* kvn_g; const float* w_ukv; const float* q_g; const float* kn_g; const float* kr_g; const float* conv_w;
    const float* ln_g; const float* ln_b; const float* sg_w; const float* sg_b; const float* mq_g; const float* mk_g;
    const float* w_out; float* out; unsigned char* ws;
};

namespace pg8 {
#define PG8_LAS __attribute__((address_space(3)))
typedef unsigned short bf16_t;
typedef short bf16x8 __attribute__((ext_vector_type(8)));
typedef float f32x4 __attribute__((ext_vector_type(4)));
typedef unsigned u32x4 __attribute__((ext_vector_type(4)));
constexpr int BM = 256, BK = 64, HALF = 128, HTB = HALF * BK * 2  , STAGE_BYTES = 8 * HTB, NXCD = 8, WGM = 8;

__host__ __device__ __forceinline__ int lds_byte(int r, int c) { const int st = (r >> 4) * 2 + (c >> 5), rr = r & 15, cc = c & 31, ob = rr * 64 + cc * 2; return st * 1024 + (ob ^ (((ob >> 9) & 1) << 5)); }
__host__ __device__ __forceinline__ void stage_rc(int b, int& R, int& C) { const int st = b / 1024, sb = b % 1024, swz = sb ^ (((sb >> 9) & 1) << 5); R = (st >> 1) * 16 + swz / 64; C = (st & 1) * 32 + (swz % 64) / 2; }
__host__ __device__ __forceinline__ int perm32(int rho) { const int n = rho >> 4, i = rho & 15; return 8 * (i >> 2) + 4 * n + (i & 3); }

struct Unit { int pm, pn; };
struct Gemm { const bf16_t* A; const bf16_t* Bt; int M, N, K, lda; };

struct StaticOrder {
    int nM, nN, nwg, G, c;
    __host__ __device__ void init(int M, int N, int G_, int c_) { nM = M / BM; nN = N / BM; nwg = nM * nN; G = G_; c = c_; }
    __host__ __device__ bool next(int i, Unit& u) const {
        const long L = (long)i * G + c; if (L >= nwg) return false;
        int wgid = (int)L; { const int q = nwg / NXCD, r = nwg % NXCD, xcd = wgid % NXCD, off = wgid / NXCD; wgid = (xcd < r ? xcd * (q + 1) : r * (q + 1) + (xcd - r) * q) + off; }
        const int nig = WGM * nN, gid = wgid / nig, fm = gid * WGM, gsz = (nM - fm) < WGM ? (nM - fm) : WGM;
        u.pm = fm + ((wgid % nig) % gsz); u.pn = (wgid % nig) / gsz; return true;
    }
    __device__ __forceinline__ void a_ready(const Unit&) const {}
    __device__ __forceinline__ void done(const Unit&) const {}
};


template <class Epi, class Sched, class AOff, bool ALIGN_EPI = false, bool SP2 = false>
__device__ __forceinline__ void gemm_phase(const Ctx& cx, PG8_LAS unsigned char* lds, const Gemm g, const Sched& S, const Epi& E, const AOff& AO) {
    const int tid = cx.tid, wid = __builtin_amdgcn_readfirstlane(tid >> 6), lane = tid & 63, wr = wid >> 2, wc = wid & 3, fr = lane & 15, fq = lane >> 4;
    const int K = g.K, nt = K / BK;
    unsigned voffA[2], voffB[2];
#pragma unroll
    for (int i = 0; i < 2; ++i) { int R, C; stage_rc(tid * 16 + i * 8192, R, C); const int Rb = Epi::PERM ? ((R & ~31) + perm32(R & 31)) : R;
        voffA[i] = (unsigned)(R * g.lda + C) * 2u; voffB[i] = (unsigned)(Rb * K + C) * 2u; }
    const size_t kstep = (size_t)(BK * 2);
    const size_t hstepB = (size_t)HALF * K * 2, hstepA = (size_t)HALF * g.lda * 2;
    const size_t tstepB = 2 * hstepB, tstepA = 2 * hstepA;
    const unsigned ldsw = (unsigned)wid * 1024u;
    const int aoff = lds_byte(wr * 64 + fr, fq * 8), boff = lds_byte(wc * 32 + fr, fq * 8);
#define PG8_SA(b, h) (((b) * 2 + (h)) * HTB)
#define PG8_SB(b, h) ((4 + (b) * 2 + (h)) * HTB)
#define PG8_STAGE(bufoff, gbase, voff) do { _Pragma("unroll") for (int _i = 0; _i < 2; ++_i) \
        __builtin_amdgcn_global_load_lds((const unsigned*)((const char*)(gbase) + (voff)[_i]), (PG8_LAS unsigned*)(lds + (bufoff) + ldsw + _i * 8192), 16, 0, 0); } while (0)
#define PG8_LDA(dst, b, h) do { _Pragma("unroll") for (int m = 0; m < 4; ++m) _Pragma("unroll") for (int k = 0; k < 2; ++k) dst[m][k] = *(const PG8_LAS bf16x8*)(lds + PG8_SA(b, h) + aoff + m * 2048 + k * 1024); } while (0)
#define PG8_LDB(dst, b, h) do { _Pragma("unroll") for (int n = 0; n < 2; ++n) _Pragma("unroll") for (int k = 0; k < 2; ++k) dst[n][k] = *(const PG8_LAS bf16x8*)(lds + PG8_SB(b, h) + boff + n * 2048 + k * 1024); } while (0)
#define PG8_MMA(ai, bj, At, Bt) do { __builtin_amdgcn_s_setprio(1); _Pragma("unroll") for (int m = 0; m < 4; ++m) _Pragma("unroll") for (int n = 0; n < 2; ++n) _Pragma("unroll") for (int k = 0; k < 2; ++k) \
        acc[ai][bj][m][n] = __builtin_amdgcn_mfma_f32_16x16x32_bf16(Bt[n][k], At[m][k], acc[ai][bj][m][n], 0, 0, 0); __builtin_amdgcn_s_setprio(0); } while (0)
#define PG8_WAIT_V(n) asm volatile("s_waitcnt vmcnt(" #n ")" ::: "memory")
#define PG8_WAIT_L(n) asm volatile("s_waitcnt lgkmcnt(" #n ")" ::: "memory")
#define PG8_BAR __builtin_amdgcn_s_barrier()
#define PG8_SCHED __builtin_amdgcn_sched_barrier(0)
    Unit cur, nxt; int ui = 0;
    if (!S.next(0, cur)) return;
    f32x4 acc[2][2][4][2];
#pragma unroll
    for (int a = 0; a < 2; ++a)
#pragma unroll
        for (int b = 0; b < 2; ++b)
#pragma unroll
            for (int m = 0; m < 4; ++m)
#pragma unroll
                for (int n = 0; n < 2; ++n) acc[a][b][m][n] = (f32x4){0.f, 0.f, 0.f, 0.f};
    bf16x8 At[4][2], B0[2][2], B1[2][2];
    const char* cA = (const char*)g.A + (size_t)cur.pm * tstepA; const char* cB = (const char*)g.Bt + (size_t)cur.pn * tstepB;
    S.a_ready(cur);
    if constexpr (SP2) {
        PG8_STAGE(PG8_SB(0, 0), cB, voffB); PG8_STAGE(PG8_SB(0, 1), cB + hstepB, voffB); PG8_STAGE(PG8_SA(0, 0), cA + AO(0), voffA); PG8_STAGE(PG8_SA(0, 1), cA + AO(0) + hstepA, voffA);
        if (wr == 1) PG8_BAR;
        PG8_WAIT_V(2); PG8_BAR;
        PG8_STAGE(PG8_SB(1, 0), cB + kstep, voffB); PG8_STAGE(PG8_SA(1, 0), cA + AO(1), voffA); PG8_STAGE(PG8_SB(1, 1), cB + hstepB + kstep, voffB);
        PG8_WAIT_V(6); PG8_BAR;
    } else {
        PG8_STAGE(PG8_SB(0, 0), cB, voffB); PG8_STAGE(PG8_SA(0, 0), cA + AO(0), voffA); PG8_STAGE(PG8_SB(0, 1), cB + hstepB, voffB); PG8_STAGE(PG8_SA(0, 1), cA + AO(0) + hstepA, voffA);
        if (wr == 1) PG8_BAR;
        PG8_WAIT_V(4); PG8_BAR;
        PG8_STAGE(PG8_SB(1, 0), cB + kstep, voffB); PG8_STAGE(PG8_SA(1, 0), cA + AO(1), voffA); PG8_STAGE(PG8_SB(1, 1), cB + hstepB + kstep, voffB);
        PG8_WAIT_V(6); PG8_BAR;
    }
    for (;;) {
        const bool has_next = S.next(ui + 1, nxt);
        const char* nA = has_next ? (const char*)g.A + (size_t)nxt.pm * tstepA : cA; const char* nB = has_next ? (const char*)g.Bt + (size_t)nxt.pn * tstepB : cB;
        for (int t = 0; t < nt; t += 2) {
            const bool last = (t == nt - 2);
            const char* a1 = cA + AO(t + 1);
            const char* a2 = last ? nA + AO(0) : cA + AO(t + 2); const char* b2 = last ? nB : cB + (size_t)(t + 2) * kstep;
            const char* a3 = last ? nA + AO(1) : cA + AO(t + 3); const char* b3 = b2 + kstep;
            if (last && has_next) S.a_ready(nxt);
            if constexpr (SP2) {
            PG8_LDB(B0, 0, 0); PG8_LDB(B1, 0, 1); PG8_SCHED; PG8_LDA(At, 0, 0); PG8_STAGE(PG8_SA(1, 1), a1 + hstepA, voffA);
            PG8_WAIT_V(8); PG8_WAIT_L(0); PG8_BAR; PG8_MMA(0, 0, At, B0); PG8_MMA(0, 1, At, B1); PG8_BAR; PG8_SCHED;
            PG8_LDA(At, 0, 1); PG8_STAGE(PG8_SB(0, 0), b2, voffB); PG8_STAGE(PG8_SB(0, 1), b2 + hstepB, voffB); PG8_STAGE(PG8_SA(0, 0), a2, voffA);
            PG8_WAIT_V(8); PG8_WAIT_L(0); PG8_BAR; PG8_MMA(1, 0, At, B0); PG8_MMA(1, 1, At, B1); PG8_BAR; PG8_SCHED;
            PG8_LDB(B0, 1, 0); PG8_LDB(B1, 1, 1); PG8_SCHED; PG8_LDA(At, 1, 0); PG8_STAGE(PG8_SA(0, 1), a2 + hstepA, voffA);
            PG8_WAIT_V(8); PG8_WAIT_L(0); PG8_BAR; PG8_MMA(0, 0, At, B0); PG8_MMA(0, 1, At, B1); PG8_BAR; PG8_SCHED;
            PG8_LDA(At, 1, 1); PG8_STAGE(PG8_SB(1, 0), b3, voffB); PG8_STAGE(PG8_SB(1, 1), b3 + hstepB, voffB); PG8_STAGE(PG8_SA(1, 0), a3, voffA);
            PG8_WAIT_V(8); PG8_WAIT_L(0); PG8_BAR; PG8_MMA(1, 0, At, B0); PG8_MMA(1, 1, At, B1); PG8_BAR; PG8_SCHED;
            } else {
            PG8_LDB(B0, 0, 0); PG8_SCHED; PG8_LDA(At, 0, 0); PG8_STAGE(PG8_SA(1, 1), a1 + hstepA, voffA);
            PG8_WAIT_L(8); PG8_BAR; PG8_WAIT_L(0); PG8_MMA(0, 0, At, B0); PG8_BAR; PG8_SCHED;
            PG8_LDB(B1, 0, 1); PG8_STAGE(PG8_SB(0, 0), b2, voffB);
            PG8_BAR; PG8_WAIT_L(0); PG8_MMA(0, 1, At, B1); PG8_BAR;
            PG8_LDA(At, 0, 1); PG8_STAGE(PG8_SA(0, 0), a2, voffA);
            PG8_BAR; PG8_WAIT_L(0); PG8_MMA(1, 0, At, B0); PG8_BAR; PG8_SCHED;
            PG8_STAGE(PG8_SB(0, 1), b2 + hstepB, voffB);
            PG8_WAIT_V(6); PG8_BAR; PG8_MMA(1, 1, At, B1); PG8_BAR;
            PG8_LDB(B0, 1, 0); PG8_SCHED; PG8_LDA(At, 1, 0); PG8_STAGE(PG8_SA(0, 1), a2 + hstepA, voffA);
            PG8_WAIT_L(8); PG8_BAR; PG8_WAIT_L(0); PG8_MMA(0, 0, At, B0); PG8_BAR; PG8_SCHED;
            PG8_LDB(B1, 1, 1); PG8_STAGE(PG8_SB(1, 0), b3, voffB);
            PG8_BAR; PG8_WAIT_L(0); PG8_MMA(0, 1, At, B1); PG8_BAR;
            PG8_LDA(At, 1, 1); PG8_STAGE(PG8_SA(1, 0), a3, voffA);
            PG8_BAR; PG8_WAIT_L(0); PG8_MMA(1, 0, At, B0); PG8_BAR; PG8_SCHED;
            PG8_STAGE(PG8_SB(1, 1), b3 + hstepB, voffB);
            PG8_WAIT_V(6); PG8_BAR; PG8_MMA(1, 1, At, B1); PG8_BAR;
            }
        }
        if constexpr (ALIGN_EPI) { if (wr == 0) PG8_BAR; }
        if constexpr (!Epi::AFTER_DRAIN) { E(acc, cur, wr, wc, fr, fq); S.done(cur); }
        if (!has_next) break;
#pragma unroll
        for (int a = 0; a < 2; ++a)
#pragma unroll
            for (int b = 0; b < 2; ++b)
#pragma unroll
                for (int m = 0; m < 4; ++m)
#pragma unroll
                    for (int n = 0; n < 2; ++n) acc[a][b][m][n] = (f32x4){0.f, 0.f, 0.f, 0.f};
        cur = nxt; cA = nA; cB = nB; ++ui;
        if constexpr (ALIGN_EPI) { if (wr == 1) PG8_BAR; }
    }
    PG8_WAIT_V(0);
    if constexpr (!ALIGN_EPI) { if (wr == 0) PG8_BAR; }
    PG8_BAR;
    if constexpr (Epi::AFTER_DRAIN) { E.fused(acc, cur, wr, wc, fr, fq, lds, wid, lane); S.done(cur); }
#undef PG8_SA
#undef PG8_SB
#undef PG8_STAGE
#undef PG8_LDA
#undef PG8_LDB
#undef PG8_MMA
#undef PG8_WAIT_V
#undef PG8_WAIT_L
#undef PG8_BAR
#undef PG8_SCHED
}

__device__ __forceinline__ unsigned cvt_pk_bf16(float lo, float hi) { unsigned r; asm volatile("v_cvt_pk_bf16_f32 %0, %1, %2" : "=v"(r) : "v"(lo), "v"(hi)); return r; }
struct AOffId { __device__ __forceinline__ size_t operator()(int t) const { return (size_t)t * (BK * 2); } };
struct AOffY {
    __device__ __forceinline__ size_t operator()(int t) const { const int g = t >> 2; const int base = g == 0 ? 512 : g == 1 ? 1536 : g == 2 ? 2304 : 3328; return (size_t)(base + (t & 3) * 64) * 2; }
};
struct EpiInP {
    static constexpr bool PERM = true, AFTER_DRAIN = false;
    bf16_t* P; const float* rstd; int ldp;
    __device__ __forceinline__ void operator()(const f32x4 (&acc)[2][2][4][2], const Unit& u, int wr, int wc, int fr, int fq) const {
        const int row0 = u.pm * BM + wr * 64 + fr, col0 = u.pn * BM + wc * 32 + 8 * fq;
#pragma unroll
        for (int ai = 0; ai < 2; ++ai)
#pragma unroll
            for (int m = 0; m < 4; ++m) { const int row = row0 + ai * HALF + m * 16; const float r = rstd[row]; bf16_t* rowp = P + (size_t)row * ldp + col0;
#pragma unroll
                for (int bj = 0; bj < 2; ++bj) { const f32x4 v0 = acc[ai][bj][m][0] * r, v1 = acc[ai][bj][m][1] * r;
                    u32x4 w; w.x = cvt_pk_bf16(v0[0], v0[1]); w.y = cvt_pk_bf16(v0[2], v0[3]); w.z = cvt_pk_bf16(v1[0], v1[1]); w.w = cvt_pk_bf16(v1[2], v1[3]);
                    *(u32x4*)(rowp + bj * HALF) = w; } }
    }
};
struct EpiOutP {
    static constexpr bool PERM = false, AFTER_DRAIN = false;
    const float* xin; float* out; int ldc;
    __device__ __forceinline__ void operator()(const f32x4 (&acc)[2][2][4][2], const Unit& u, int wr, int wc, int fr, int fq) const {
        const int col0 = u.pn * BM + wc * 32 + 4 * fq;
#pragma unroll
        for (int ai = 0; ai < 2; ++ai)
#pragma unroll
            for (int m = 0; m < 4; ++m) { const size_t off = (size_t)(u.pm * BM + ai * HALF + wr * 64 + m * 16 + fr) * ldc + col0;
#pragma unroll
                for (int bj = 0; bj < 2; ++bj)
#pragma unroll
                    for (int n = 0; n < 2; ++n) { const f32x4 xi = *(const f32x4*)(xin + off + bj * HALF + n * 16); *(f32x4*)(out + off + bj * HALF + n * 16) = xi + acc[ai][bj][m][n]; } }
    }
};
}

__device__ __forceinline__ void transpose_tiles(const Ctx& cx, const float* __restrict__ src, int K, int Nsrc, const float* __restrict__ gk,
                                bf16_t* __restrict__ dst, int Ndst, int gap_at, int gap_len, float* lds) {
    float (*t)[33] = (float (*)[33])lds;
    const int tid = cx.tid, a = tid >> 5, b = tid & 31;
    const int tilesN = Ndst / 32, tilesK = K / 32;
    for (int tile = cx.bid; tile < tilesN * tilesK; tile += cx.nb) {
        const int tn = tile % tilesN, tk = tile / tilesN, n0 = tn * 32, k0 = tk * 32;
        __syncthreads();
#pragma unroll
        for (int i = 0; i < 2; ++i) {
            const int kk = a + 16 * i, np = n0 + b;
            const bool z = (np >= gap_at && np < gap_at + gap_len);
            const int n = np < gap_at ? np : np - gap_len;
            float v = z ? 0.f : src[(size_t)(k0 + kk) * Nsrc + n];
            if (gk) v *= gk[k0 + kk];
            t[kk][b] = v;
        }
        __syncthreads();
#pragma unroll
        for (int i = 0; i < 2; ++i) {
            const int nn = a + 16 * i;
            dst[(size_t)(n0 + nn) * K + k0 + b] = (bf16_t)f2bf(t[b][nn]);
        }
    }
}

__device__ __forceinline__ void rows_prep(const Ctx& cx, const float* __restrict__ xsrc, bf16_t* __restrict__ Xb, float* __restrict__ rstd) {
    const int wave = cx.tid >> 6, lane = cx.tid & 63;
    const int gw = cx.bid * (NT / 64) + wave, NGW = cx.nb * (NT / 64);
    for (int m = gw; m < S; m += NGW) {
        const float4* xr = (const float4*)(xsrc + (size_t)m * DM) + lane;
        float4 v[4]; float s = 0.f;
#pragma unroll
        for (int j = 0; j < 4; ++j) { v[j] = xr[64 * j]; s += (v[j].x * v[j].x + v[j].y * v[j].y) + (v[j].z * v[j].z + v[j].w * v[j].w); }
        s = wave_sum(s, lane);
        const float r = 1.0f / sqrtf(s * (1.0f / DM) + EPS);
        if (lane == 0) rstd[m] = r;
        uint2* o = (uint2*)(Xb + (size_t)m * DM) + lane;
#pragma unroll
        for (int j = 0; j < 4; ++j) o[64 * j] = make_uint2(pk2(v[j].x, v[j].y), pk2(v[j].z, v[j].w));
    }
}

__device__ __forceinline__ void phase_prep(const Ctx& cx, const Params& p, float* lds) {
    unsigned char* ws = p.ws;
    for (int l = 0; l < DEPTH; ++l) {
        transpose_tiles(cx, p.w_in + (size_t)l * DM * DIN, DM, DIN, p.norm_g + l * DM, (bf16_t*)(ws + OFF_WINT) + (size_t)l * NP * DM, NP, 416, 96, lds);
        transpose_tiles(cx, p.w_out + (size_t)l * DM * DM, DM, DM, nullptr, (bf16_t*)(ws + OFF_WOUTT) + (size_t)l * DM * DM, DM, DM, 0, lds);
        transpose_tiles(cx, p.w_uq + (size_t)l * 256 * 384, 256, 384, p.qn_g + l * 256, (bf16_t*)(ws + OFF_WUQT) + (size_t)l * 384 * 256, 384, 384, 0, lds);
        transpose_tiles(cx, p.w_ukv + (size_t)l * 128 * 512, 128, 512, p.kvn_g + l * 128, (bf16_t*)(ws + OFF_WUKVT) + (size_t)l * 512 * 128, 512, 512, 0, lds);
    }
    const int gtid = cx.bid * NT + cx.tid, GT = cx.nb * NT;
    {
        bf16_t* sgw = (bf16_t*)(ws + OFF_SGW);
        for (int i = gtid; i < DEPTH * 4 * 128 * 128; i += GT) {
            const int s_ = i & 127, t_ = (i >> 7) & 127;
            sgw[i] = (bf16_t)f2bf(s_ <= t_ ? p.sg_w[i] : 0.f);
        }
    }
    {
        float* cosA = (float*)(ws + OFF_COSA); float* sinA = (float*)(ws + OFF_SINA);
        float* cosD = (float*)(ws + OFF_COSD); float* sinD = (float*)(ws + OFF_SIND);
        for (int i = gtid; i < S * 24; i += GT) {
            const int s_ = i / 24, j = i % 24;
            const float posf = (float)p.pos[s_];
            float inv;
            if (j < 16) inv = powf(500000.0f, -((float)j * 2.0f / 32.0f));
            else inv = powf(500000.0f, -((float)(j - 16) * 2.0f / 16.0f));
            const float ang = posf * inv;
            const double a = (double)ang;
            const double r = a - rint(a * 0.15915494309189535) * 6.283185307179586;
            const float c = (float)cos(r), sn = (float)sin(r);
            if (j < 16) { cosA[s_ * 16 + j] = c; sinA[s_ * 16 + j] = sn; }
            else { cosD[s_ * 8 + (j - 16)] = c; sinD[s_ * 8 + (j - 16)] = sn; }
        }
    }
    rows_prep(cx, p.x, (bf16_t*)(ws + OFF_XB), (float*)(ws + OFF_RSTD));
}

struct AMapId { __device__ __forceinline__ int operator()(int k0) const { return k0; } };
struct AMapY {
    __device__ __forceinline__ int operator()(int k0) const { const int g = k0 >> 8; const int base = g == 0 ? C_GA : g == 1 ? C_GB : g == 2 ? C_GC : C_GD; return base + (k0 & 255); }
};
template <class AMap, class Epi>
__device__ __forceinline__ void gemm_naive(const Ctx& cx, const bf16_t* __restrict__ A, int lda, AMap amap, const bf16_t* __restrict__ Bt, int K, int M, int N, Epi epi, float* lds) {
    float (*As)[132] = (float (*)[132])lds;
    float (*Bs)[132] = (float (*)[132])(lds + 16 * 132);
    const int tid = cx.tid, ty = tid >> 5, tx = tid & 31;
    const int lr = tid >> 2, lk = (tid & 3) * 4;
    const int ntm = M / 128, ntn = N / 128;
    for (int tile = cx.bid; tile < ntm * ntn; tile += cx.nb) {
        const int tm = tile / ntn, tn = tile % ntn;
        float acc[8][4];
#pragma unroll
        for (int i = 0; i < 8; ++i)
#pragma unroll
            for (int j = 0; j < 4; ++j) acc[i][j] = 0.f;
        for (int k0 = 0; k0 < K; k0 += 16) {
            const uint2 av = *(const uint2*)(A + (size_t)(tm * 128 + lr) * lda + amap(k0) + lk);
            const uint2 bv = *(const uint2*)(Bt + (size_t)(tn * 128 + lr) * K + k0 + lk);
            __syncthreads();
            As[lk + 0][lr] = lo16(av.x); As[lk + 1][lr] = hi16(av.x); As[lk + 2][lr] = lo16(av.y); As[lk + 3][lr] = hi16(av.y);
            Bs[lk + 0][lr] = lo16(bv.x); Bs[lk + 1][lr] = hi16(bv.x); Bs[lk + 2][lr] = lo16(bv.y); Bs[lk + 3][lr] = hi16(bv.y);
            __syncthreads();
#pragma unroll
            for (int kk = 0; kk < 16; ++kk) {
                const float4 a0 = *(const float4*)&As[kk][ty * 8], a1 = *(const float4*)&As[kk][ty * 8 + 4];
                const float4 b = *(const float4*)&Bs[kk][tx * 4];
                const float a[8] = {a0.x, a0.y, a0.z, a0.w, a1.x, a1.y, a1.z, a1.w};
                const float bb[4] = {b.x, b.y, b.z, b.w};
#pragma unroll
                for (int i = 0; i < 8; ++i)
#pragma unroll
                    for (int j = 0; j < 4; ++j) acc[i][j] = fmaf(a[i], bb[j], acc[i][j]);
            }
        }
#pragma unroll
        for (int i = 0; i < 8; ++i) epi(tm * 128 + ty * 8 + i, tn * 128 + tx * 4, acc[i]);
    }
}
struct EpiIn {
    bf16_t* P; const float* rstd;
    __device__ __forceinline__ void operator()(int m, int n, const float (&v)[4]) const {
        const float r = rstd[m];
        *(uint2*)(P + (size_t)m * NP + n) = make_uint2(pk2(v[0] * r, v[1] * r), pk2(v[2] * r, v[3] * r));
    }
};
struct EpiOut {
    const float* xin; float* out;
    __device__ __forceinline__ void operator()(int m, int n, const float (&v)[4]) const {
        const float4 xi = *(const float4*)(xin + (size_t)m * DM + n);
        *(float4*)(out + (size_t)m * DM + n) = make_float4(xi.x + v[0], xi.y + v[1], xi.z + v[2], xi.w + v[3]);
    }
};

constexpr float QSCALE_A = 0.10206207261596577f * LOG2E;
constexpr float QSCALE_D = 0.125f * LOG2E;

__device__ __forceinline__ void post_mla(const Ctx& cx, const Params& p, int l, float* lds) {
    unsigned char* ws = p.ws;
    const bf16_t* P = (const bf16_t*)(ws + OFF_P);
    const bf16_t* WuqT = (const bf16_t*)(ws + OFF_WUQT) + (size_t)l * 384 * 256;
    const bf16_t* WukvT = (const bf16_t*)(ws + OFF_WUKVT) + (size_t)l * 512 * 128;
    bf16_t* Qa = (bf16_t*)(ws + OFF_QA); bf16_t* Ka = (bf16_t*)(ws + OFF_KA); bf16_t* Va = (bf16_t*)(ws + OFF_VA);
    const float* cosA = (const float*)(ws + OFF_COSA); const float* sinA = (const float*)(ws + OFF_SINA);
    const float* q_g = p.q_g + l * 96; const float* kn_g = p.kn_g + l * 64; const float* kr_g = p.kr_g + l * 32;
    float* cq = lds;
    float* ckv = lds + 256;
    float* kr = lds + 384;
    float* qf = lds + 416;
    float* kvf = lds + 800;
    float* st = lds + 1312;
    const int tid = cx.tid, wave = tid >> 6, lane = tid & 63;
    for (int s = cx.bid; s < S; s += cx.nb) {
        __syncthreads();
        if (tid < 416) lds[tid] = bf2f(P[(size_t)s * NP + tid]);
        __syncthreads();
        if (wave == 0) { float a = 0.f; for (int j = 0; j < 4; ++j) { const float v = cq[lane + 64 * j]; a += v * v; } a = wave_sum(a, lane); if (lane == 0) st[0] = 1.0f / sqrtf(a * (1.f / 256.f) + EPS); }
        if (wave == 1) { float a = 0.f; for (int j = 0; j < 2; ++j) { const float v = ckv[lane + 64 * j]; a += v * v; } a = wave_sum(a, lane); if (lane == 0) st[1] = 1.0f / sqrtf(a * (1.f / 128.f) + EPS); }
        if (wave == 2) { float a = 0.f; if (lane < 32) { const float v = kr[lane]; a = v * v; } a = wave_sum(a, lane); if (lane == 0) st[2] = 1.0f / sqrtf(a * (1.f / 32.f) + EPS); }
        __syncthreads();
        if (tid < 384) {
            const uint4* w = (const uint4*)(WuqT + (size_t)tid * 256);
            float a = 0.f;
            for (int c = 0; c < 32; ++c) {
                const uint4 u = w[c]; const float* x = cq + c * 8;
                a += x[0] * lo16(u.x) + x[1] * hi16(u.x) + x[2] * lo16(u.y) + x[3] * hi16(u.y) + x[4] * lo16(u.z) + x[5] * hi16(u.z) + x[6] * lo16(u.w) + x[7] * hi16(u.w);
            }
            qf[tid] = a * st[0];
        }
        {
            const uint4* w = (const uint4*)(WukvT + (size_t)tid * 128);
            float a = 0.f;
            for (int c = 0; c < 16; ++c) {
                const uint4 u = w[c]; const float* x = ckv + c * 8;
                a += x[0] * lo16(u.x) + x[1] * hi16(u.x) + x[2] * lo16(u.y) + x[3] * hi16(u.y) + x[4] * lo16(u.z) + x[5] * hi16(u.z) + x[6] * lo16(u.w) + x[7] * hi16(u.w);
            }
            kvf[tid] = a * st[1];
        }
        __syncthreads();
        if (wave < 4) {
            float a = qf[wave * 96 + lane] * qf[wave * 96 + lane];
            if (lane < 32) { const float v = qf[wave * 96 + 64 + lane]; a += v * v; }
            a = wave_sum(a, lane); if (lane == 0) st[4 + wave] = 1.0f / sqrtf(a * (1.f / 96.f) + EPS);
        } else {
            const int h = wave - 4; const float v = kvf[h * 128 + lane]; float a = wave_sum(v * v, lane);
            if (lane == 0) st[8 + h] = 1.0f / sqrtf(a * (1.f / 64.f) + EPS);
        }
        __syncthreads();
        if (tid < 384) {
            const int h = tid / 96, d = tid % 96;
            float v = qf[tid] * st[4 + h] * q_g[d];
            if (d >= 64) {
                const int i = (d - 64) & 15; const bool first = (d - 64) < 16;
                const int pd = first ? d + 16 : d - 16;
                const float pv = qf[h * 96 + pd] * st[4 + h] * q_g[pd];
                const float c = cosA[s * 16 + i], sn = sinA[s * 16 + i];
                v = first ? v * c - pv * sn : v * c + pv * sn;
            }
            Qa[((size_t)h * S + s) * 96 + d] = (bf16_t)f2bf(v * QSCALE_A);
        }
        if (tid < 256) {
            const int h = tid >> 6, d = tid & 63;
            Ka[((size_t)h * S + s) * 96 + d] = (bf16_t)f2bf(kvf[h * 128 + d] * st[8 + h] * kn_g[d]);
        } else {
            const int t2 = tid - 256, h = t2 >> 6, d = t2 & 63;
            Va[((size_t)h * S + s) * 64 + d] = (bf16_t)f2bf(kvf[h * 128 + 64 + d]);
        }
        if (tid < 32) {
            const int i = tid & 15; const bool first = tid < 16; const int pd = first ? tid + 16 : tid - 16;
            const float v = kr[tid] * st[2] * kr_g[tid], pv = kr[pd] * st[2] * kr_g[pd];
            const float c = cosA[s * 16 + i], sn = sinA[s * 16 + i];
            const bf16_t o = (bf16_t)f2bf(first ? v * c - pv * sn : v * c + pv * sn);
            for (int h = 0; h < 4; ++h) Ka[((size_t)h * S + s) * 96 + 64 + tid] = o;
        }
    }
}

__device__ __forceinline__ void post_conv(const Ctx& cx, const Params& p, int l) {
    bf16_t* P = (bf16_t*)(p.ws + OFF_P);
    const float* cw = p.conv_w + l * 3 * 256;
    const int gtid = cx.bid * NT + cx.tid, GT = cx.nb * NT;
    for (int i = gtid; i < S * 256; i += GT) {
        const int t = i >> 8, c = i & 255;
        const bf16_t* row = P + (size_t)t * NP;
        float z0 = bf2f(row[C_CC + c]) * bf2f(row[C_CH + c]);
        float z1 = 0.f, z2 = 0.f;
        if (t >= 1) { const bf16_t* r1 = row - NP; z1 = bf2f(r1[C_CC + c]) * bf2f(r1[C_CH + c]); }
        if (t >= 2) { const bf16_t* r2 = row - 2 * NP; z2 = bf2f(r2[C_CC + c]) * bf2f(r2[C_CH + c]); }
        const float conv = cw[c] * z2 + cw[256 + c] * z1 + cw[512 + c] * z0;
        const float y = bf2f(row[C_CB + c]) * conv * silu(bf2f(row[C_GB + c]));
        P[(size_t)t * NP + C_GB + c] = (bf16_t)f2bf(y);
    }
}

__device__ __forceinline__ void post_sg(const Ctx& cx, const Params& p, int l, float* lds) {
    bf16_t* P = (bf16_t*)(p.ws + OFF_P);
    const bf16_t* SGW = (const bf16_t*)(p.ws + OFF_SGW) + (size_t)l * 4 * 128 * 128;
    const float* lng = p.ln_g + l * 256; const float* lnb = p.ln_b + l * 256; const float* sgb = p.sg_b + l * 4 * 128;
    float (*vn)[65] = (float (*)[65])lds;
    const int tid = cx.tid, r = tid >> 2, q4 = tid & 3, lane = tid & 63;
    for (int it = cx.bid; it < 128 * 4; it += cx.nb) {
        const int ch = it >> 2, g = it & 3;
        const size_t row = (size_t)ch * 128 + r;
        __syncthreads();
        float xv[64];
        {
            const uint4* src = (const uint4*)(P + row * NP + C_SV + q4 * 64);
#pragma unroll
            for (int c = 0; c < 8; ++c) { const uint4 u = src[c]; xv[c * 8 + 0] = lo16(u.x); xv[c * 8 + 1] = hi16(u.x); xv[c * 8 + 2] = lo16(u.y); xv[c * 8 + 3] = hi16(u.y); xv[c * 8 + 4] = lo16(u.z); xv[c * 8 + 5] = hi16(u.z); xv[c * 8 + 6] = lo16(u.w); xv[c * 8 + 7] = hi16(u.w); }
        }
        float sm = 0.f;
#pragma unroll
        for (int c = 0; c < 64; ++c) sm += xv[c];
        sm += shx(sm, 1, lane); sm += shx(sm, 2, lane);
        const float mu = sm * (1.f / 256.f);
        float sq = 0.f;
#pragma unroll
        for (int c = 0; c < 64; ++c) { const float d = xv[c] - mu; sq += d * d; }
        sq += shx(sq, 1, lane); sq += shx(sq, 2, lane);
        const float rs = 1.0f / sqrtf(sq * (1.f / 256.f) + EPS);
        if (q4 == g) {
#pragma unroll
            for (int c = 0; c < 64; ++c) vn[r][c] = (xv[c] - mu) * rs * lng[g * 64 + c] + lnb[g * 64 + c];
        }
        __syncthreads();
        float acc[16];
#pragma unroll
        for (int j = 0; j < 16; ++j) acc[j] = 0.f;
        const bf16_t* wrow = SGW + ((size_t)g * 128 + r) * 128;
        for (int s_ = 0; s_ <= r; ++s_) {
            const float w = bf2f(wrow[s_]);
#pragma unroll
            for (int j = 0; j < 16; ++j) acc[j] = fmaf(w, vn[s_][q4 * 16 + j], acc[j]);
        }
        const float bias = sgb[g * 128 + r];
        bf16_t* prow = P + row * NP;
#pragma unroll
        for (int j = 0; j < 16; ++j) {
            const int c = g * 64 + q4 * 16 + j;
            const float y = bf2f(prow[C_SU + c]) * (acc[j] + bias) * silu(bf2f(prow[C_GC + c]));
            prow[C_GC + c] = (bf16_t)f2bf(y);
        }
    }
}

__device__ __forceinline__ void post_moba(const Ctx& cx, const Params& p, int l, float* lds) {
    bf16_t* P = (bf16_t*)(p.ws + OFF_P);
    float* kmean = (float*)(p.ws + OFF_KMEAN);
    const float* cosD = (const float*)(p.ws + OFF_COSD); const float* sinD = (const float*)(p.ws + OFF_SIND);
    const float* mq_g = p.mq_g + l * 64; const float* mk_g = p.mk_g + l * 64;
    float (*kf)[65] = (float (*)[65])lds;
    const int tid = cx.tid;
    for (int it = cx.bid; it < 64 * 4; it += cx.nb) {
        const int n = it >> 2, h = it & 3;
        const bool isq = tid >= 256; const int r = tid & 255;
        const int srow = n * 256 + r;
        bf16_t* ptr = P + (size_t)srow * NP + (isq ? C_MQ : C_MK) + h * 64;
        const float* gg = isq ? mq_g : mk_g;
        float v[64];
        {
            const uint4* src = (const uint4*)ptr;
#pragma unroll
            for (int c = 0; c < 8; ++c) { const uint4 u = src[c]; v[c * 8 + 0] = lo16(u.x); v[c * 8 + 1] = hi16(u.x); v[c * 8 + 2] = lo16(u.y); v[c * 8 + 3] = hi16(u.y); v[c * 8 + 4] = lo16(u.z); v[c * 8 + 5] = hi16(u.z); v[c * 8 + 6] = lo16(u.w); v[c * 8 + 7] = hi16(u.w); }
        }
        float ss = 0.f;
#pragma unroll
        for (int c = 0; c < 64; ++c) ss += v[c] * v[c];
        const float rs = 1.0f / sqrtf(ss * (1.f / 64.f) + EPS);
#pragma unroll
        for (int c = 0; c < 64; ++c) v[c] = v[c] * rs * gg[c];
#pragma unroll
        for (int i = 0; i < 8; ++i) {
            const float c_ = cosD[srow * 8 + i], s_ = sinD[srow * 8 + i];
            const float a = v[i], b = v[i + 8];
            v[i] = a * c_ - b * s_; v[i + 8] = b * c_ + a * s_;
        }
        __syncthreads();
        if (!isq) {
#pragma unroll
            for (int c = 0; c < 64; ++c) kf[r][c] = v[c];
        }
        const float sc = isq ? QSCALE_D : 1.0f;
        {
            uint4* dst = (uint4*)ptr;
#pragma unroll
            for (int c = 0; c < 8; ++c) dst[c] = make_uint4(pk2(v[c * 8] * sc, v[c * 8 + 1] * sc), pk2(v[c * 8 + 2] * sc, v[c * 8 + 3] * sc), pk2(v[c * 8 + 4] * sc, v[c * 8 + 5] * sc), pk2(v[c * 8 + 6] * sc, v[c * 8 + 7] * sc));
        }
        __syncthreads();
        if (tid < 64) {
            float a = 0.f;
            for (int rr = 0; rr < 256; ++rr) a += kf[rr][tid];
            kmean[((size_t)h * 64 + n) * 64 + tid] = a * (1.f / 256.f);
        }
    }
}

__device__ __forceinline__ void phase_gate(const Ctx& cx, const Params& p, int l) {
    const bf16_t* P = (const bf16_t*)(p.ws + OFF_P);
    const float* kmean = (const float*)(p.ws + OFF_KMEAN);
    int* sel = (int*)(p.ws + OFF_SEL); int* mcnt = (int*)(p.ws + OFF_MCNT); int* mlist = (int*)(p.ws + OFF_LIST);
    const int gtid = cx.bid * NT + cx.tid, GT = cx.nb * NT;
    for (int i = gtid; i < 4 * S; i += GT) {
        const int h = i / S, s = i % S, qb = s >> 8;
        float q[64];
        {
            const uint4* src = (const uint4*)(P + (size_t)s * NP + C_MQ + h * 64);
#pragma unroll
            for (int c = 0; c < 8; ++c) { const uint4 u = src[c]; q[c * 8 + 0] = lo16(u.x); q[c * 8 + 1] = hi16(u.x); q[c * 8 + 2] = lo16(u.y); q[c * 8 + 3] = hi16(u.y); q[c * 8 + 4] = lo16(u.z); q[c * 8 + 5] = hi16(u.z); q[c * 8 + 6] = lo16(u.w); q[c * 8 + 7] = hi16(u.w); }
        }
        float b0 = -3.0e38f, b1 = -3.0e38f, b2 = -3.0e38f; int i0 = -1, i1 = -1, i2 = -1;
        for (int n = 0; n < qb; ++n) {
            const float* km = kmean + ((size_t)h * 64 + n) * 64;
            float g = 0.f;
#pragma unroll
            for (int c = 0; c < 64; ++c) g = fmaf(q[c], km[c], g);
            if (g > b0) { b2 = b1; i2 = i1; b1 = b0; i1 = i0; b0 = g; i0 = n; }
            else if (g > b1) { b2 = b1; i2 = i1; b1 = g; i1 = n; }
            else if (g > b2) { b2 = g; i2 = n; }
        }
        const int nv = qb < 3 ? qb : 3;
        *(int4*)(sel + (size_t)i * 4) = make_int4(i0, i1, i2, nv);
        const int lane = cx.tid & 63;
#pragma unroll 1
        for (int j = 0; j < 3; ++j) {
            const int n = j == 0 ? i0 : j == 1 ? i1 : i2; const bool valid = j < nv;
            unsigned long long todo = __ballot(valid);
            while (todo) {
                const int leader = __builtin_ctzll(todo);
                const int n0 = __builtin_amdgcn_readlane(n, leader);
                const bool mine = valid && n == n0;
                const unsigned long long m = __ballot(mine);
                const int rank = __builtin_popcountll(m & ((1ull << lane) - 1ull));
                int base = 0;
                if (lane == leader) base = atomicAdd(mcnt + h * 64 + n0, __builtin_popcountll(m));
                base = __builtin_amdgcn_readlane(base, leader);
                if (mine) mlist[(size_t)h * LIST_PER_HEAD + 256 * (63 * n0 - n0 * (n0 - 1) / 2) + base + rank] = (s << 2) | j;
                todo &= ~m;
            }
        }
    }
}

__device__ __forceinline__ void attn_mla_naive(const Ctx& cx, const Params& p, int l, float* lds) {
    unsigned char* ws = p.ws;
    bf16_t* P = (bf16_t*)(ws + OFF_P);
    const bf16_t* Qa = (const bf16_t*)(ws + OFF_QA); const bf16_t* Ka = (const bf16_t*)(ws + OFF_KA); const bf16_t* Va = (const bf16_t*)(ws + OFF_VA);
    float (*Ks)[100] = (float (*)[100])lds;
    float (*Vs)[68] = (float (*)[68])(lds + 64 * 100);
    float c2;
    {
        float gq = 0.f, gn = 0.f, gr = 0.f;
        for (int d = 0; d < 96; ++d) gq = fmaxf(gq, fabsf(p.q_g[l * 96 + d]));
        for (int d = 0; d < 64; ++d) gn = fmaxf(gn, fabsf(p.kn_g[l * 64 + d]));
        for (int d = 0; d < 32; ++d) gr = fmaxf(gr, fabsf(p.kr_g[l * 32 + d]));
        c2 = gq * sqrtf(64.f * gn * gn + 32.f * gr * gr) * LOG2E * 1.02f;
    }
    const int tid = cx.tid, qi = tid >> 2, part = tid & 3, lane = tid & 63;
    for (int it = cx.bid; it < 512; it += cx.nb) {
        const int pi = it & 255, sec = it >> 8, h = pi >> 6, j = pi & 63, i = sec ? 127 - j : j;
        const int qrow = i * 128 + qi;
        float q[96];
        {
            const uint4* src = (const uint4*)(Qa + ((size_t)h * S + qrow) * 96);
#pragma unroll
            for (int c = 0; c < 12; ++c) { const uint4 u = src[c]; q[c * 8 + 0] = lo16(u.x); q[c * 8 + 1] = hi16(u.x); q[c * 8 + 2] = lo16(u.y); q[c * 8 + 3] = hi16(u.y); q[c * 8 + 4] = lo16(u.z); q[c * 8 + 5] = hi16(u.z); q[c * 8 + 6] = lo16(u.w); q[c * 8 + 7] = hi16(u.w); }
        }
        float o[64];
#pragma unroll
        for (int d = 0; d < 64; ++d) o[d] = 0.f;
        float lsum = 0.f;
        const int ntiles = 2 * (i + 1);
        for (int kt = 0; kt < ntiles; ++kt) {
            __syncthreads();
            for (int c = tid; c < 768; c += NT) {
                const int key = c / 12, chn = c % 12;
                const uint4 u = *(const uint4*)(Ka + ((size_t)h * S + kt * 64 + key) * 96 + chn * 8);
                float* d_ = &Ks[key][chn * 8];
                d_[0] = lo16(u.x); d_[1] = hi16(u.x); d_[2] = lo16(u.y); d_[3] = hi16(u.y); d_[4] = lo16(u.z); d_[5] = hi16(u.z); d_[6] = lo16(u.w); d_[7] = hi16(u.w);
            }
            {
                const int key = tid >> 3, chn = tid & 7;
                const uint4 u = *(const uint4*)(Va + ((size_t)h * S + kt * 64 + key) * 64 + chn * 8);
                float* d_ = &Vs[key][chn * 8];
                d_[0] = lo16(u.x); d_[1] = hi16(u.x); d_[2] = lo16(u.y); d_[3] = hi16(u.y); d_[4] = lo16(u.z); d_[5] = hi16(u.z); d_[6] = lo16(u.w); d_[7] = hi16(u.w);
            }
            __syncthreads();
            for (int kk = 0; kk < 16; ++kk) {
                const int key = part + 4 * kk, kpos = kt * 64 + key;
                float sc = 0.f;
#pragma unroll
                for (int d = 0; d < 96; d += 4) { const float4 kv = *(const float4*)&Ks[key][d]; sc = fmaf(q[d], kv.x, sc); sc = fmaf(q[d + 1], kv.y, sc); sc = fmaf(q[d + 2], kv.z, sc); sc = fmaf(q[d + 3], kv.w, sc); }
                const float pr = (kpos <= qrow) ? exp2f(sc - c2) : 0.f;
                lsum += pr;
#pragma unroll
                for (int d = 0; d < 64; d += 4) { const float4 vv = *(const float4*)&Vs[key][d]; o[d] = fmaf(pr, vv.x, o[d]); o[d + 1] = fmaf(pr, vv.y, o[d + 1]); o[d + 2] = fmaf(pr, vv.z, o[d + 2]); o[d + 3] = fmaf(pr, vv.w, o[d + 3]); }
            }
        }
        lsum += shx(lsum, 1, lane); lsum += shx(lsum, 2, lane);
        const float inv = 1.0f / lsum;
        bf16_t* prow = P + (size_t)qrow * NP + C_GA + h * 64;
#pragma unroll
        for (int d = 0; d < 64; ++d) {
            float v = o[d]; v += shx(v, 1, lane); v += shx(v, 2, lane);
            if ((d >> 4) == part) { const float g = bf2f(prow[d]); prow[d] = (bf16_t)f2bf(v * inv * silu(g)); }
        }
    }
}

__device__ __forceinline__ void attn_moba_naive(const Ctx& cx, const Params& p, int l) {
    bf16_t* P = (bf16_t*)(p.ws + OFF_P);
    const int* sel = (const int*)(p.ws + OFF_SEL);
    float c2;
    {
        float gq = 0.f, gk = 0.f;
        for (int d = 0; d < 64; ++d) { gq = fmaxf(gq, fabsf(p.mq_g[l * 64 + d])); gk = fmaxf(gk, fabsf(p.mk_g[l * 64 + d])); }
        c2 = gq * gk * 8.0f * LOG2E * 1.02f;
    }
    const int wave = cx.tid >> 6, lane = cx.tid & 63;
    const int gw = cx.bid * (NT / 64) + wave, NGW = cx.nb * (NT / 64);
    for (int it = gw; it < 4 * S; it += NGW) {
        const int h = it / S, s = it % S, own = s >> 8;
        float q[64];
        {
            const uint4* src = (const uint4*)(P + (size_t)s * NP + C_MQ + h * 64);
#pragma unroll
            for (int c = 0; c < 8; ++c) { const uint4 u = src[c]; q[c * 8 + 0] = lo16(u.x); q[c * 8 + 1] = hi16(u.x); q[c * 8 + 2] = lo16(u.y); q[c * 8 + 3] = hi16(u.y); q[c * 8 + 4] = lo16(u.z); q[c * 8 + 5] = hi16(u.z); q[c * 8 + 6] = lo16(u.w); q[c * 8 + 7] = hi16(u.w); }
        }
        const int4 sl = *(const int4*)(sel + (size_t)it * 4);
        float o[64];
#pragma unroll
        for (int d = 0; d < 64; ++d) o[d] = 0.f;
        float lsum = 0.f;
        const int nsel = sl.w;
#pragma unroll 1
        for (int bi = 3 - nsel; bi < 4; ++bi) {
            const int sidx = 2 - bi;
            const int blk = bi == 3 ? own : (sidx == 0 ? sl.x : sidx == 1 ? sl.y : sl.z);
#pragma unroll 1
            for (int jj = 0; jj < 4; ++jj) {
                const int kpos = blk * 256 + lane + 64 * jj;
                const uint4* kp = (const uint4*)(P + (size_t)kpos * NP + C_MK + h * 64);
                float sc = 0.f;
#pragma unroll
                for (int c = 0; c < 8; ++c) { const uint4 u = kp[c]; sc += q[c * 8] * lo16(u.x) + q[c * 8 + 1] * hi16(u.x) + q[c * 8 + 2] * lo16(u.y) + q[c * 8 + 3] * hi16(u.y) + q[c * 8 + 4] * lo16(u.z) + q[c * 8 + 5] * hi16(u.z) + q[c * 8 + 6] * lo16(u.w) + q[c * 8 + 7] * hi16(u.w); }
                const bool ok = (bi != 3) || (kpos <= s);
                const float pr = ok ? exp2f(sc - c2) : 0.f;
                lsum += pr;
                const uint4* vp = (const uint4*)(P + (size_t)kpos * NP + C_MV + h * 64);
#pragma unroll
                for (int c = 0; c < 8; ++c) { const uint4 u = vp[c]; o[c * 8] = fmaf(pr, lo16(u.x), o[c * 8]); o[c * 8 + 1] = fmaf(pr, hi16(u.x), o[c * 8 + 1]); o[c * 8 + 2] = fmaf(pr, lo16(u.y), o[c * 8 + 2]); o[c * 8 + 3] = fmaf(pr, hi16(u.y), o[c * 8 + 3]); o[c * 8 + 4] = fmaf(pr, lo16(u.z), o[c * 8 + 4]); o[c * 8 + 5] = fmaf(pr, hi16(u.z), o[c * 8 + 5]); o[c * 8 + 6] = fmaf(pr, lo16(u.w), o[c * 8 + 6]); o[c * 8 + 7] = fmaf(pr, hi16(u.w), o[c * 8 + 7]); }
            }
        }
        lsum = wave_sum(lsum, lane);
        float r32[32], r16[16], r8[8], r4[4], r2[2];
#pragma unroll
        for (int d = 0; d < 32; ++d) { const bool hb = (lane & 32) != 0; const float keep = hb ? o[d + 32] : o[d], send = hb ? o[d] : o[d + 32]; r32[d] = keep + shx(send, 32, lane); }
#pragma unroll
        for (int d = 0; d < 16; ++d) { const bool hb = (lane & 16) != 0; const float keep = hb ? r32[d + 16] : r32[d], send = hb ? r32[d] : r32[d + 16]; r16[d] = keep + shx(send, 16, lane); }
#pragma unroll
        for (int d = 0; d < 8; ++d) { const bool hb = (lane & 8) != 0; const float keep = hb ? r16[d + 8] : r16[d], send = hb ? r16[d] : r16[d + 8]; r8[d] = keep + shx(send, 8, lane); }
#pragma unroll
        for (int d = 0; d < 4; ++d) { const bool hb = (lane & 4) != 0; const float keep = hb ? r8[d + 4] : r8[d], send = hb ? r8[d] : r8[d + 4]; r4[d] = keep + shx(send, 4, lane); }
#pragma unroll
        for (int d = 0; d < 2; ++d) { const bool hb = (lane & 2) != 0; const float keep = hb ? r4[d + 2] : r4[d], send = hb ? r4[d] : r4[d + 2]; r2[d] = keep + shx(send, 2, lane); }
        float mine;
        { const bool hb = (lane & 1) != 0; const float keep = hb ? r2[1] : r2[0], send = hb ? r2[0] : r2[1]; mine = keep + shx(send, 1, lane); }
        bf16_t* gp = P + (size_t)s * NP + C_GD + h * 64 + lane;
        const float g = bf2f(*gp);
        *gp = (bf16_t)f2bf(mine / lsum * silu(g));
    }
}


namespace mla {
typedef short bf16x8 __attribute__((ext_vector_type(8)));
typedef short s16x4 __attribute__((ext_vector_type(4)));
typedef float f32x16 __attribute__((ext_vector_type(16)));
typedef unsigned u32x4 __attribute__((ext_vector_type(4)));
#define LAS3 __attribute__((address_space(3)))
constexpr int KT_BYTES = 12288, VT_BYTES = 8192, STAGE_BYTES = 2 * KT_BYTES + 2 * VT_BYTES;
constexpr int OFF_OCOMB = 2 * STAGE_BYTES, OFF_LCOMB = OFF_OCOMB + 32768, OFF_WSF = OFF_LCOMB + 512, OFF_OST = OFF_WSF + 512, MLA_LDS_END = OFF_OST + 16384;
static_assert(MLA_LDS_END <= LDS_BYTES, "mla lds");
__device__ __forceinline__ int crow(int r, int hi) { return (r & 3) + 8 * (r >> 2) + 4 * hi; }
__device__ __forceinline__ s16x4 vtr(const LAS3 unsigned char* p) { typedef short v4i16_t __attribute__((ext_vector_type(4))); return __builtin_bit_cast(s16x4, __builtin_amdgcn_ds_read_tr16_b64_v4i16((LAS3 v4i16_t*)p)); }
__device__ __forceinline__ unsigned cvtpk(float lo, float hi) { typedef float f32x2_t __attribute__((ext_vector_type(2))); typedef __bf16 bf16x2_t __attribute__((ext_vector_type(2))); f32x2_t v = {lo, hi}; bf16x2_t b = __builtin_convertvector(v, bf16x2_t); return __builtin_bit_cast(unsigned, b); }

__device__ __forceinline__ void attn_mla_fast(const Ctx& cx, const Params& p, int l, unsigned char* lds_generic) {
    unsigned char* ws = p.ws;
    bf16_t* P = (bf16_t*)(ws + OFF_P);
    const bf16_t* Qa = (const bf16_t*)(ws + OFF_QA); const bf16_t* Ka = (const bf16_t*)(ws + OFF_KA); const bf16_t* Va = (const bf16_t*)(ws + OFF_VA);
    LAS3 unsigned char* lds = (LAS3 unsigned char*)lds_generic;
    float c2;
    {
        float gq = 0.f, gn = 0.f, gr = 0.f;
        for (int d = 0; d < 96; ++d) gq = fmaxf(gq, fabsf(p.q_g[l * 96 + d]));
        for (int d = 0; d < 64; ++d) gn = fmaxf(gn, fabsf(p.kn_g[l * 64 + d]));
        for (int d = 0; d < 32; ++d) gr = fmaxf(gr, fabsf(p.kr_g[l * 32 + d]));
        c2 = gq * sqrtf(64.f * gn * gn + 32.f * gr * gr) * LOG2E * 1.02f;
    }
    const int tid = cx.tid, lane = tid & 63, r32 = lane & 31, hi = lane >> 5;
    const int wave = __builtin_amdgcn_readfirstlane(tid >> 6), grp = wave >> 2, w = wave & 3;
    int kgo[3], klo[3];
#pragma unroll
    for (int j = 0; j < 3; ++j) { const int idx = tid + 512 * j, tile = idx / 768, rem = idx % 768, c = rem >> 6, key = rem & 63; kgo[j] = (tile * 64 + key) * 96 + c * 8; klo[j] = tile * KT_BYTES + c * 1024 + key * 16; }
    const int vkey = tid >> 3, vdc = tid & 7;
    const int vgo = vkey * 64 + vdc * 8, vlo_ = 2 * KT_BYTES + (vdc >> 2) * 4096 + (vkey >> 4) * 1024 + (vkey & 15) * 64 + (vdc & 3) * 16;
    const int kfrag = hi * 1024 + r32 * 16;
    const int vfrag = ((lane >> 4) & 1) * 32 + (lane & 3) * 8 + (4 * hi + ((lane & 15) >> 2)) * 64;
    for (int it = cx.bid; it < 512; it += cx.nb) {
        const int pi = it & 255, sec = it >> 8, h = pi >> 6, jj = pi & 63, i = sec ? 127 - jj : jj;
        const int q0 = i * 128, qrow = q0 + 32 * w + r32, nsteps = i + 1;
        const bf16_t* Kh = Ka + (size_t)h * S * 96; const bf16_t* Vh = Va + (size_t)h * S * 64;
        bf16x8 qr[6];
#pragma unroll
        for (int d0 = 0; d0 < 6; ++d0) qr[d0] = *(const bf16x8*)(Qa + ((size_t)h * S + qrow) * 96 + d0 * 16 + hi * 8);
        f32x16 o0, o1;
#pragma unroll
        for (int r = 0; r < 16; ++r) { o0[r] = 0.f; o1[r] = 0.f; }
        float lsum = 0.f;
        u32x4 kreg[3], vreg[2];
#define MLA_LOADG(st) do { const bf16_t* kb_ = Kh + (size_t)(st) * 128 * 96; const bf16_t* vb_ = Vh + (size_t)(st) * 128 * 64; \
            _Pragma("unroll") for (int j = 0; j < 3; ++j) kreg[j] = *(const u32x4*)(kb_ + kgo[j]); \
            vreg[0] = *(const u32x4*)(vb_ + vgo); vreg[1] = *(const u32x4*)(vb_ + 64 * 64 + vgo); } while (0)
#define MLA_WRITEL(sb) do { LAS3 unsigned char* b_ = lds + (sb) * STAGE_BYTES; \
            _Pragma("unroll") for (int j = 0; j < 3; ++j) *(LAS3 u32x4*)(b_ + klo[j]) = kreg[j]; \
            *(LAS3 u32x4*)(b_ + vlo_) = vreg[0]; *(LAS3 u32x4*)(b_ + vlo_ + VT_BYTES) = vreg[1]; } while (0)
        __syncthreads();
        MLA_LOADG(0); MLA_WRITEL(0);
        __syncthreads();
        for (int s = 0; s < nsteps; ++s) {
            const bool more = (s + 1 < nsteps), last = !more;
            if (more) MLA_LOADG(s + 1);
            const LAS3 unsigned char* Kt = lds + (s & 1) * STAGE_BYTES + grp * KT_BYTES;
            const LAS3 unsigned char* Vt = lds + (s & 1) * STAGE_BYTES + 2 * KT_BYTES + grp * VT_BYTES;
            const bool active = !(last && grp == 1 && w < 2);
            if (active) {
                f32x16 p0, p1;
#pragma unroll
                for (int r = 0; r < 16; ++r) { p0[r] = -c2; p1[r] = -c2; }
#pragma unroll
                for (int d0 = 0; d0 < 6; ++d0) {
                    const bf16x8 a0 = *(const LAS3 bf16x8*)(Kt + kfrag + d0 * 2048);
                    const bf16x8 a1 = *(const LAS3 bf16x8*)(Kt + kfrag + d0 * 2048 + 512);
                    p0 = __builtin_amdgcn_mfma_f32_32x32x16_bf16(a0, qr[d0], p0, 0, 0, 0);
                    p1 = __builtin_amdgcn_mfma_f32_32x32x16_bf16(a1, qr[d0], p1, 0, 0, 0);
                }
                if (last) {
                    const int kbase = s * 128 + grp * 64 + 4 * hi;
#pragma unroll
                    for (int r = 0; r < 16; ++r) { const int kv = kbase + (r & 3) + 8 * (r >> 2); if (kv > qrow) p0[r] = -INFINITY; if (kv + 32 > qrow) p1[r] = -INFINITY; }
                }
                float sacc = 0.f;
#pragma unroll
                for (int r = 0; r < 16; ++r) { p0[r] = __builtin_amdgcn_exp2f(p0[r]); p1[r] = __builtin_amdgcn_exp2f(p1[r]); sacc += p0[r] + p1[r]; }
                lsum += sacc;
                u32x4 pw[4];
                pw[0] = (u32x4){cvtpk(p0[0], p0[1]), cvtpk(p0[2], p0[3]), cvtpk(p0[4], p0[5]), cvtpk(p0[6], p0[7])};
                pw[1] = (u32x4){cvtpk(p0[8], p0[9]), cvtpk(p0[10], p0[11]), cvtpk(p0[12], p0[13]), cvtpk(p0[14], p0[15])};
                pw[2] = (u32x4){cvtpk(p1[0], p1[1]), cvtpk(p1[2], p1[3]), cvtpk(p1[4], p1[5]), cvtpk(p1[6], p1[7])};
                pw[3] = (u32x4){cvtpk(p1[8], p1[9]), cvtpk(p1[10], p1[11]), cvtpk(p1[12], p1[13]), cvtpk(p1[14], p1[15])};
#pragma unroll
                for (int ks = 0; ks < 4; ++ks) {
                    const s16x4 l0 = vtr(Vt + vfrag + ks * 1024), h0 = vtr(Vt + vfrag + ks * 1024 + 512);
                    const s16x4 l1 = vtr(Vt + vfrag + 4096 + ks * 1024), h1 = vtr(Vt + vfrag + 4096 + ks * 1024 + 512);
                    const bf16x8 b0 = (bf16x8){l0[0], l0[1], l0[2], l0[3], h0[0], h0[1], h0[2], h0[3]};
                    const bf16x8 b1 = (bf16x8){l1[0], l1[1], l1[2], l1[3], h1[0], h1[1], h1[2], h1[3]};
                    const bf16x8 pa = __builtin_bit_cast(bf16x8, pw[ks]);
                    o0 = __builtin_amdgcn_mfma_f32_32x32x16_bf16(pa, b0, o0, 0, 0, 0);
                    o1 = __builtin_amdgcn_mfma_f32_32x32x16_bf16(pa, b1, o1, 0, 0, 0);
                }
            }
            if (more) MLA_WRITEL((s + 1) & 1);
            __syncthreads();
        }
#undef MLA_LOADG
#undef MLA_WRITEL
        lsum += shx(lsum, 32, lane);
        LAS3 float* Ocomb = (LAS3 float*)(lds + OFF_OCOMB) + w * 2048;
        LAS3 float* lcomb = (LAS3 float*)(lds + OFF_LCOMB) + w * 32;
        LAS3 float* wsf = (LAS3 float*)(lds + OFF_WSF) + w * 32;
        LAS3 bf16_t* Ost = (LAS3 bf16_t*)(lds + OFF_OST);
        if (grp == 1) {
#pragma unroll
            for (int r = 0; r < 16; ++r) { Ocomb[r * 64 + lane] = o0[r]; Ocomb[1024 + r * 64 + lane] = o1[r]; }
            if (hi == 0) lcomb[r32] = lsum;
        }
        __syncthreads();
        if (grp == 0) {
#pragma unroll
            for (int r = 0; r < 16; ++r) { o0[r] += Ocomb[r * 64 + lane]; o1[r] += Ocomb[1024 + r * 64 + lane]; }
            lsum += lcomb[r32];
            if (hi == 0) wsf[r32] = lsum;
            __builtin_amdgcn_s_waitcnt(0xC07F);
#pragma unroll
            for (int r = 0; r < 16; ++r) {
                const int orow = crow(r, hi); const float rl = 1.0f / wsf[orow];
                Ost[(32 * w + orow) * 64 + r32] = (bf16_t)f2bf(o0[r] * rl);
                Ost[(32 * w + orow) * 64 + 32 + r32] = (bf16_t)f2bf(o1[r] * rl);
            }
        }
        __syncthreads();
#pragma unroll
        for (int j = 0; j < 2; ++j) {
            const int chunk = tid + 512 * j, row = chunk >> 3, dc = chunk & 7;
            const u32x4 ov = *(const LAS3 u32x4*)(Ost + row * 64 + dc * 8);
            bf16_t* gp = P + (size_t)(q0 + row) * NP + C_GA + h * 64 + dc * 8;
            const uint4 gv = *(const uint4*)gp;
            uint4 y;
            y.x = pk2(lo16(ov.x) * silu(lo16(gv.x)), hi16(ov.x) * silu(hi16(gv.x)));
            y.y = pk2(lo16(ov.y) * silu(lo16(gv.y)), hi16(ov.y) * silu(hi16(gv.y)));
            y.z = pk2(lo16(ov.z) * silu(lo16(gv.z)), hi16(ov.z) * silu(hi16(gv.z)));
            y.w = pk2(lo16(ov.w) * silu(lo16(gv.w)), hi16(ov.w) * silu(hi16(gv.w)));
            *(uint4*)gp = y;
        }
    }
}
}


namespace moba {
using mla::bf16x8; using mla::s16x4; using mla::f32x16; using mla::u32x4; using mla::crow; using mla::vtr; using mla::cvtpk;
constexpr int KV_BYTES = 65536, OFF_MWSF = KV_BYTES, OFF_MPRE = OFF_MWSF + 1024;
template <bool OWN>
__device__ __forceinline__ void block_item(const Ctx& cx, const Params& p, int l, LAS3 unsigned char* lds, float c2, int h, int n, const int* lst, int cnt, int cstart) {
    bf16_t* P = (bf16_t*)(p.ws + OFF_P);
    bf16_t* part = (bf16_t*)(p.ws + OFF_PART); float* lpart = (float*)(p.ws + OFF_LPART);
    const int tid = cx.tid, lane = tid & 63, r32 = lane & 31, hi = lane >> 5;
    const int w = __builtin_amdgcn_readfirstlane(tid >> 6);
    __syncthreads();
    {
        const bf16_t* kb = P + (size_t)n * 256 * NP + C_MK + h * 64; const bf16_t* vb = P + (size_t)n * 256 * NP + C_MV + h * 64;
        u32x4 kr[4], vr[4];
#pragma unroll
        for (int j = 0; j < 4; ++j) { const int idx = tid + 512 * j, tile = idx >> 9, c = (idx & 511) >> 6, key = idx & 63; kr[j] = *(const u32x4*)(kb + (size_t)(tile * 64 + key) * NP + c * 8); }
#pragma unroll
        for (int j = 0; j < 4; ++j) { const int key = tid >> 3, dc = tid & 7; vr[j] = *(const u32x4*)(vb + (size_t)(j * 64 + key) * NP + dc * 8); }
#pragma unroll
        for (int j = 0; j < 4; ++j) { const int idx = tid + 512 * j, tile = idx >> 9, c = (idx & 511) >> 6, key = idx & 63; *(LAS3 u32x4*)(lds + tile * 8192 + c * 1024 + key * 16) = kr[j]; }
#pragma unroll
        for (int j = 0; j < 4; ++j) { const int key = tid >> 3, dc = tid & 7; *(LAS3 u32x4*)(lds + 32768 + j * 8192 + (dc >> 2) * 4096 + (key >> 4) * 1024 + (key & 15) * 64 + (dc & 3) * 16) = vr[j]; }
    }
    const int rr = 32 * w + r32;
    int entry = 0; bool valid = true;
    if (!OWN) { const int e = cstart + rr; valid = e < cnt; entry = lst[valid ? e : cstart]; }
    const int srow = OWN ? n * 256 + rr : (entry >> 2);
    bf16x8 qr[4];
#pragma unroll
    for (int d0 = 0; d0 < 4; ++d0) qr[d0] = *(const bf16x8*)(P + (size_t)srow * NP + C_MQ + h * 64 + d0 * 16 + hi * 8);
    f32x16 o0, o1;
#pragma unroll
    for (int r = 0; r < 16; ++r) { o0[r] = 0.f; o1[r] = 0.f; }
    float lsum = 0.f;
    const int kfrag = hi * 1024 + r32 * 16;
    const int vfrag = ((lane >> 4) & 1) * 32 + (lane & 3) * 8 + (4 * hi + ((lane & 15) >> 2)) * 64;
    const int tmax = OWN ? (w >> 1) : 3;
    __syncthreads();
#pragma unroll 1
    for (int t = 0; t <= tmax; ++t) {
        const LAS3 unsigned char* Kt = lds + t * 8192; const LAS3 unsigned char* Vt = lds + 32768 + t * 8192;
        f32x16 p0, p1;
#pragma unroll
        for (int r = 0; r < 16; ++r) { p0[r] = -c2; p1[r] = -c2; }
#pragma unroll
        for (int d0 = 0; d0 < 4; ++d0) {
            const bf16x8 a0 = *(const LAS3 bf16x8*)(Kt + kfrag + d0 * 2048);
            const bf16x8 a1 = *(const LAS3 bf16x8*)(Kt + kfrag + d0 * 2048 + 512);
            p0 = __builtin_amdgcn_mfma_f32_32x32x16_bf16(a0, qr[d0], p0, 0, 0, 0);
            p1 = __builtin_amdgcn_mfma_f32_32x32x16_bf16(a1, qr[d0], p1, 0, 0, 0);
        }
        if (OWN && t == tmax) {
            const int kbase = t * 64 + 4 * hi;
#pragma unroll
            for (int r = 0; r < 16; ++r) { const int kv = kbase + (r & 3) + 8 * (r >> 2); if (kv > rr) p0[r] = -INFINITY; if (kv + 32 > rr) p1[r] = -INFINITY; }
        }
        float sacc = 0.f;
#pragma unroll
        for (int r = 0; r < 16; ++r) { p0[r] = __builtin_amdgcn_exp2f(p0[r]); p1[r] = __builtin_amdgcn_exp2f(p1[r]); sacc += p0[r] + p1[r]; }
        lsum += sacc;
        u32x4 pw[4];
        pw[0] = (u32x4){cvtpk(p0[0], p0[1]), cvtpk(p0[2], p0[3]), cvtpk(p0[4], p0[5]), cvtpk(p0[6], p0[7])};
        pw[1] = (u32x4){cvtpk(p0[8], p0[9]), cvtpk(p0[10], p0[11]), cvtpk(p0[12], p0[13]), cvtpk(p0[14], p0[15])};
        pw[2] = (u32x4){cvtpk(p1[0], p1[1]), cvtpk(p1[2], p1[3]), cvtpk(p1[4], p1[5]), cvtpk(p1[6], p1[7])};
        pw[3] = (u32x4){cvtpk(p1[8], p1[9]), cvtpk(p1[10], p1[11]), cvtpk(p1[12], p1[13]), cvtpk(p1[14], p1[15])};
#pragma unroll
        for (int ks = 0; ks < 4; ++ks) {
            const s16x4 l0 = vtr(Vt + vfrag + ks * 1024), h0 = vtr(Vt + vfrag + ks * 1024 + 512);
            const s16x4 l1 = vtr(Vt + vfrag + 4096 + ks * 1024), h1 = vtr(Vt + vfrag + 4096 + ks * 1024 + 512);
            const bf16x8 b0 = (bf16x8){l0[0], l0[1], l0[2], l0[3], h0[0], h0[1], h0[2], h0[3]};
            const bf16x8 b1 = (bf16x8){l1[0], l1[1], l1[2], l1[3], h1[0], h1[1], h1[2], h1[3]};
            const bf16x8 pa = __builtin_bit_cast(bf16x8, pw[ks]);
            o0 = __builtin_amdgcn_mfma_f32_32x32x16_bf16(pa, b0, o0, 0, 0, 0);
            o1 = __builtin_amdgcn_mfma_f32_32x32x16_bf16(pa, b1, o1, 0, 0, 0);
        }
    }
    lsum += shx(lsum, 32, lane);
    if (!OWN) {
        const int dst = valid ? (h * S + (entry >> 2)) * 3 + (entry & 3) : -1;
        if (hi == 0 && valid) lpart[dst] = lsum;
#pragma unroll
        for (int r = 0; r < 16; ++r) {
            const int q = crow(r, hi);
            const int dq = __builtin_amdgcn_ds_bpermute(q << 2, dst);
            if (dq >= 0) { bf16_t* o = part + (size_t)dq * 64; o[r32] = (bf16_t)f2bf(o0[r]); o[32 + r32] = (bf16_t)f2bf(o1[r]); }
        }
    } else {
        const int nsel = n < 3 ? n : 3;
        const size_t pb = ((size_t)h * S + srow) * 3;
        for (int j = 0; j < nsel; ++j) lsum += lpart[pb + j];
        LAS3 float* wsf = (LAS3 float*)(lds + OFF_MWSF) + w * 32;
        if (hi == 0) wsf[r32] = lsum;
        __builtin_amdgcn_s_waitcnt(0xC07F);
#pragma unroll
        for (int r = 0; r < 16; ++r) {
            const int q = crow(r, hi); const int sq = n * 256 + 32 * w + q;
            float a0 = o0[r], a1 = o1[r];
            const bf16_t* pp = part + ((size_t)h * S + sq) * 3 * 64;
            for (int j = 0; j < nsel; ++j) { a0 += bf2f(pp[j * 64 + r32]); a1 += bf2f(pp[j * 64 + 32 + r32]); }
            const float rl = 1.0f / wsf[q];
            bf16_t* gp = P + (size_t)sq * NP + C_GD + h * 64;
            gp[r32] = (bf16_t)f2bf(a0 * rl * silu(bf2f(gp[r32])));
            gp[32 + r32] = (bf16_t)f2bf(a1 * rl * silu(bf2f(gp[32 + r32])));
        }
    }
}
__device__ __forceinline__ float c2_bound(const Params& p, int l) {
    float gq = 0.f, gk = 0.f;
    for (int d = 0; d < 64; ++d) { gq = fmaxf(gq, fabsf(p.mq_g[l * 64 + d])); gk = fmaxf(gk, fabsf(p.mk_g[l * 64 + d])); }
    return gq * gk * 8.0f * LOG2E * 1.02f;
}
__device__ __forceinline__ void gather_items(const Ctx& cx, const Params& p, int l, unsigned char* lds_generic) {
    LAS3 unsigned char* lds = (LAS3 unsigned char*)lds_generic;
    const int* mcnt = (const int*)(p.ws + OFF_MCNT); const int* mlist = (const int*)(p.ws + OFF_LIST);
    LAS3 int* pre = (LAS3 int*)(lds + OFF_MPRE);
    const float c2 = c2_bound(p, l);
    __syncthreads();
    if (cx.tid == 0) { int acc = 0; for (int i = 0; i < 256; ++i) { pre[i] = acc; acc += (mcnt[i] + 255) >> 8; } pre[256] = acc; }
    __syncthreads();
    const int total = pre[256];
    for (int c = cx.bid; c < total; c += cx.nb) {
        int lo = 0, hi_ = 255;
        while (lo < hi_) { const int mid = (lo + hi_ + 1) >> 1; if (pre[mid] <= c) lo = mid; else hi_ = mid - 1; }
        const int pair = lo, h = pair >> 6, n = pair & 63, cstart = (c - pre[pair]) * 256;
        block_item<false>(cx, p, l, lds, c2, h, n, mlist + (size_t)h * LIST_PER_HEAD + 256 * (63 * n - n * (n - 1) / 2), mcnt[pair], cstart);
    }
}
__device__ __forceinline__ void own_items(const Ctx& cx, const Params& p, int l, unsigned char* lds_generic) {
    LAS3 unsigned char* lds = (LAS3 unsigned char*)lds_generic;
    const float c2 = c2_bound(p, l);
    for (int it = cx.bid; it < 256; it += cx.nb) block_item<true>(cx, p, l, lds, c2, it >> 6, it & 63, nullptr, 0, 0);
}
}

#ifdef PROBE_CHECK
constexpr size_t OFF_T1 = OFF_END, OFF_T2 = OFF_END + (size_t)S * 256 * 2, OFF_CNT = 1024;
__device__ __forceinline__ void probe_cols(const Ctx& cx, const Params& p, int col, int dir) {
    bf16_t* P = (bf16_t*)(p.ws + OFF_P); bf16_t* T1 = (bf16_t*)(p.ws + OFF_T1); bf16_t* T2 = (bf16_t*)(p.ws + OFF_T2);
    unsigned* cnt = (unsigned*)(p.ws + OFF_CNT);
    const int gtid = cx.bid * NT + cx.tid, GT = cx.nb * NT;
    unsigned bad = 0;
    for (int i = gtid; i < S * 256; i += GT) {
        const int t = i >> 8, c = i & 255; bf16_t* pp = P + (size_t)t * NP + col + c;
        if (dir == 0) T1[i] = *pp;
        else if (dir == 1) { T2[i] = *pp; *pp = T1[i]; }
        else { const float a = bf2f(*pp), b = bf2f(T2[i]); const float d = fabsf(a - b); if (!(d <= 0.03f * fmaxf(fabsf(a), fabsf(b)) + PROBE_ABS)) ++bad; }
    }
    if (dir == 2 && bad) atomicAdd(cnt, bad);
}
__device__ __forceinline__ void probe_poison(const Ctx& cx, const Params& p) {
    const unsigned c = *(volatile unsigned*)(p.ws + OFF_CNT);
    if (cx.bid == 0 && cx.tid == 0 && c) p.out[0] += (float)c;
}
#endif


#define XB_TMO      128
#define XB_XCNT(j)  (256  + 64 * (j))
#define XB_XSUB(j)  (1280 + 64 * (j))
#define XB_XGEN(j)  (2304 + 64 * (j))
#define XB_TOP      3328
#define XB_TOPGEN   3392
#define XB_SPIN_CAP (1u << 20)
constexpr size_t OFF_BAR = 16384;
__device__ __forceinline__ unsigned xb_ld(unsigned* p)              { return __hip_atomic_load(p, __ATOMIC_RELAXED, __HIP_MEMORY_SCOPE_AGENT); }
__device__ __forceinline__ unsigned xb_add(unsigned* p, unsigned v) { return __hip_atomic_fetch_add(p, v, __ATOMIC_RELAXED, __HIP_MEMORY_SCOPE_AGENT); }
__device__ __forceinline__ unsigned xb_xcc_id() { return (unsigned)__builtin_amdgcn_s_getreg((3 << 11) | 20) & 0xFu; }
#define XB_SPIN(cond, bar) do { unsigned _sp = 0; while (cond) { __builtin_amdgcn_s_sleep(1); \
    if ((++_sp & 255u) == 0u) { if (xb_ld(&(bar)[XB_TMO])) break; if (_sp > XB_SPIN_CAP) { atomicAdd(&(bar)[XB_TMO], 1u); break; } } } } while (0)
__device__ __forceinline__ bool is_thread0(int wave_s) { int ln; asm volatile("v_mbcnt_lo_u32_b32 %0, -1, 0\n\tv_mbcnt_hi_u32_b32 %0, -1, %0" : "=v"(ln)); return wave_s == 0 && ln == 0; }
__device__ __forceinline__ void xcd_barrier_complete(unsigned* bar, unsigned x, unsigned& nloc, unsigned& nx) {
    const unsigned G = (unsigned)__builtin_amdgcn_grid_size_x() / NT;
    unsigned sum, cnt, mine, sp = 0u;
    for (;;) {
        sum = 0u; cnt = 0u; mine = 0u;
#pragma unroll
        for (unsigned j = 0; j < 16; ++j) { const unsigned c = xb_ld(&bar[XB_XCNT(j)]); sum += c; cnt += (c > 0u) ? 1u : 0u; mine = (j == x) ? c : mine; }
        if (sum == G) break;
        __builtin_amdgcn_s_sleep(1);
        if ((++sp & 255u) == 0u) { if (xb_ld(&bar[XB_TMO])) break; if (sp > XB_SPIN_CAP) { atomicAdd(&bar[XB_TMO], 1u); break; } }
    }
    nloc = mine > 0u ? mine : 1u; nx = cnt > 0u ? cnt : 1u;
}
__device__ __forceinline__ void xcd_barrier(unsigned char* ws, volatile __attribute__((address_space(3))) unsigned* st, int wave_s) {
    asm volatile("s_waitcnt vmcnt(0)" ::: "memory");
    __syncthreads();
    if (is_thread0(wave_s)) {
        unsigned* bar = (unsigned*)(ws + OFF_BAR);
        const unsigned x = xb_xcc_id();
        __builtin_amdgcn_s_waitcnt(0);
        unsigned nloc = st[0], nx = st[1];
        if (nloc == 0u) { xcd_barrier_complete(bar, x, nloc, nx); st[0] = nloc; st[1] = nx; }
        const unsigned old = xb_add(&bar[XB_XSUB(x)], 1u);
        const unsigned gen = old / nloc;
        if (old + 1u == (gen + 1u) * nloc) {
            __builtin_amdgcn_fence(__ATOMIC_RELEASE, "agent");
            asm volatile("s_waitcnt vmcnt(0)" ::: "memory");
            const unsigned og = xb_add(&bar[XB_TOP], 1u);
            const unsigned tg = og / nx;
            if (og + 1u == (tg + 1u) * nx) xb_add(&bar[XB_TOPGEN], 1u);
            else XB_SPIN(xb_ld(&bar[XB_TOPGEN]) == tg, bar);
            __builtin_amdgcn_fence(__ATOMIC_ACQUIRE, "agent");
            xb_add(&bar[XB_XGEN(x)], 1u);
            asm volatile("s_waitcnt vmcnt(0)" ::: "memory");
        } else {
            XB_SPIN(xb_ld(&bar[XB_XGEN(x)]) == gen, bar);
            __builtin_amdgcn_fence(__ATOMIC_ACQUIRE, "agent");
            asm volatile("s_waitcnt vmcnt(0)" ::: "memory");
        }
    }
    __syncthreads();
}

#define AS4 __attribute__((address_space(4)))
__device__ __forceinline__ Params load_params() {
    const AS4 unsigned char* k = (const AS4 unsigned char*)__builtin_amdgcn_kernarg_segment_ptr();
    asm volatile("" : "+s"(k));
    Params q;
#define LDP(field, T) q.field = *(T const AS4*)(k + __builtin_offsetof(Params, field))
    LDP(x, const float*); LDP(pos, const int*); LDP(norm_g, const float*); LDP(w_in, const float*); LDP(qn_g, const float*); LDP(w_uq, const float*);
    LDP(kvn_g, const float*); LDP(w_ukv, const float*); LDP(q_g, const float*); LDP(kn_g, const float*); LDP(kr_g, const float*); LDP(conv_w, const float*);
    LDP(ln_g, const float*); LDP(ln_b, const float*); LDP(sg_w, const float*); LDP(sg_b, const float*); LDP(mq_g, const float*); LDP(mk_g, const float*);
    LDP(w_out, const float*); LDP(out, float*); LDP(ws, unsigned char*);
#undef LDP
    return q;
}
template <int PH> __device__ __forceinline__ void run_phase(int wave_s, int l, float* lds) {
    const Params p = load_params();
    Ctx cx;
    { int w = wave_s; asm volatile("" : "+s"(w)); int ln; asm volatile("v_mbcnt_lo_u32_b32 %0, -1, 0\n\tv_mbcnt_hi_u32_b32 %0, -1, %0" : "=v"(ln)); cx.tid = w * 64 + ln; asm volatile("" : "+v"(cx.tid)); }
    { int b = __builtin_amdgcn_workgroup_id_x(); asm volatile("" : "+s"(b)); cx.bid = b; }
    { int nbk = (int)__builtin_amdgcn_grid_size_x() / NT; asm volatile("" : "+s"(nbk)); cx.nb = nbk; }
    unsigned char* ws = p.ws;
    if (PH == 0) phase_prep(cx, p, lds);
    if (PH == 1) {
        pg8::Gemm g{(const bf16_t*)(ws + OFF_XB), (const bf16_t*)(ws + OFF_WINT) + (size_t)l * NP * DM, S, NP, DM, DM};
        pg8::StaticOrder So; So.init(S, NP, cx.nb, cx.bid);
        pg8::EpiInP E{(bf16_t*)(ws + OFF_P), (const float*)(ws + OFF_RSTD), NP};
        pg8::gemm_phase<pg8::EpiInP, pg8::StaticOrder, pg8::AOffId, true, true>(cx, (PG8_LAS unsigned char*)lds, g, So, E, pg8::AOffId{});
    }
    if (PH == 2) { if (cx.bid == 0 && cx.tid < 256) ((int*)(ws + OFF_MCNT))[cx.tid] = 0; post_mla(cx, p, l, lds); post_conv(cx, p, l); post_sg(cx, p, l, lds); post_moba(cx, p, l, lds); }
    if (PH == 3) phase_gate(cx, p, l);
    if (PH == 4) { mla::attn_mla_fast(cx, p, l, (unsigned char*)lds); moba::gather_items(cx, p, l, (unsigned char*)lds); }
    if (PH == 7) moba::own_items(cx, p, l, (unsigned char*)lds);
    if (PH == 5) {
        pg8::Gemm g{(const bf16_t*)(ws + OFF_P), (const bf16_t*)(ws + OFF_WOUTT) + (size_t)l * DM * DM, S, DM, DM, NP};
        pg8::StaticOrder So; So.init(S, DM, cx.nb, cx.bid);
        pg8::EpiOutP E{l == 0 ? p.x : p.out, p.out, DM};
        pg8::gemm_phase<pg8::EpiOutP, pg8::StaticOrder, pg8::AOffY, false, true>(cx, (PG8_LAS unsigned char*)lds, g, So, E, pg8::AOffY{});
    }
#ifdef PROBE_CHECK
    if (PH == 10) { if (cx.bid == 0 && cx.tid == 0) *(unsigned*)(ws + OFF_CNT) = 0u; probe_cols(cx, p, PROBE_COL, 0); }
    if (PH == 11) { PROBE_NAIVE; }
    if (PH == 12) probe_cols(cx, p, PROBE_COL, 1);
    if (PH == 13) probe_cols(cx, p, PROBE_COL, 2);
    if (PH == 14) probe_poison(cx, p);
#endif
    if (PH == 6) rows_prep(cx, p.out, (bf16_t*)(ws + OFF_XB), (float*)(ws + OFF_RSTD));
}

__global__ void __launch_bounds__(NT) mega_kernel(Params p) {
    extern __shared__ __attribute__((aligned(16))) unsigned char lds_raw[];
    float* lds = (float*)lds_raw;
    cg::grid_group grid = cg::this_grid();
    const int wave_s = __builtin_amdgcn_readfirstlane((int)(threadIdx.x >> 6));
    volatile __attribute__((address_space(3))) unsigned* bst = (volatile __attribute__((address_space(3))) unsigned*)((__attribute__((address_space(3))) unsigned char*)lds_raw + (LDS_BYTES - 64));
    if (is_thread0(wave_s)) { bst[0] = 0u; bst[1] = 0u; xb_add((unsigned*)(p.ws + OFF_BAR) + XB_XCNT(xb_xcc_id()), 1u); }
#define GSYNC() xcd_barrier(load_params().ws, bst, wave_s)
    run_phase<0>(wave_s, 0, lds); grid.sync();
    run_phase<1>(wave_s, 0, lds); GSYNC();
    run_phase<2>(wave_s, 0, lds); GSYNC();
    run_phase<3>(wave_s, 0, lds); GSYNC();
#ifdef PROBE_CHECK
    run_phase<10>(wave_s, 0, lds); GSYNC();
    run_phase<11>(wave_s, 0, lds); GSYNC();
    run_phase<12>(wave_s, 0, lds); GSYNC();
#endif
    run_phase<4>(wave_s, 0, lds); GSYNC();
    run_phase<7>(wave_s, 0, lds); GSYNC();
#ifdef PROBE_CHECK
    run_phase<13>(wave_s, 0, lds); GSYNC();
#endif
    run_phase<5>(wave_s, 0, lds); GSYNC();
    run_phase<6>(wave_s, 0, lds); GSYNC();
    run_phase<1>(wave_s, 1, lds); GSYNC();
    run_phase<2>(wave_s, 1, lds); GSYNC();
    run_phase<3>(wave_s, 1, lds); GSYNC();
    run_phase<4>(wave_s, 1, lds); GSYNC();
    run_phase<7>(wave_s, 1, lds); GSYNC();
    run_phase<5>(wave_s, 1, lds);
#ifdef PROBE_CHECK
    GSYNC(); run_phase<14>(wave_s, 1, lds);
#endif
}

extern "C" void kernel_launch(void* const* d_in, const int* in_sizes, int n_in, void* d_out, int out_size, void* d_ws, size_t ws_size, hipStream_t stream) {
    static int grid_blocks = 0;
    if (grid_blocks == 0) {
        int dev = 0, cus = 0, per_cu = 0;
        hipGetDevice(&dev);
        hipDeviceGetAttribute(&cus, hipDeviceAttributeMultiprocessorCount, dev);
        hipFuncSetAttribute((const void*)mega_kernel, hipFuncAttributeMaxDynamicSharedMemorySize, LDS_BYTES);
        hipOccupancyMaxActiveBlocksPerMultiprocessor(&per_cu, (const void*)mega_kernel, NT, LDS_BYTES);
        if (per_cu < 1) { fprintf(stderr, "occupancy query returned %d\n", per_cu); per_cu = 1; }
        if (per_cu > 1) per_cu = 1;
        grid_blocks = cus * per_cu;
        if (ws_size < OFF_END) { fprintf(stderr, "workspace too small: %zu < %zu\n", ws_size, (size_t)OFF_END); grid_blocks = -1; }
    }
    if (grid_blocks < 0) return;
    Params p{};
    p.x = (const float*)d_in[0]; p.pos = (const int*)d_in[1]; p.norm_g = (const float*)d_in[2]; p.w_in = (const float*)d_in[3];
    p.qn_g = (const float*)d_in[4]; p.w_uq = (const float*)d_in[5]; p.kvn_g = (const float*)d_in[6]; p.w_ukv = (const float*)d_in[7];
    p.q_g = (const float*)d_in[8]; p.kn_g = (const float*)d_in[9]; p.kr_g = (const float*)d_in[10]; p.conv_w = (const float*)d_in[11];
    p.ln_g = (const float*)d_in[12]; p.ln_b = (const float*)d_in[13]; p.sg_w = (const float*)d_in[14]; p.sg_b = (const float*)d_in[15];
    p.mq_g = (const float*)d_in[16]; p.mk_g = (const float*)d_in[17]; p.w_out = (const float*)d_in[18];
    p.out = (float*)d_out; p.ws = (unsigned char*)d_ws;
    if (hipMemsetAsync(d_ws, 0, 65536, stream) != hipSuccess) fprintf(stderr, "memset failed\n");
    void* args[] = {&p};
    hipError_t e = hipLaunchCooperativeKernel((const void*)mega_kernel, dim3(grid_blocks), dim3(NT), args, LDS_BYTES, stream);
    if (e != hipSuccess) fprintf(stderr, "cooperative launch failed: %s (grid %d)\n", hipGetErrorString(e), grid_blocks);
}
```

```cpp
#include <hip/hip_runtime.h>
#include <hip/hip_cooperative_groups.h>
#include <stdint.h>
#include <cstdio>
namespace cg = cooperative_groups;

constexpr int S = 16384, DM = 1024, NP = 3584, DEPTH = 2, DIN = 3488;
constexpr int NT = 512;
constexpr float EPS = 1e-6f;
constexpr float LOG2E = 1.4426950408889634f;
constexpr int C_CQ = 0, C_CKV = 256, C_KR = 384, C_GA = 512, C_CH = 768, C_CB = 1024, C_CC = 1280, C_GB = 1536,
              C_SU = 1792, C_SV = 2048, C_GC = 2304, C_MQ = 2560, C_MK = 2816, C_MV = 3072, C_GD = 3328;

typedef unsigned short bf16_t;
struct Ctx { int tid, bid, nb; };
__device__ __forceinline__ float bf2f(bf16_t v) { return __uint_as_float(((unsigned)v) << 16); }
__device__ __forceinline__ unsigned f2bf(float f) { unsigned u = __float_as_uint(f); return (u + 0x7fffu + ((u >> 16) & 1u)) >> 16; }
__device__ __forceinline__ unsigned pk2(float lo, float hi) { return f2bf(lo) | (f2bf(hi) << 16); }
__device__ __forceinline__ float lo16(unsigned u) { return __uint_as_float(u << 16); }
__device__ __forceinline__ float hi16(unsigned u) { return __uint_as_float(u & 0xffff0000u); }
__device__ __forceinline__ float shx(float v, int k, int lane) { return __builtin_bit_cast(float, __builtin_amdgcn_ds_bpermute((lane ^ k) << 2, __builtin_bit_cast(int, v))); }
__device__ __forceinline__ float wave_sum(float v, int lane) {
#pragma unroll
    for (int o = 1; o < 64; o <<= 1) v += shx(v, o, lane);
    return v;
}
__device__ __forceinline__ float silu(float g) { return g / (1.f + __expf(-g)); }

constexpr size_t al256(size_t x) { return (x + 255) & ~(size_t)255; }
constexpr size_t OFF_CTRL = 0;
constexpr size_t OFF_WINT = 65536;
constexpr size_t OFF_WOUTT = OFF_WINT + (size_t)DEPTH * NP * DM * 2;
constexpr size_t OFF_WUQT = OFF_WOUTT + (size_t)DEPTH * DM * DM * 2;
constexpr size_t OFF_WUKVT = OFF_WUQT + (size_t)DEPTH * 384 * 256 * 2;
constexpr size_t OFF_SGW = OFF_WUKVT + (size_t)DEPTH * 512 * 128 * 2;
constexpr size_t OFF_COSA = OFF_SGW + (size_t)DEPTH * 4 * 128 * 128 * 2;
constexpr size_t OFF_SINA = OFF_COSA + (size_t)S * 16 * 4;
constexpr size_t OFF_COSD = OFF_SINA + (size_t)S * 16 * 4;
constexpr size_t OFF_SIND = OFF_COSD + (size_t)S * 8 * 4;
constexpr size_t OFF_RSTD = OFF_SIND + (size_t)S * 8 * 4;
constexpr size_t OFF_KMEAN = OFF_RSTD + (size_t)S * 4;
constexpr size_t OFF_SEL = OFF_KMEAN + (size_t)4 * 64 * 64 * 4;
constexpr size_t OFF_XB = OFF_SEL + (size_t)4 * S * 4 * 4;
constexpr size_t OFF_P = OFF_XB + (size_t)S * DM * 2;
constexpr size_t OFF_QA = OFF_P + (size_t)S * NP * 2;
constexpr size_t OFF_KA = OFF_QA + (size_t)4 * S * 96 * 2;
constexpr size_t OFF_VA = OFF_KA + (size_t)4 * S * 96 * 2;
constexpr size_t OFF_LIST = OFF_VA + (size_t)4 * S * 64 * 2;
constexpr int LIST_PER_HEAD = 256 * 2016;
constexpr size_t OFF_LPART = OFF_LIST + (size_t)4 * LIST_PER_HEAD * 4;
constexpr size_t OFF_SSQ = OFF_LPART + (size_t)4 * S * 3 * 4;
constexpr size_t OFF_WUQF = OFF_SSQ + (size_t)S * 16 * 4;
constexpr size_t OFF_WUKVF = OFF_WUQF + (size_t)DEPTH * 384 * 256 * 2;
constexpr size_t OFF_PART = OFF_WUKVF + (size_t)DEPTH * 512 * 128 * 2;
constexpr size_t OFF_END = OFF_PART + (size_t)4 * S * 3 * 64 * 2;
constexpr size_t OFF_C2 = 512;
constexpr size_t OFF_GCTR = 768;
constexpr size_t OFF_MCNT = 2048;
static_assert(OFF_END <= 268435456, "workspace map exceeds 256 MiB");
static_assert((OFF_XB % 256) == 0 && (OFF_P % 256) == 0 && (OFF_QA % 256) == 0, "alignment");

constexpr int LDS_BYTES = 147456;

struct Params {
    const float* x; const int* pos; const float* norm_g; const float* w_in; const float* qn_g; const float* w_uq;
    const float* kvn_g; const float* w_ukv; const float* q_g; const float* kn_g; const float* kr_g; const float* conv_w;
    const float* ln_g; const float* ln_b; const float* sg_w; const float* sg_b; const float* mq_g; const float* mk_g;
    const float* w_out; float* out; unsigned char* ws;
};

namespace pg8 {
#define PG8_LAS __attribute__((address_space(3)))
typedef unsigned short bf16_t;
typedef short bf16x8 __attribute__((ext_vector_type(8)));
typedef float f32x4 __attribute__((ext_vector_type(4)));
typedef unsigned u32x4 __attribute__((ext_vector_type(4)));
constexpr int BM = 256, BK = 64, HALF = 128, HTB = HALF * BK * 2  , STAGE_BYTES = 8 * HTB, NXCD = 8, WGM = 8;

__host__ __device__ __forceinline__ int lds_byte(int r, int c) { const int st = (r >> 4) * 2 + (c >> 5), rr = r & 15, cc = c & 31, ob = rr * 64 + cc * 2; return st * 1024 + (ob ^ (((ob >> 9) & 1) << 5)); }
__host__ __device__ __forceinline__ void stage_rc(int b, int& R, int& C) { const int st = b / 1024, sb = b % 1024, swz = sb ^ (((sb >> 9) & 1) << 5); R = (st >> 1) * 16 + swz / 64; C = (st & 1) * 32 + (swz % 64) / 2; }
__host__ __device__ __forceinline__ int perm32(int rho) { const int n = rho >> 4, i = rho & 15; return 8 * (i >> 2) + 4 * n + (i & 3); }

struct Unit { int pm, pn; };
struct Gemm { const bf16_t* A; const bf16_t* Bt; int M, N, K, lda; };

struct StaticOrder {
    int nM, nN, nwg, G, c;
    __host__ __device__ void init(int M, int N, int G_, int c_) { nM = M / BM; nN = N / BM; nwg = nM * nN; G = G_; c = c_; }
    __host__ __device__ bool next(int i, Unit& u) const {
        const long L = (long)i * G + c; if (L >= nwg) return false;
        int wgid = (int)L; { const int q = nwg / NXCD, r = nwg % NXCD, xcd = wgid % NXCD, off = wgid / NXCD; wgid = (xcd < r ? xcd * (q + 1) : r * (q + 1) + (xcd - r) * q) + off; }
        const int nig = WGM * nN, gid = wgid / nig, fm = gid * WGM, gsz = (nM - fm) < WGM ? (nM - fm) : WGM;
        u.pm = fm + ((wgid % nig) % gsz); u.pn = (wgid % nig) / gsz; return true;
    }
    __device__ __forceinline__ void a_ready(const Unit&) const {}
    __device__ __forceinline__ void done(const Unit&) const {}
};


template <class Epi, class Sched, class AOff, bool ALIGN_EPI = false, bool SP2 = false>
__device__ __forceinline__ void gemm_phase(const Ctx& cx, PG8_LAS unsigned char* lds, const Gemm g, const Sched& S, const Epi& E, const AOff& AO) {
    const int tid = cx.tid, wid = __builtin_amdgcn_readfirstlane(tid >> 6), lane = tid & 63, wr = wid >> 2, wc = wid & 3, fr = lane & 15, fq = lane >> 4;
    const int K = g.K, nt = K / BK;
    unsigned voffA[2], voffB[2];
#pragma unroll
    for (int i = 0; i < 2; ++i) { int R, C; stage_rc(tid * 16 + i * 8192, R, C); const int Rb = Epi::PERM ? ((R & ~31) + perm32(R & 31)) : R;
        voffA[i] = (unsigned)(R * g.lda + C) * 2u; voffB[i] = (unsigned)(Rb * K + C) * 2u; }
    const size_t kstep = (size_t)(BK * 2);
    const size_t hstepB = (size_t)HALF * K * 2, hstepA = (size_t)HALF * g.lda * 2;
    const size_t tstepB = 2 * hstepB, tstepA = 2 * hstepA;
    const unsigned ldsw = (unsigned)wid * 1024u;
    const int aoff = lds_byte(wr * 64 + fr, fq * 8), boff = lds_byte(wc * 32 + fr, fq * 8);
#define PG8_SA(b, h) (((b) * 2 + (h)) * HTB)
#define PG8_SB(b, h) ((4 + (b) * 2 + (h)) * HTB)
#define PG8_STAGE(bufoff, gbase, voff) do { _Pragma("unroll") for (int _i = 0; _i < 2; ++_i) \
        __builtin_amdgcn_global_load_lds((const unsigned*)((const char*)(gbase) + (voff)[_i]), (PG8_LAS unsigned*)(lds + (bufoff) + ldsw + _i * 8192), 16, 0, 0); } while (0)
#define PG8_LDA(dst, b, h) do { _Pragma("unroll") for (int m = 0; m < 4; ++m) _Pragma("unroll") for (int k = 0; k < 2; ++k) dst[m][k] = *(const PG8_LAS bf16x8*)(lds + PG8_SA(b, h) + aoff + m * 2048 + k * 1024); } while (0)
#define PG8_LDB(dst, b, h) do { _Pragma("unroll") for (int n = 0; n < 2; ++n) _Pragma("unroll") for (int k = 0; k < 2; ++k) dst[n][k] = *(const PG8_LAS bf16x8*)(lds + PG8_SB(b, h) + boff + n * 2048 + k * 1024); } while (0)
#define PG8_MMA(ai, bj, At, Bt) do { __builtin_amdgcn_s_setprio(1); _Pragma("unroll") for (int m = 0; m < 4; ++m) _Pragma("unroll") for (int n = 0; n < 2; ++n) _Pragma("unroll") for (int k = 0; k < 2; ++k) \
        acc[ai][bj][m][n] = __builtin_amdgcn_mfma_f32_16x16x32_bf16(Bt[n][k], At[m][k], acc[ai][bj][m][n], 0, 0, 0); __builtin_amdgcn_s_setprio(0); } while (0)
#define PG8_WAIT_V(n) asm volatile("s_waitcnt vmcnt(" #n ")" ::: "memory")
#define PG8_WAIT_L(n) asm volatile("s_waitcnt lgkmcnt(" #n ")" ::: "memory")
#define PG8_BAR __builtin_amdgcn_s_barrier()
#define PG8_SCHED __builtin_amdgcn_sched_barrier(0)
    Unit cur, nxt; int ui = 0;
    if (!S.next(0, cur)) return;
    PG8_LAS float* epi_rows = Epi::setup(E, S, cur, (PG8_LAS float*)(lds + STAGE_BYTES), tid) ? (PG8_LAS float*)(lds + STAGE_BYTES) : (PG8_LAS float*)nullptr;
    f32x4 acc[2][2][4][2];
#pragma unroll
    for (int a = 0; a < 2; ++a)
#pragma unroll
        for (int b = 0; b < 2; ++b)
#pragma unroll
            for (int m = 0; m < 4; ++m)
#pragma unroll
                for (int n = 0; n < 2; ++n) acc[a][b][m][n] = (f32x4){0.f, 0.f, 0.f, 0.f};
    bf16x8 At[4][2], B0[2][2], B1[2][2];
    const char* cA = (const char*)g.A + (size_t)cur.pm * tstepA; const char* cB = (const char*)g.Bt + (size_t)cur.pn * tstepB;
    S.a_ready(cur);
    if constexpr (SP2) {
        PG8_STAGE(PG8_SB(0, 0), cB, voffB); PG8_STAGE(PG8_SB(0, 1), cB + hstepB, voffB); PG8_STAGE(PG8_SA(0, 0), cA + AO(0), voffA); PG8_STAGE(PG8_SA(0, 1), cA + AO(0) + hstepA, voffA);
        if (wr == 1) PG8_BAR;
        PG8_WAIT_V(2); PG8_BAR;
        PG8_STAGE(PG8_SB(1, 0), cB + kstep, voffB); PG8_STAGE(PG8_SA(1, 0), cA + AO(1), voffA); PG8_STAGE(PG8_SB(1, 1), cB + hstepB + kstep, voffB);
        PG8_WAIT_V(6); PG8_BAR;
    } else {
        PG8_STAGE(PG8_SB(0, 0), cB, voffB); PG8_STAGE(PG8_SA(0, 0), cA + AO(0), voffA); PG8_STAGE(PG8_SB(0, 1), cB + hstepB, voffB); PG8_STAGE(PG8_SA(0, 1), cA + AO(0) + hstepA, voffA);
        if (wr == 1) PG8_BAR;
        PG8_WAIT_V(4); PG8_BAR;
        PG8_STAGE(PG8_SB(1, 0), cB + kstep, voffB); PG8_STAGE(PG8_SA(1, 0), cA + AO(1), voffA); PG8_STAGE(PG8_SB(1, 1), cB + hstepB + kstep, voffB);
        PG8_WAIT_V(6); PG8_BAR;
    }
    for (;;) {
        const bool has_next = S.next(ui + 1, nxt);
        const char* nA = has_next ? (const char*)g.A + (size_t)nxt.pm * tstepA : cA; const char* nB = has_next ? (const char*)g.Bt + (size_t)nxt.pn * tstepB : cB;
        for (int t = 0; t < nt; t += 2) {
            const bool last = (t == nt - 2);
            const char* a1 = cA + AO(t + 1);
            const char* a2 = last ? nA + AO(0) : cA + AO(t + 2); const char* b2 = last ? nB : cB + (size_t)(t + 2) * kstep;
            const char* a3 = last ? nA + AO(1) : cA + AO(t + 3); const char* b3 = b2 + kstep;
            if (last && has_next) S.a_ready(nxt);
            if constexpr (SP2) {
            PG8_LDB(B0, 0, 0); PG8_LDB(B1, 0, 1); PG8_SCHED; PG8_LDA(At, 0, 0); PG8_STAGE(PG8_SA(1, 1), a1 + hstepA, voffA);
            PG8_WAIT_V(8); PG8_WAIT_L(0); PG8_BAR; PG8_MMA(0, 0, At, B0); PG8_MMA(0, 1, At, B1); PG8_BAR; PG8_SCHED;
            PG8_LDA(At, 0, 1); PG8_STAGE(PG8_SB(0, 0), b2, voffB); PG8_STAGE(PG8_SB(0, 1), b2 + hstepB, voffB); PG8_STAGE(PG8_SA(0, 0), a2, voffA);
            PG8_WAIT_V(8); PG8_WAIT_L(0); PG8_BAR; PG8_MMA(1, 0, At, B0); PG8_MMA(1, 1, At, B1); PG8_BAR; PG8_SCHED;
            PG8_LDB(B0, 1, 0); PG8_LDB(B1, 1, 1); PG8_SCHED; PG8_LDA(At, 1, 0); PG8_STAGE(PG8_SA(0, 1), a2 + hstepA, voffA);
            PG8_WAIT_V(8); PG8_WAIT_L(0); PG8_BAR; PG8_MMA(0, 0, At, B0); PG8_MMA(0, 1, At, B1); PG8_BAR; PG8_SCHED;
            PG8_LDA(At, 1, 1); PG8_STAGE(PG8_SB(1, 0), b3, voffB); PG8_STAGE(PG8_SB(1, 1), b3 + hstepB, voffB); PG8_STAGE(PG8_SA(1, 0), a3, voffA);
            PG8_WAIT_V(8); PG8_WAIT_L(0); PG8_BAR; PG8_MMA(1, 0, At, B0); PG8_MMA(1, 1, At, B1); PG8_BAR; PG8_SCHED;
            } else {
            PG8_LDB(B0, 0, 0); PG8_SCHED; PG8_LDA(At, 0, 0); PG8_STAGE(PG8_SA(1, 1), a1 + hstepA, voffA);
            PG8_WAIT_L(8); PG8_BAR; PG8_WAIT_L(0); PG8_MMA(0, 0, At, B0); PG8_BAR; PG8_SCHED;
            PG8_LDB(B1, 0, 1); PG8_STAGE(PG8_SB(0, 0), b2, voffB);
            PG8_BAR; PG8_WAIT_L(0); PG8_MMA(0, 1, At, B1); PG8_BAR;
            PG8_LDA(At, 0, 1); PG8_STAGE(PG8_SA(0, 0), a2, voffA);
            PG8_BAR; PG8_WAIT_L(0); PG8_MMA(1, 0, At, B0); PG8_BAR; PG8_SCHED;
            PG8_STAGE(PG8_SB(0, 1), b2 + hstepB, voffB);
            PG8_WAIT_V(6); PG8_BAR; PG8_MMA(1, 1, At, B1); PG8_BAR;
            PG8_LDB(B0, 1, 0); PG8_SCHED; PG8_LDA(At, 1, 0); PG8_STAGE(PG8_SA(0, 1), a2 + hstepA, voffA);
            PG8_WAIT_L(8); PG8_BAR; PG8_WAIT_L(0); PG8_MMA(0, 0, At, B0); PG8_BAR; PG8_SCHED;
            PG8_LDB(B1, 1, 1); PG8_STAGE(PG8_SB(1, 0), b3, voffB);
            PG8_BAR; PG8_WAIT_L(0); PG8_MMA(0, 1, At, B1); PG8_BAR;
            PG8_LDA(At, 1, 1); PG8_STAGE(PG8_SA(1, 0), a3, voffA);
            PG8_BAR; PG8_WAIT_L(0); PG8_MMA(1, 0, At, B0); PG8_BAR; PG8_SCHED;
            PG8_STAGE(PG8_SB(1, 1), b3 + hstepB, voffB);
            PG8_WAIT_V(6); PG8_BAR; PG8_MMA(1, 1, At, B1); PG8_BAR;
            }
        }
        if constexpr (ALIGN_EPI) { if (wr == 0) PG8_BAR; }
        if constexpr (!Epi::AFTER_DRAIN) { E(acc, cur, wr, wc, fr, fq, epi_rows); S.done(cur); }
        if (!has_next) break;
#pragma unroll
        for (int a = 0; a < 2; ++a)
#pragma unroll
            for (int b = 0; b < 2; ++b)
#pragma unroll
                for (int m = 0; m < 4; ++m)
#pragma unroll
                    for (int n = 0; n < 2; ++n) acc[a][b][m][n] = (f32x4){0.f, 0.f, 0.f, 0.f};
        cur = nxt; cA = nA; cB = nB; ++ui;
        if constexpr (ALIGN_EPI) { if (wr == 1) PG8_BAR; }
    }
    PG8_WAIT_V(0);
    if constexpr (!ALIGN_EPI) { if (wr == 0) PG8_BAR; }
    PG8_BAR;
    if constexpr (Epi::AFTER_DRAIN) { E.fused(acc, cur, wr, wc, fr, fq, lds, wid, lane); S.done(cur); }
#undef PG8_SA
#undef PG8_SB
#undef PG8_STAGE
#undef PG8_LDA
#undef PG8_LDB
#undef PG8_MMA
#undef PG8_WAIT_V
#undef PG8_WAIT_L
#undef PG8_BAR
#undef PG8_SCHED
}

__device__ __forceinline__ unsigned cvt_pk_bf16(float lo, float hi) { unsigned r; asm volatile("v_cvt_pk_bf16_f32 %0, %1, %2" : "=v"(r) : "v"(lo), "v"(hi)); return r; }
struct AOffId { __device__ __forceinline__ size_t operator()(int t) const { return (size_t)t * (BK * 2); } };
struct AOffY {
    __device__ __forceinline__ size_t operator()(int t) const { const int g = t >> 2; const int base = g == 0 ? 512 : g == 1 ? 1536 : g == 2 ? 2304 : 3328; return (size_t)(base + (t & 3) * 64) * 2; }
};
struct EpiInP {
    static constexpr bool PERM = true, AFTER_DRAIN = false;
    bf16_t* P; const float* rstd; int ldp; const float* ssq;
    template <class Sched>
    static __device__ __forceinline__ bool setup(const EpiInP& E, const Sched& S, const Unit& first, PG8_LAS float* rows, int tid) {
        bool same = true; Unit u_;
        for (int i = 1; S.next(i, u_); ++i) same = same && (u_.pm == first.pm);
        if (!same) return false;
        if (tid < BM) { const int row = first.pm * BM + tid; float r;
            if (E.ssq) { const f32x4* sp = (const f32x4*)(E.ssq + (size_t)row * 16); const f32x4 a = sp[0], b = sp[1], c = sp[2], d = sp[3];
                const float q0 = (a[0] + a[1]) + (a[2] + a[3]), q1 = (b[0] + b[1]) + (b[2] + b[3]), q2 = (c[0] + c[1]) + (c[2] + c[3]), q3 = (d[0] + d[1]) + (d[2] + d[3]);
                r = 1.0f / sqrtf(((q0 + q1) + (q2 + q3)) * (1.0f / 1024.0f) + 1e-6f); }
            else r = E.rstd[row];
            rows[tid] = r; }
        return true;
    }
    __device__ __forceinline__ void operator()(const f32x4 (&acc)[2][2][4][2], const Unit& u, int wr, int wc, int fr, int fq, PG8_LAS float* rows) const {
        const int row0 = u.pm * BM + wr * 64 + fr, col0 = u.pn * BM + wc * 32 + 8 * fq;
        float r[8];
        if (rows) {
#pragma unroll
            for (int i = 0; i < 8; ++i) r[i] = rows[wr * 64 + fr + (i >> 2) * HALF + (i & 3) * 16]; }
        else if (ssq) { f32x4 t[8];
#pragma unroll
            for (int i = 0; i < 8; ++i) t[i] = *(const f32x4*)(ssq + (size_t)(row0 + (i >> 2) * HALF + (i & 3) * 16) * 16 + 4 * fq);
#pragma unroll
            for (int i = 0; i < 8; ++i) { float sm = (t[i][0] + t[i][1]) + (t[i][2] + t[i][3]); const int lane = fq * 16 + fr; sm += shx(sm, 16, lane); sm += shx(sm, 32, lane);
                r[i] = 1.0f / sqrtf(sm * (1.0f / 1024.0f) + 1e-6f); } }
        else {
#pragma unroll
            for (int i = 0; i < 8; ++i) r[i] = rstd[row0 + (i >> 2) * HALF + (i & 3) * 16]; }
#pragma unroll
        for (int ai = 0; ai < 2; ++ai)
#pragma unroll
            for (int m = 0; m < 4; ++m) { const int row = row0 + ai * HALF + m * 16; const float rr = r[ai * 4 + m];
                bf16_t* rowp = P + (size_t)row * ldp + col0;
#pragma unroll
                for (int bj = 0; bj < 2; ++bj) { const f32x4 v0 = acc[ai][bj][m][0] * rr, v1 = acc[ai][bj][m][1] * rr;
                    u32x4 w; w.x = cvt_pk_bf16(v0[0], v0[1]); w.y = cvt_pk_bf16(v0[2], v0[3]); w.z = cvt_pk_bf16(v1[0], v1[1]); w.w = cvt_pk_bf16(v1[2], v1[3]);
                    *(u32x4*)(rowp + bj * HALF) = w; } }
    }
};
struct EpiOutP {
    static constexpr bool PERM = false, AFTER_DRAIN = false;
    const float* xin; const bf16_t* xinb; float* out; int ldc; bf16_t* xb; float* ssq; int lane;
    static __device__ __forceinline__ void pswap(unsigned& a, unsigned& b) { typedef unsigned u32x2_t __attribute__((ext_vector_type(2))); const u32x2_t r = __builtin_amdgcn_permlane16_swap(a, b, false, false); a = r.x; b = r.y; }
    template <class Sched> static __device__ __forceinline__ bool setup(const EpiOutP&, const Sched&, const Unit&, PG8_LAS float*, int) { return false; }
    __device__ __forceinline__ void operator()(const f32x4 (&acc)[2][2][4][2], const Unit& u, int wr, int wc, int fr, int fq, PG8_LAS float*) const {
        const int col0 = u.pn * BM + wc * 32 + 4 * fq, colw = u.pn * BM + wc * 32 + ((fq & 1) << 4) + ((fq >> 1) << 3);
        f32x4 xr[2][4];
#define EO_LOAD(set, g) do { const size_t row_ = (size_t)(u.pm * BM + ((g) >> 2) * HALF + wr * 64 + ((g) & 3) * 16 + fr) * ldc; \
            if (xinb) { _Pragma("unroll") for (int bj = 0; bj < 2; ++bj) { const u32x4 t_ = *(const u32x4*)(xinb + row_ + colw + bj * HALF); \
                    xr[set][2 * bj] = (f32x4){__uint_as_float(t_.x), __uint_as_float(t_.y), __uint_as_float(t_.z), __uint_as_float(t_.w)}; } } \
            else { _Pragma("unroll") for (int q = 0; q < 4; ++q) xr[set][q] = *(const f32x4*)(xin + row_ + col0 + (q >> 1) * HALF + (q & 1) * 16); } } while (0)
        EO_LOAD(0, 0);
#pragma unroll
        for (int g = 0; g < 8; ++g) {
            if (g + 1 < 8) EO_LOAD((g + 1) & 1, g + 1);
            const int ai = g >> 2, m = g & 3;
            const int row = u.pm * BM + ai * HALF + wr * 64 + m * 16 + fr; const size_t rowo = (size_t)row * ldc; float sq = 0.f;
#pragma unroll
            for (int bj = 0; bj < 2; ++bj) {
                f32x4 r0, r1;
                if (xinb) { unsigned a0 = __float_as_uint(xr[g & 1][2 * bj][0]), a1 = __float_as_uint(xr[g & 1][2 * bj][1]), b0 = __float_as_uint(xr[g & 1][2 * bj][2]), b1 = __float_as_uint(xr[g & 1][2 * bj][3]);
                    pswap(a0, b0); pswap(a1, b1);
                    r0 = (f32x4){__uint_as_float(a0 << 16), __uint_as_float(a0 & 0xffff0000u), __uint_as_float(a1 << 16), __uint_as_float(a1 & 0xffff0000u)};
                    r1 = (f32x4){__uint_as_float(b0 << 16), __uint_as_float(b0 & 0xffff0000u), __uint_as_float(b1 << 16), __uint_as_float(b1 & 0xffff0000u)}; }
                else { r0 = xr[g & 1][2 * bj]; r1 = xr[g & 1][2 * bj + 1]; }
                const f32x4 y0 = r0 + acc[ai][bj][m][0], y1 = r1 + acc[ai][bj][m][1];
                if (out) { __builtin_nontemporal_store(y0, (f32x4*)(out + rowo + col0 + bj * HALF));
                           __builtin_nontemporal_store(y1, (f32x4*)(out + rowo + col0 + bj * HALF + 16)); }
                if (xb) { sq += ((y0[0] * y0[0] + y0[1] * y0[1]) + (y0[2] * y0[2] + y0[3] * y0[3])) + ((y1[0] * y1[0] + y1[1] * y1[1]) + (y1[2] * y1[2] + y1[3] * y1[3]));
                    unsigned a0 = cvt_pk_bf16(y0[0], y0[1]), a1 = cvt_pk_bf16(y0[2], y0[3]), b0 = cvt_pk_bf16(y1[0], y1[1]), b1 = cvt_pk_bf16(y1[2], y1[3]);
                    pswap(a0, b0); pswap(a1, b1);
                    u32x4 w; w.x = a0; w.y = a1; w.z = b0; w.w = b1; *(u32x4*)(xb + rowo + colw + bj * HALF) = w; } }
            if (xb) { sq += shx(sq, 16, lane); sq += shx(sq, 32, lane); if (fq == 0) ssq[(size_t)row * 16 + u.pn * 4 + wc] = sq; }
        }
#undef EO_LOAD
    }
};
}

__device__ __forceinline__ void transpose_tiles(const Ctx& cx, const float* __restrict__ src, int K, int Nsrc, const float* __restrict__ gk,
                                bf16_t* __restrict__ dst, int Ndst, int gap_at, int gap_len, float* lds) {
    float (*t)[33] = (float (*)[33])lds;
    const int tid = cx.tid, a = tid >> 5, b = tid & 31;
    const int tilesN = Ndst / 32, tilesK = K / 32;
    for (int tile = cx.bid; tile < tilesN * tilesK; tile += cx.nb) {
        const int tn = tile % tilesN, tk = tile / tilesN, n0 = tn * 32, k0 = tk * 32;
        __syncthreads();
#pragma unroll
        for (int i = 0; i < 2; ++i) {
            const int kk = a + 16 * i, np = n0 + b;
            const bool z = (np >= gap_at && np < gap_at + gap_len);
            const int n = np < gap_at ? np : np - gap_len;
            float v = z ? 0.f : src[(size_t)(k0 + kk) * Nsrc + n];
            if (gk) v *= gk[k0 + kk];
            t[kk][b] = v;
        }
        __syncthreads();
#pragma unroll
        for (int i = 0; i < 2; ++i) {
            const int nn = a + 16 * i;
            dst[(size_t)(n0 + nn) * K + k0 + b] = (bf16_t)f2bf(t[b][nn]);
        }
    }
}


__device__ __forceinline__ void transpose_item(const float* __restrict__ W, int K, int Nsrc, const float* __restrict__ gk, bf16_t* __restrict__ WT,
                                               int gap_at, int gap_len, int ntn, int item, int lane, __attribute__((address_space(3))) float* scr,
                                               bf16_t* __restrict__ WF = nullptr, int fr_nth = 0) {
    const int kb = item / ntn, nb_ = item % ntn, k0 = 64 * kb, n0d = 32 * nb_;
    const bool pad = (n0d >= gap_at && n0d < gap_at + gap_len);
    const int n0s = n0d < gap_at ? n0d : n0d - gap_len;
    if (!pad) {
#pragma unroll 16
        for (int i = 0; i < 32; ++i) { const int kk = 2 * i + (lane >> 5); float v = W[(size_t)(k0 + kk) * Nsrc + n0s + (lane & 31)]; if (gk) v *= gk[k0 + kk]; scr[kk * 33 + (lane & 31)] = v; }
    }
    asm volatile("s_waitcnt lgkmcnt(0)" ::: "memory");
    const int c = lane & 7;
#pragma unroll
    for (int j = 0; j < 4; ++j) {
        const int n = (lane >> 3) + 8 * j; const __attribute__((address_space(3))) float* sp = scr + (8 * c) * 33 + n;
        uint4 o = make_uint4(0u, 0u, 0u, 0u);
        if (!pad) { o.x = pk2(sp[0 * 33], sp[1 * 33]); o.y = pk2(sp[2 * 33], sp[3 * 33]); o.z = pk2(sp[4 * 33], sp[5 * 33]); o.w = pk2(sp[6 * 33], sp[7 * 33]); }
        *(uint4*)(WT + (size_t)(n0d + n) * K + k0 + 8 * c) = o;
        if (WF) {
            const int nn = n0d + n, hn = fr_nth * 32, hh = nn / hn, nt = (nn % hn) >> 5, rr = nn & 31, kq = k0 + 8 * c, ks = kq >> 4, hi = (kq >> 3) & 1;
            *(uint4*)(WF + ((((size_t)(hh * fr_nth + nt) * (K / 16) + ks) * 2 + hi) * 32 + rr) * 8) = o;
        }
    }
    asm volatile("s_waitcnt lgkmcnt(0)" ::: "memory");
}

__device__ __forceinline__ void rows_prep(const Ctx& cx, const float* __restrict__ xsrc, bf16_t* __restrict__ Xb, float* __restrict__ rstd) {
    const int wave = cx.tid >> 6, lane = cx.tid & 63;
    const int gw = cx.bid * (NT / 64) + wave, NGW = cx.nb * (NT / 64);
    for (int m = gw; m < S / 2; m += NGW) {
        const float4* xr0 = (const float4*)(xsrc + (size_t)m * DM) + lane; const float4* xr1 = (const float4*)(xsrc + (size_t)(m + S / 2) * DM) + lane;
        float4 v0[4], v1[4]; float s0 = 0.f, s1 = 0.f;
#pragma unroll
        for (int j = 0; j < 4; ++j) { v0[j] = xr0[64 * j]; v1[j] = xr1[64 * j]; }
#pragma unroll
        for (int j = 0; j < 4; ++j) { s0 += (v0[j].x * v0[j].x + v0[j].y * v0[j].y) + (v0[j].z * v0[j].z + v0[j].w * v0[j].w); s1 += (v1[j].x * v1[j].x + v1[j].y * v1[j].y) + (v1[j].z * v1[j].z + v1[j].w * v1[j].w); }
        s0 = wave_sum(s0, lane); s1 = wave_sum(s1, lane);
        if (lane == 0) { rstd[m] = 1.0f / sqrtf(s0 * (1.0f / DM) + EPS); rstd[m + S / 2] = 1.0f / sqrtf(s1 * (1.0f / DM) + EPS); }
        uint2* o0 = (uint2*)(Xb + (size_t)m * DM) + lane; uint2* o1 = (uint2*)(Xb + (size_t)(m + S / 2) * DM) + lane;
#pragma unroll
        for (int j = 0; j < 4; ++j) { o0[64 * j] = make_uint2(pk2(v0[j].x, v0[j].y), pk2(v0[j].z, v0[j].w)); o1[64 * j] = make_uint2(pk2(v1[j].x, v1[j].y), pk2(v1[j].z, v1[j].w)); }
    }
}


__device__ __forceinline__ void transpose_item64(const float* __restrict__ W, int K, int Nsrc, const float* __restrict__ gk, bf16_t* __restrict__ WT,
                                                 int gap_at, int gap_len, int ntn64, int item, int lane, __attribute__((address_space(3))) float* scr,
                                                 bf16_t* __restrict__ WF = nullptr, int fr_nth = 0) {
    const int kb = item / ntn64, nb_ = item % ntn64, k0 = 64 * kb, n0d = 64 * nb_;
    const int kk4 = lane >> 4, nq = (lane & 15) * 4, nd = n0d + nq;
    const bool padg = (nd >= gap_at && nd < gap_at + gap_len);
    const int ns = nd < gap_at ? nd : nd - gap_len;
    float4 v[16];
#pragma unroll
    for (int i = 0; i < 16; ++i) v[i] = padg ? make_float4(0.f, 0.f, 0.f, 0.f) : *(const float4*)(W + (size_t)(k0 + 4 * i + kk4) * Nsrc + ns);
#pragma unroll
    for (int i = 0; i < 16; ++i) { const int kk = 4 * i + kk4; const float g = gk ? gk[k0 + kk] : 1.0f; __attribute__((address_space(3))) float* d = scr + kk * 65 + nq; d[0] = v[i].x * g; d[1] = v[i].y * g; d[2] = v[i].z * g; d[3] = v[i].w * g; }
    asm volatile("s_waitcnt lgkmcnt(0)" ::: "memory");
    const int c = lane & 7;
#pragma unroll
    for (int j = 0; j < 8; ++j) {
        const int n = (lane >> 3) + 8 * j; const __attribute__((address_space(3))) float* sp = scr + (8 * c) * 65 + n;
        uint4 o; o.x = pk2(sp[0 * 65], sp[1 * 65]); o.y = pk2(sp[2 * 65], sp[3 * 65]); o.z = pk2(sp[4 * 65], sp[5 * 65]); o.w = pk2(sp[6 * 65], sp[7 * 65]);
        *(uint4*)(WT + (size_t)(n0d + n) * K + k0 + 8 * c) = o;
        if (WF) { const int nn = n0d + n, hn = fr_nth * 32, hh = nn / hn, nt = (nn % hn) >> 5, rr = nn & 31, kq = k0 + 8 * c, ks = kq >> 4, hi = (kq >> 3) & 1;
            *(uint4*)(WF + ((((size_t)(hh * fr_nth + nt) * (K / 16) + ks) * 2 + hi) * 32 + rr) * 8) = o; }
    }
    asm volatile("s_waitcnt lgkmcnt(0)" ::: "memory");
}


constexpr int WI_IN = (DM / 64) * (NP / 64), WI_OUT = (DM / 64) * (DM / 64), WI_UQ = (256 / 64) * (384 / 64), WI_UKV = (128 / 64) * (512 / 64), WI_L = WI_IN + WI_OUT + WI_UQ + WI_UKV;
__device__ __forceinline__ void weight_item(const Params& p, int l, int r, int lane, __attribute__((address_space(3))) float* scr64) {
    unsigned char* ws = p.ws;
    if (r < WI_IN) { transpose_item64(p.w_in + (size_t)l * DM * DIN, DM, DIN, p.norm_g + l * DM, (bf16_t*)(ws + OFF_WINT) + (size_t)l * NP * DM, 416, 96, NP / 64, r, lane, scr64); return; } r -= WI_IN;
    if (r < WI_OUT) { transpose_item64(p.w_out + (size_t)l * DM * DM, DM, DM, nullptr, (bf16_t*)(ws + OFF_WOUTT) + (size_t)l * DM * DM, DM, 0, DM / 64, r, lane, scr64); return; } r -= WI_OUT;
    if (r < WI_UQ) { transpose_item64(p.w_uq + (size_t)l * 256 * 384, 256, 384, p.qn_g + l * 256, (bf16_t*)(ws + OFF_WUQT) + (size_t)l * 384 * 256, 384, 0, 384 / 64, r, lane, scr64, (bf16_t*)(ws + OFF_WUQF) + (size_t)l * 384 * 256, 3); return; } r -= WI_UQ;
    transpose_item64(p.w_ukv + (size_t)l * 128 * 512, 128, 512, p.kvn_g + l * 128, (bf16_t*)(ws + OFF_WUKVT) + (size_t)l * 512 * 128, 512, 0, 512 / 64, r, lane, scr64, (bf16_t*)(ws + OFF_WUKVF) + (size_t)l * 512 * 128, 4);
}

constexpr size_t OFF_WQ = 12288;
__device__ __forceinline__ void rows_item(const float* __restrict__ xsrc, bf16_t* __restrict__ Xb, float* __restrict__ rstd, int m, int lane) {
    float4 v[4][4]; float ss[4];
#pragma unroll
    for (int r = 0; r < 4; ++r) { const float4* xr = (const float4*)(xsrc + (size_t)(m + r * (S / 4)) * DM) + lane;
#pragma unroll
        for (int j = 0; j < 4; ++j) v[r][j] = xr[64 * j]; }
#pragma unroll
    for (int r = 0; r < 4; ++r) { float a = 0.f;
#pragma unroll
        for (int j = 0; j < 4; ++j) a += (v[r][j].x * v[r][j].x + v[r][j].y * v[r][j].y) + (v[r][j].z * v[r][j].z + v[r][j].w * v[r][j].w);
        ss[r] = wave_sum(a, lane); }
#pragma unroll
    for (int r = 0; r < 4; ++r) { const int row = m + r * (S / 4);
        if (lane == 0) rstd[row] = 1.0f / sqrtf(ss[r] * (1.0f / DM) + EPS);
        uint2* o = (uint2*)(Xb + (size_t)row * DM) + lane;
#pragma unroll
        for (int j = 0; j < 4; ++j) o[64 * j] = make_uint2(pk2(v[r][j].x, v[r][j].y), pk2(v[r][j].z, v[r][j].w)); }
}
__device__ __forceinline__ void phase_prep(const Ctx& cx, const Params& p, float* lds) {
    unsigned char* ws = p.ws;
    const int wave = __builtin_amdgcn_readfirstlane(cx.tid >> 6), lane = cx.tid & 63;
    const int gtid = cx.bid * NT + cx.tid, GT = cx.nb * NT;
    if (cx.bid == 0 && cx.tid < DEPTH * 2) {
        const int l_ = cx.tid >> 1; float c2v;
        if ((cx.tid & 1) == 0) {
            float gq = 0.f, gn = 0.f, gr = 0.f;
            for (int d = 0; d < 96; ++d) gq = fmaxf(gq, fabsf(p.q_g[l_ * 96 + d]));
            for (int d = 0; d < 64; ++d) gn = fmaxf(gn, fabsf(p.kn_g[l_ * 64 + d]));
            for (int d = 0; d < 32; ++d) gr = fmaxf(gr, fabsf(p.kr_g[l_ * 32 + d]));
            c2v = gq * sqrtf(64.f * gn * gn + 32.f * gr * gr) * LOG2E * 1.02f;
        } else {
            float gq = 0.f, gk = 0.f;
            for (int d = 0; d < 64; ++d) { gq = fmaxf(gq, fabsf(p.mq_g[l_ * 64 + d])); gk = fmaxf(gk, fabsf(p.mk_g[l_ * 64 + d])); }
            c2v = gq * gk * 8.0f * LOG2E * 1.02f;
        }
        ((float*)(ws + OFF_C2))[cx.tid] = c2v;
    }
    {
        bf16_t* sgw = (bf16_t*)(ws + OFF_SGW);
        for (int i = gtid; i < DEPTH * 4 * 128 * 128; i += GT) {
            const int s_ = i & 127, t_ = (i >> 7) & 127;
            sgw[i] = (bf16_t)f2bf(s_ <= t_ ? p.sg_w[i] : 0.f);
        }
        float* cosA = (float*)(ws + OFF_COSA); float* sinA = (float*)(ws + OFF_SINA);
        float* cosD = (float*)(ws + OFF_COSD); float* sinD = (float*)(ws + OFF_SIND);
        for (int i = gtid; i < S * 24; i += GT) {
            const int s_ = i / 24, j = i % 24;
            const float posf = (float)p.pos[s_];
            float inv;
            if (j < 16) inv = powf(500000.0f, -((float)j * 2.0f / 32.0f));
            else inv = powf(500000.0f, -((float)(j - 16) * 2.0f / 16.0f));
            const float ang = posf * inv;
            const double rev = (double)ang * 0.15915494309189535;
            const float frac = (float)(rev - rint(rev));
            const float c = __builtin_amdgcn_cosf(frac), sn = __builtin_amdgcn_sinf(frac);
            if (j < 16) { cosA[s_ * 16 + j] = c; sinA[s_ * 16 + j] = sn; }
            else { cosD[s_ * 8 + (j - 16)] = c; sinD[s_ * 8 + (j - 16)] = sn; }
        }
    }
    {
        __attribute__((address_space(3))) float* scr = (__attribute__((address_space(3))) float*)lds + wave * (64 * 33);
        const int nwl = (cx.nb == 256) ? 1 : DEPTH;
        const int N_W = nwl * WI_L, N_R = S / 4, N_ALL = N_W + N_R;
        const int share = cx.bid & 7;
        unsigned* head = (unsigned*)(ws + OFF_WQ) + share * 64;
        const int per = (N_ALL + 7) / 8;
        __attribute__((address_space(3))) float* scr64 = (__attribute__((address_space(3))) float*)lds + wave * (64 * 65);
        for (;;) {
            int base = 0;
            if (lane == 0) base = (int)atomicAdd(head, 2u);
            base = __builtin_amdgcn_readfirstlane(base);
            if (base >= per) break;
#pragma unroll 1
            for (int k = 0; k < 2; ++k) {
                const int it = (base + k) * 8 + share; if (base + k >= per || it >= N_ALL) break;
                if (it < N_W) { weight_item(p, it / WI_L, it % WI_L, lane, scr64);
                } else rows_item(p.x, (bf16_t*)(ws + OFF_XB), (float*)(ws + OFF_RSTD), it - N_W, lane);
            }
        }
    }
}

struct AMapId { __device__ __forceinline__ int operator()(int k0) const { return k0; } };
struct AMapY {
    __device__ __forceinline__ int operator()(int k0) const { const int g = k0 >> 8; const int base = g == 0 ? C_GA : g == 1 ? C_GB : g == 2 ? C_GC : C_GD; return base + (k0 & 255); }
};
template <class AMap, class Epi>
__device__ __forceinline__ void gemm_naive(const Ctx& cx, const bf16_t* __restrict__ A, int lda, AMap amap, const bf16_t* __restrict__ Bt, int K, int M, int N, Epi epi, float* lds) {
    float (*As)[132] = (float (*)[132])lds;
    float (*Bs)[132] = (float (*)[132])(lds + 16 * 132);
    const int tid = cx.tid, ty = tid >> 5, tx = tid & 31;
    const int lr = tid >> 2, lk = (tid & 3) * 4;
    const int ntm = M / 128, ntn = N / 128;
    for (int tile = cx.bid; tile < ntm * ntn; tile += cx.nb) {
        const int tm = tile / ntn, tn = tile % ntn;
        float acc[8][4];
#pragma unroll
        for (int i = 0; i < 8; ++i)
#pragma unroll
            for (int j = 0; j < 4; ++j) acc[i][j] = 0.f;
        for (int k0 = 0; k0 < K; k0 += 16) {
            const uint2 av = *(const uint2*)(A + (size_t)(tm * 128 + lr) * lda + amap(k0) + lk);
            const uint2 bv = *(const uint2*)(Bt + (size_t)(tn * 128 + lr) * K + k0 + lk);
            __syncthreads();
            As[lk + 0][lr] = lo16(av.x); As[lk + 1][lr] = hi16(av.x); As[lk + 2][lr] = lo16(av.y); As[lk + 3][lr] = hi16(av.y);
            Bs[lk + 0][lr] = lo16(bv.x); Bs[lk + 1][lr] = hi16(bv.x); Bs[lk + 2][lr] = lo16(bv.y); Bs[lk + 3][lr] = hi16(bv.y);
            __syncthreads();
#pragma unroll
            for (int kk = 0; kk < 16; ++kk) {
                const float4 a0 = *(const float4*)&As[kk][ty * 8], a1 = *(const float4*)&As[kk][ty * 8 + 4];
                const float4 b = *(const float4*)&Bs[kk][tx * 4];
                const float a[8] = {a0.x, a0.y, a0.z, a0.w, a1.x, a1.y, a1.z, a1.w};
                const float bb[4] = {b.x, b.y, b.z, b.w};
#pragma unroll
                for (int i = 0; i < 8; ++i)
#pragma unroll
                    for (int j = 0; j < 4; ++j) acc[i][j] = fmaf(a[i], bb[j], acc[i][j]);
            }
        }
#pragma unroll
        for (int i = 0; i < 8; ++i) epi(tm * 128 + ty * 8 + i, tn * 128 + tx * 4, acc[i]);
    }
}
struct EpiIn {
    bf16_t* P; const float* rstd;
    __device__ __forceinline__ void operator()(int m, int n, const float (&v)[4]) const {
        const float r = rstd[m];
        *(uint2*)(P + (size_t)m * NP + n) = make_uint2(pk2(v[0] * r, v[1] * r), pk2(v[2] * r, v[3] * r));
    }
};
struct EpiOut {
    const float* xin; float* out;
    __device__ __forceinline__ void operator()(int m, int n, const float (&v)[4]) const {
        const float4 xi = *(const float4*)(xin + (size_t)m * DM + n);
        *(float4*)(out + (size_t)m * DM + n) = make_float4(xi.x + v[0], xi.y + v[1], xi.z + v[2], xi.w + v[3]);
    }
};

constexpr float QSCALE_A = 0.10206207261596577f * LOG2E;
constexpr float QSCALE_D = 0.125f * LOG2E;

__device__ __forceinline__ void post_mla(const Ctx& cx, const Params& p, int l, float* lds) {
    unsigned char* ws = p.ws;
    const bf16_t* P = (const bf16_t*)(ws + OFF_P);
    const bf16_t* WuqT = (const bf16_t*)(ws + OFF_WUQT) + (size_t)l * 384 * 256;
    const bf16_t* WukvT = (const bf16_t*)(ws + OFF_WUKVT) + (size_t)l * 512 * 128;
    bf16_t* Qa = (bf16_t*)(ws + OFF_QA); bf16_t* Ka = (bf16_t*)(ws + OFF_KA); bf16_t* Va = (bf16_t*)(ws + OFF_VA);
    const float* cosA = (const float*)(ws + OFF_COSA); const float* sinA = (const float*)(ws + OFF_SINA);
    const float* q_g = p.q_g + l * 96; const float* kn_g = p.kn_g + l * 64; const float* kr_g = p.kr_g + l * 32;
    float* cq = lds;
    float* ckv = lds + 256;
    float* kr = lds + 384;
    float* qf = lds + 416;
    float* kvf = lds + 800;
    float* st = lds + 1312;
    const int tid = cx.tid, wave = tid >> 6, lane = tid & 63;
    for (int s = cx.bid; s < S; s += cx.nb) {
        __syncthreads();
        if (tid < 416) lds[tid] = bf2f(P[(size_t)s * NP + tid]);
        __syncthreads();
        if (wave == 0) { float a = 0.f; for (int j = 0; j < 4; ++j) { const float v = cq[lane + 64 * j]; a += v * v; } a = wave_sum(a, lane); if (lane == 0) st[0] = 1.0f / sqrtf(a * (1.f / 256.f) + EPS); }
        if (wave == 1) { float a = 0.f; for (int j = 0; j < 2; ++j) { const float v = ckv[lane + 64 * j]; a += v * v; } a = wave_sum(a, lane); if (lane == 0) st[1] = 1.0f / sqrtf(a * (1.f / 128.f) + EPS); }
        if (wave == 2) { float a = 0.f; if (lane < 32) { const float v = kr[lane]; a = v * v; } a = wave_sum(a, lane); if (lane == 0) st[2] = 1.0f / sqrtf(a * (1.f / 32.f) + EPS); }
        __syncthreads();
        if (tid < 384) {
            const uint4* w = (const uint4*)(WuqT + (size_t)tid * 256);
            float a = 0.f;
            for (int c = 0; c < 32; ++c) {
                const uint4 u = w[c]; const float* x = cq + c * 8;
                a += x[0] * lo16(u.x) + x[1] * hi16(u.x) + x[2] * lo16(u.y) + x[3] * hi16(u.y) + x[4] * lo16(u.z) + x[5] * hi16(u.z) + x[6] * lo16(u.w) + x[7] * hi16(u.w);
            }
            qf[tid] = a * st[0];
        }
        {
            const uint4* w = (const uint4*)(WukvT + (size_t)tid * 128);
            float a = 0.f;
            for (int c = 0; c < 16; ++c) {
                const uint4 u = w[c]; const float* x = ckv + c * 8;
                a += x[0] * lo16(u.x) + x[1] * hi16(u.x) + x[2] * lo16(u.y) + x[3] * hi16(u.y) + x[4] * lo16(u.z) + x[5] * hi16(u.z) + x[6] * lo16(u.w) + x[7] * hi16(u.w);
            }
            kvf[tid] = a * st[1];
        }
        __syncthreads();
        if (wave < 4) {
            float a = qf[wave * 96 + lane] * qf[wave * 96 + lane];
            if (lane < 32) { const float v = qf[wave * 96 + 64 + lane]; a += v * v; }
            a = wave_sum(a, lane); if (lane == 0) st[4 + wave] = 1.0f / sqrtf(a * (1.f / 96.f) + EPS);
        } else {
            const int h = wave - 4; const float v = kvf[h * 128 + lane]; float a = wave_sum(v * v, lane);
            if (lane == 0) st[8 + h] = 1.0f / sqrtf(a * (1.f / 64.f) + EPS);
        }
        __syncthreads();
        if (tid < 384) {
            const int h = tid / 96, d = tid % 96;
            float v = qf[tid] * st[4 + h] * q_g[d];
            if (d >= 64) {
                const int i = (d - 64) & 15; const bool first = (d - 64) < 16;
                const int pd = first ? d + 16 : d - 16;
                const float pv = qf[h * 96 + pd] * st[4 + h] * q_g[pd];
                const float c = cosA[s * 16 + i], sn = sinA[s * 16 + i];
                v = first ? v * c - pv * sn : v * c + pv * sn;
            }
            Qa[((size_t)h * S + s) * 96 + d] = (bf16_t)f2bf(v * QSCALE_A);
        }
        if (tid < 256) {
            const int h = tid >> 6, d = tid & 63;
            Ka[((size_t)h * (S / 64) + (s >> 6)) * 6144 + (d >> 3) * 512 + (s & 63) * 8 + (d & 7)] = (bf16_t)f2bf(kvf[h * 128 + d] * st[8 + h] * kn_g[d]);
        } else {
            const int t2 = tid - 256, h = t2 >> 6, d = t2 & 63;
            Va[((size_t)h * (S / 64) + (s >> 6)) * 4096 + (d >> 5) * 2048 + ((s & 63) >> 4) * 512 + (s & 15) * 32 + (d & 31)] = (bf16_t)f2bf(kvf[h * 128 + 64 + d]);
        }
        if (tid < 32) {
            const int i = tid & 15; const bool first = tid < 16; const int pd = first ? tid + 16 : tid - 16;
            const float v = kr[tid] * st[2] * kr_g[tid], pv = kr[pd] * st[2] * kr_g[pd];
            const float c = cosA[s * 16 + i], sn = sinA[s * 16 + i];
            const bf16_t o = (bf16_t)f2bf(first ? v * c - pv * sn : v * c + pv * sn);
            for (int h = 0; h < 4; ++h) Ka[((size_t)h * (S / 64) + (s >> 6)) * 6144 + ((64 + tid) >> 3) * 512 + (s & 63) * 8 + (tid & 7)] = o;
        }
    }
}

__device__ __forceinline__ void post_conv(const Ctx& cx, const Params& p, int l) {
    bf16_t* P = (bf16_t*)(p.ws + OFF_P);
    const float* cw = p.conv_w + l * 3 * 256;
    const int gtid = cx.bid * NT + cx.tid, GT = cx.nb * NT;
    for (int i = gtid; i < S * 256; i += GT) {
        const int t = i >> 8, c = i & 255;
        const bf16_t* row = P + (size_t)t * NP;
        float z0 = bf2f(row[C_CC + c]) * bf2f(row[C_CH + c]);
        float z1 = 0.f, z2 = 0.f;
        if (t >= 1) { const bf16_t* r1 = row - NP; z1 = bf2f(r1[C_CC + c]) * bf2f(r1[C_CH + c]); }
        if (t >= 2) { const bf16_t* r2 = row - 2 * NP; z2 = bf2f(r2[C_CC + c]) * bf2f(r2[C_CH + c]); }
        const float conv = cw[c] * z2 + cw[256 + c] * z1 + cw[512 + c] * z0;
        const float y = bf2f(row[C_CB + c]) * conv * silu(bf2f(row[C_GB + c]));
        P[(size_t)t * NP + C_GB + c] = (bf16_t)f2bf(y);
    }
}

__device__ __forceinline__ void post_sg(const Ctx& cx, const Params& p, int l, float* lds) {
    bf16_t* P = (bf16_t*)(p.ws + OFF_P);
    const bf16_t* SGW = (const bf16_t*)(p.ws + OFF_SGW) + (size_t)l * 4 * 128 * 128;
    const float* lng = p.ln_g + l * 256; const float* lnb = p.ln_b + l * 256; const float* sgb = p.sg_b + l * 4 * 128;
    float (*vn)[65] = (float (*)[65])lds;
    const int tid = cx.tid, r = tid >> 2, q4 = tid & 3, lane = tid & 63;
    for (int it = cx.bid; it < 128 * 4; it += cx.nb) {
        const int ch = it >> 2, g = it & 3;
        const size_t row = (size_t)ch * 128 + r;
        __syncthreads();
        float xv[64];
        {
            const uint4* src = (const uint4*)(P + row * NP + C_SV + q4 * 64);
#pragma unroll
            for (int c = 0; c < 8; ++c) { const uint4 u = src[c]; xv[c * 8 + 0] = lo16(u.x); xv[c * 8 + 1] = hi16(u.x); xv[c * 8 + 2] = lo16(u.y); xv[c * 8 + 3] = hi16(u.y); xv[c * 8 + 4] = lo16(u.z); xv[c * 8 + 5] = hi16(u.z); xv[c * 8 + 6] = lo16(u.w); xv[c * 8 + 7] = hi16(u.w); }
        }
        float sm = 0.f;
#pragma unroll
        for (int c = 0; c < 64; ++c) sm += xv[c];
        sm += shx(sm, 1, lane); sm += shx(sm, 2, lane);
        const float mu = sm * (1.f / 256.f);
        float sq = 0.f;
#pragma unroll
        for (int c = 0; c < 64; ++c) { const float d = xv[c] - mu; sq += d * d; }
        sq += shx(sq, 1, lane); sq += shx(sq, 2, lane);
        const float rs = 1.0f / sqrtf(sq * (1.f / 256.f) + EPS);
        if (q4 == g) {
#pragma unroll
            for (int c = 0; c < 64; ++c) vn[r][c] = (xv[c] - mu) * rs * lng[g * 64 + c] + lnb[g * 64 + c];
        }
        __syncthreads();
        float acc[16];
#pragma unroll
        for (int j = 0; j < 16; ++j) acc[j] = 0.f;
        const bf16_t* wrow = SGW + ((size_t)g * 128 + r) * 128;
        for (int s_ = 0; s_ <= r; ++s_) {
            const float w = bf2f(wrow[s_]);
#pragma unroll
            for (int j = 0; j < 16; ++j) acc[j] = fmaf(w, vn[s_][q4 * 16 + j], acc[j]);
        }
        const float bias = sgb[g * 128 + r];
        bf16_t* prow = P + row * NP;
#pragma unroll
        for (int j = 0; j < 16; ++j) {
            const int c = g * 64 + q4 * 16 + j;
            const float y = bf2f(prow[C_SU + c]) * (acc[j] + bias) * silu(bf2f(prow[C_GC + c]));
            prow[C_GC + c] = (bf16_t)f2bf(y);
        }
    }
}

__device__ __forceinline__ void post_moba(const Ctx& cx, const Params& p, int l, float* lds) {
    bf16_t* P = (bf16_t*)(p.ws + OFF_P);
    float* kmean = (float*)(p.ws + OFF_KMEAN);
    const float* cosD = (const float*)(p.ws + OFF_COSD); const float* sinD = (const float*)(p.ws + OFF_SIND);
    const float* mq_g = p.mq_g + l * 64; const float* mk_g = p.mk_g + l * 64;
    float (*kf)[65] = (float (*)[65])lds;
    const int tid = cx.tid;
    for (int it = cx.bid; it < 64 * 4; it += cx.nb) {
        const int n = it >> 2, h = it & 3;
        const bool isq = tid >= 256; const int r = tid & 255;
        const int srow = n * 256 + r;
        bf16_t* ptr = P + (size_t)srow * NP + (isq ? C_MQ : C_MK) + h * 64;
        const float* gg = isq ? mq_g : mk_g;
        float v[64];
        {
            const uint4* src = (const uint4*)ptr;
#pragma unroll
            for (int c = 0; c < 8; ++c) { const uint4 u = src[c]; v[c * 8 + 0] = lo16(u.x); v[c * 8 + 1] = hi16(u.x); v[c * 8 + 2] = lo16(u.y); v[c * 8 + 3] = hi16(u.y); v[c * 8 + 4] = lo16(u.z); v[c * 8 + 5] = hi16(u.z); v[c * 8 + 6] = lo16(u.w); v[c * 8 + 7] = hi16(u.w); }
        }
        float ss = 0.f;
#pragma unroll
        for (int c = 0; c < 64; ++c) ss += v[c] * v[c];
        const float rs = 1.0f / sqrtf(ss * (1.f / 64.f) + EPS);
#pragma unroll
        for (int c = 0; c < 64; ++c) v[c] = v[c] * rs * gg[c];
#pragma unroll
        for (int i = 0; i < 8; ++i) {
            const float c_ = cosD[srow * 8 + i], s_ = sinD[srow * 8 + i];
            const float a = v[i], b = v[i + 8];
            v[i] = a * c_ - b * s_; v[i + 8] = b * c_ + a * s_;
        }
        __syncthreads();
        if (!isq) {
#pragma unroll
            for (int c = 0; c < 64; ++c) kf[r][c] = v[c];
        }
        const float sc = isq ? QSCALE_D : 1.0f;
        {
            uint4* dst = (uint4*)ptr;
#pragma unroll
            for (int c = 0; c < 8; ++c) dst[c] = make_uint4(pk2(v[c * 8] * sc, v[c * 8 + 1] * sc), pk2(v[c * 8 + 2] * sc, v[c * 8 + 3] * sc), pk2(v[c * 8 + 4] * sc, v[c * 8 + 5] * sc), pk2(v[c * 8 + 6] * sc, v[c * 8 + 7] * sc));
        }
        __syncthreads();
        if (tid < 64) {
            float a = 0.f;
            for (int rr = 0; rr < 256; ++rr) a += kf[rr][tid];
            kmean[((size_t)h * 64 + n) * 64 + tid] = a * (1.f / 256.f);
        }
    }
}

__device__ __forceinline__ void phase_gate(const Ctx& cx, const Params& p, int l) {
    const bf16_t* P = (const bf16_t*)(p.ws + OFF_P);
    const float* kmean = (const float*)(p.ws + OFF_KMEAN);
    int* sel = (int*)(p.ws + OFF_SEL); int* mcnt = (int*)(p.ws + OFF_MCNT); int* mlist = (int*)(p.ws + OFF_LIST);
    const int gtid = cx.bid * NT + cx.tid, GT = cx.nb * NT;
    for (int i = gtid; i < 4 * S; i += GT) {
        const int h = i / S, s = i % S, qb = s >> 8;
        float q[64];
        {
            const uint4* src = (const uint4*)(P + (size_t)s * NP + C_MQ + h * 64);
#pragma unroll
            for (int c = 0; c < 8; ++c) { const uint4 u = src[c]; q[c * 8 + 0] = lo16(u.x); q[c * 8 + 1] = hi16(u.x); q[c * 8 + 2] = lo16(u.y); q[c * 8 + 3] = hi16(u.y); q[c * 8 + 4] = lo16(u.z); q[c * 8 + 5] = hi16(u.z); q[c * 8 + 6] = lo16(u.w); q[c * 8 + 7] = hi16(u.w); }
        }
        float b0 = -3.0e38f, b1 = -3.0e38f, b2 = -3.0e38f; int i0 = -1, i1 = -1, i2 = -1;
        for (int n = 0; n < qb; ++n) {
            const float* km = kmean + ((size_t)h * 64 + n) * 64;
            float g = 0.f;
#pragma unroll
            for (int c = 0; c < 64; ++c) g = fmaf(q[c], km[c], g);
            if (g > b0) { b2 = b1; i2 = i1; b1 = b0; i1 = i0; b0 = g; i0 = n; }
            else if (g > b1) { b2 = b1; i2 = i1; b1 = g; i1 = n; }
            else if (g > b2) { b2 = g; i2 = n; }
        }
        const int nv = qb < 3 ? qb : 3;
        *(int4*)(sel + (size_t)i * 4) = make_int4(i0, i1, i2, nv);
        const int lane = cx.tid & 63;
#pragma unroll 1
        for (int j = 0; j < 3; ++j) {
            const int n = j == 0 ? i0 : j == 1 ? i1 : i2; const bool valid = j < nv;
            unsigned long long todo = __ballot(valid);
            while (todo) {
                const int leader = __builtin_ctzll(todo);
                const int n0 = __builtin_amdgcn_readlane(n, leader);
                const bool mine = valid && n == n0;
                const unsigned long long m = __ballot(mine);
                const int rank = __builtin_popcountll(m & ((1ull << lane) - 1ull));
                int base = 0;
                if (lane == leader) base = atomicAdd(mcnt + h * 64 + n0, __builtin_popcountll(m));
                base = __builtin_amdgcn_readlane(base, leader);
                if (mine) mlist[(size_t)h * LIST_PER_HEAD + 256 * (63 * n0 - n0 * (n0 - 1) / 2) + base + rank] = (s << 2) | j;
                todo &= ~m;
            }
        }
    }
}

__device__ __forceinline__ void attn_mla_naive(const Ctx& cx, const Params& p, int l, float* lds) {
    unsigned char* ws = p.ws;
    bf16_t* P = (bf16_t*)(ws + OFF_P);
    const bf16_t* Qa = (const bf16_t*)(ws + OFF_QA); const bf16_t* Ka = (const bf16_t*)(ws + OFF_KA); const bf16_t* Va = (const bf16_t*)(ws + OFF_VA);
    float (*Ks)[100] = (float (*)[100])lds;
    float (*Vs)[68] = (float (*)[68])(lds + 64 * 100);
    float c2;
    {
        float gq = 0.f, gn = 0.f, gr = 0.f;
        for (int d = 0; d < 96; ++d) gq = fmaxf(gq, fabsf(p.q_g[l * 96 + d]));
        for (int d = 0; d < 64; ++d) gn = fmaxf(gn, fabsf(p.kn_g[l * 64 + d]));
        for (int d = 0; d < 32; ++d) gr = fmaxf(gr, fabsf(p.kr_g[l * 32 + d]));
        c2 = gq * sqrtf(64.f * gn * gn + 32.f * gr * gr) * LOG2E * 1.02f;
    }
    const int tid = cx.tid, qi = tid >> 2, part = tid & 3, lane = tid & 63;
    for (int it = cx.bid; it < 512; it += cx.nb) {
        const int pi = it & 255, sec = it >> 8, h = pi >> 6, j = pi & 63, i = sec ? 127 - j : j;
        const int qrow = i * 128 + qi;
        float q[96];
        {
            const uint4* src = (const uint4*)(Qa + ((size_t)h * S + qrow) * 96);
#pragma unroll
            for (int c = 0; c < 12; ++c) { const uint4 u = src[c]; q[c * 8 + 0] = lo16(u.x); q[c * 8 + 1] = hi16(u.x); q[c * 8 + 2] = lo16(u.y); q[c * 8 + 3] = hi16(u.y); q[c * 8 + 4] = lo16(u.z); q[c * 8 + 5] = hi16(u.z); q[c * 8 + 6] = lo16(u.w); q[c * 8 + 7] = hi16(u.w); }
        }
        float o[64];
#pragma unroll
        for (int d = 0; d < 64; ++d) o[d] = 0.f;
        float lsum = 0.f;
        const int ntiles = 2 * (i + 1);
        for (int kt = 0; kt < ntiles; ++kt) {
            __syncthreads();
            for (int c = tid; c < 768; c += NT) {
                const int key = c / 12, chn = c % 12;
                const uint4 u = *(const uint4*)(Ka + ((size_t)h * (S / 64) + kt) * 6144 + chn * 512 + key * 8);
                float* d_ = &Ks[key][chn * 8];
                d_[0] = lo16(u.x); d_[1] = hi16(u.x); d_[2] = lo16(u.y); d_[3] = hi16(u.y); d_[4] = lo16(u.z); d_[5] = hi16(u.z); d_[6] = lo16(u.w); d_[7] = hi16(u.w);
            }
            {
                const int key = tid >> 3, chn = tid & 7;
                const uint4 u = *(const uint4*)(Va + ((size_t)h * (S / 64) + kt) * 4096 + (chn >> 2) * 2048 + (key >> 4) * 512 + (key & 15) * 32 + (chn & 3) * 8);
                float* d_ = &Vs[key][chn * 8];
                d_[0] = lo16(u.x); d_[1] = hi16(u.x); d_[2] = lo16(u.y); d_[3] = hi16(u.y); d_[4] = lo16(u.z); d_[5] = hi16(u.z); d_[6] = lo16(u.w); d_[7] = hi16(u.w);
            }
            __syncthreads();
            for (int kk = 0; kk < 16; ++kk) {
                const int key = part + 4 * kk, kpos = kt * 64 + key;
                float sc = 0.f;
#pragma unroll
                for (int d = 0; d < 96; d += 4) { const float4 kv = *(const float4*)&Ks[key][d]; sc = fmaf(q[d], kv.x, sc); sc = fmaf(q[d + 1], kv.y, sc); sc = fmaf(q[d + 2], kv.z, sc); sc = fmaf(q[d + 3], kv.w, sc); }
                const float pr = (kpos <= qrow) ? exp2f(sc - c2) : 0.f;
                lsum += pr;
#pragma unroll
                for (int d = 0; d < 64; d += 4) { const float4 vv = *(const float4*)&Vs[key][d]; o[d] = fmaf(pr, vv.x, o[d]); o[d + 1] = fmaf(pr, vv.y, o[d + 1]); o[d + 2] = fmaf(pr, vv.z, o[d + 2]); o[d + 3] = fmaf(pr, vv.w, o[d + 3]); }
            }
        }
        lsum += shx(lsum, 1, lane); lsum += shx(lsum, 2, lane);
        const float inv = 1.0f / lsum;
        bf16_t* prow = P + (size_t)qrow * NP + C_GA + h * 64;
#pragma unroll
        for (int d = 0; d < 64; ++d) {
            float v = o[d]; v += shx(v, 1, lane); v += shx(v, 2, lane);
            if ((d >> 4) == part) { const float g = bf2f(prow[d]); prow[d] = (bf16_t)f2bf(v * inv * silu(g)); }
        }
    }
}

__device__ __forceinline__ void attn_moba_naive(const Ctx& cx, const Params& p, int l) {
    bf16_t* P = (bf16_t*)(p.ws + OFF_P);
    const int* sel = (const int*)(p.ws + OFF_SEL);
    float c2;
    {
        float gq = 0.f, gk = 0.f;
        for (int d = 0; d < 64; ++d) { gq = fmaxf(gq, fabsf(p.mq_g[l * 64 + d])); gk = fmaxf(gk, fabsf(p.mk_g[l * 64 + d])); }
        c2 = gq * gk * 8.0f * LOG2E * 1.02f;
    }
    const int wave = cx.tid >> 6, lane = cx.tid & 63;
    const int gw = cx.bid * (NT / 64) + wave, NGW = cx.nb * (NT / 64);
    for (int it = gw; it < 4 * S; it += NGW) {
        const int h = it / S, s = it % S, own = s >> 8;
        float q[64];
        {
            const uint4* src = (const uint4*)(P + (size_t)s * NP + C_MQ + h * 64);
#pragma unroll
            for (int c = 0; c < 8; ++c) { const uint4 u = src[c]; q[c * 8 + 0] = lo16(u.x); q[c * 8 + 1] = hi16(u.x); q[c * 8 + 2] = lo16(u.y); q[c * 8 + 3] = hi16(u.y); q[c * 8 + 4] = lo16(u.z); q[c * 8 + 5] = hi16(u.z); q[c * 8 + 6] = lo16(u.w); q[c * 8 + 7] = hi16(u.w); }
        }
        const int4 sl = *(const int4*)(sel + (size_t)it * 4);
        float o[64];
#pragma unroll
        for (int d = 0; d < 64; ++d) o[d] = 0.f;
        float lsum = 0.f;
        const int nsel = sl.w;
#pragma unroll 1
        for (int bi = 3 - nsel; bi < 4; ++bi) {
            const int sidx = 2 - bi;
            const int blk = bi == 3 ? own : (sidx == 0 ? sl.x : sidx == 1 ? sl.y : sl.z);
#pragma unroll 1
            for (int jj = 0; jj < 4; ++jj) {
                const int kpos = blk * 256 + lane + 64 * jj;
                const uint4* kp = (const uint4*)(P + (size_t)kpos * NP + C_MK + h * 64);
                float sc = 0.f;
#pragma unroll
                for (int c = 0; c < 8; ++c) { const uint4 u = kp[c]; sc += q[c * 8] * lo16(u.x) + q[c * 8 + 1] * hi16(u.x) + q[c * 8 + 2] * lo16(u.y) + q[c * 8 + 3] * hi16(u.y) + q[c * 8 + 4] * lo16(u.z) + q[c * 8 + 5] * hi16(u.z) + q[c * 8 + 6] * lo16(u.w) + q[c * 8 + 7] * hi16(u.w); }
                const bool ok = (bi != 3) || (kpos <= s);
                const float pr = ok ? exp2f(sc - c2) : 0.f;
                lsum += pr;
                const uint4* vp = (const uint4*)(P + (size_t)kpos * NP + C_MV + h * 64);
#pragma unroll
                for (int c = 0; c < 8; ++c) { const uint4 u = vp[c]; o[c * 8] = fmaf(pr, lo16(u.x), o[c * 8]); o[c * 8 + 1] = fmaf(pr, hi16(u.x), o[c * 8 + 1]); o[c * 8 + 2] = fmaf(pr, lo16(u.y), o[c * 8 + 2]); o[c * 8 + 3] = fmaf(pr, hi16(u.y), o[c * 8 + 3]); o[c * 8 + 4] = fmaf(pr, lo16(u.z), o[c * 8 + 4]); o[c * 8 + 5] = fmaf(pr, hi16(u.z), o[c * 8 + 5]); o[c * 8 + 6] = fmaf(pr, lo16(u.w), o[c * 8 + 6]); o[c * 8 + 7] = fmaf(pr, hi16(u.w), o[c * 8 + 7]); }
            }
        }
        lsum = wave_sum(lsum, lane);
        float r32[32], r16[16], r8[8], r4[4], r2[2];
#pragma unroll
        for (int d = 0; d < 32; ++d) { const bool hb = (lane & 32) != 0; const float keep = hb ? o[d + 32] : o[d], send = hb ? o[d] : o[d + 32]; r32[d] = keep + shx(send, 32, lane); }
#pragma unroll
        for (int d = 0; d < 16; ++d) { const bool hb = (lane & 16) != 0; const float keep = hb ? r32[d + 16] : r32[d], send = hb ? r32[d] : r32[d + 16]; r16[d] = keep + shx(send, 16, lane); }
#pragma unroll
        for (int d = 0; d < 8; ++d) { const bool hb = (lane & 8) != 0; const float keep = hb ? r16[d + 8] : r16[d], send = hb ? r16[d] : r16[d + 8]; r8[d] = keep + shx(send, 8, lane); }
#pragma unroll
        for (int d = 0; d < 4; ++d) { const bool hb = (lane & 4) != 0; const float keep = hb ? r8[d + 4] : r8[d], send = hb ? r8[d] : r8[d + 4]; r4[d] = keep + shx(send, 4, lane); }
#pragma unroll
        for (int d = 0; d < 2; ++d) { const bool hb = (lane & 2) != 0; const float keep = hb ? r4[d + 2] : r4[d], send = hb ? r4[d] : r4[d + 2]; r2[d] = keep + shx(send, 2, lane); }
        float mine;
        { const bool hb = (lane & 1) != 0; const float keep = hb ? r2[1] : r2[0], send = hb ? r2[0] : r2[1]; mine = keep + shx(send, 1, lane); }
        bf16_t* gp = P + (size_t)s * NP + C_GD + h * 64 + lane;
        const float g = bf2f(*gp);
        *gp = (bf16_t)f2bf(mine / lsum * silu(g));
    }
}


namespace mla {
typedef short bf16x8 __attribute__((ext_vector_type(8)));
typedef short s16x4 __attribute__((ext_vector_type(4)));
typedef float f32x16 __attribute__((ext_vector_type(16)));
typedef unsigned u32x4 __attribute__((ext_vector_type(4)));
#define LAS3 __attribute__((address_space(3)))
constexpr int KT_BYTES = 12288, VT_BYTES = 8192, STAGE_BYTES = 2 * KT_BYTES + 2 * VT_BYTES;
constexpr int OFF_OCOMB = 2 * STAGE_BYTES, OFF_LCOMB = OFF_OCOMB + 32768, OFF_WSF = OFF_LCOMB + 512, OFF_OST = OFF_WSF + 512, MLA_LDS_END = OFF_OST + 16384;
static_assert(MLA_LDS_END <= LDS_BYTES, "mla lds");
__device__ __forceinline__ int crow(int r, int hi) { return (r & 3) + 8 * (r >> 2) + 4 * hi; }
__device__ __forceinline__ s16x4 vtr(const LAS3 unsigned char* p) { typedef short v4i16_t __attribute__((ext_vector_type(4))); return __builtin_bit_cast(s16x4, __builtin_amdgcn_ds_read_tr16_b64_v4i16((LAS3 v4i16_t*)p)); }
__device__ __forceinline__ unsigned cvtpk(float lo, float hi) { typedef float f32x2_t __attribute__((ext_vector_type(2))); typedef __bf16 bf16x2_t __attribute__((ext_vector_type(2))); f32x2_t v = {lo, hi}; bf16x2_t b = __builtin_convertvector(v, bf16x2_t); return __builtin_bit_cast(unsigned, b); }

__device__ __forceinline__ void attn_mla_fast(const Ctx& cx, const Params& p, int l, unsigned char* lds_generic) {
    unsigned char* ws = p.ws;
    bf16_t* P = (bf16_t*)(ws + OFF_P);
    const bf16_t* Qa = (const bf16_t*)(ws + OFF_QA); const bf16_t* Ka = (const bf16_t*)(ws + OFF_KA); const bf16_t* Va = (const bf16_t*)(ws + OFF_VA);
    LAS3 unsigned char* lds = (LAS3 unsigned char*)lds_generic;
    float c2;
    {
        float gq = 0.f, gn = 0.f, gr = 0.f;
        for (int d = 0; d < 96; ++d) gq = fmaxf(gq, fabsf(p.q_g[l * 96 + d]));
        for (int d = 0; d < 64; ++d) gn = fmaxf(gn, fabsf(p.kn_g[l * 64 + d]));
        for (int d = 0; d < 32; ++d) gr = fmaxf(gr, fabsf(p.kr_g[l * 32 + d]));
        c2 = gq * sqrtf(64.f * gn * gn + 32.f * gr * gr) * LOG2E * 1.02f;
    }
    const int tid = cx.tid, lane = tid & 63, r32 = lane & 31, hi = lane >> 5;
    const int wave = __builtin_amdgcn_readfirstlane(tid >> 6), grp = wave >> 2, w = wave & 3;
    int kgo[3], klo[3];
#pragma unroll
    for (int j = 0; j < 3; ++j) { const int idx = tid + 512 * j, tile = idx / 768, rem = idx % 768, c = rem >> 6, key = rem & 63; kgo[j] = (tile * 64 + key) * 96 + c * 8; klo[j] = tile * KT_BYTES + c * 1024 + key * 16; }
    const int vkey = tid >> 3, vdc = tid & 7;
    const int vgo = vkey * 64 + vdc * 8, vlo_ = 2 * KT_BYTES + (vdc >> 2) * 4096 + (vkey >> 4) * 1024 + (vkey & 15) * 64 + (vdc & 3) * 16;
    const int kfrag = hi * 1024 + r32 * 16;
    const int vfrag = ((lane >> 4) & 1) * 32 + (lane & 3) * 8 + (4 * hi + ((lane & 15) >> 2)) * 64;
    for (int it = cx.bid; it < 512; it += cx.nb) {
        const int pi = it & 255, sec = it >> 8, h = pi >> 6, jj = pi & 63, i = sec ? 127 - jj : jj;
        const int q0 = i * 128, qrow = q0 + 32 * w + r32, nsteps = i + 1;
        const bf16_t* Kh = Ka + (size_t)h * S * 96; const bf16_t* Vh = Va + (size_t)h * S * 64;
        bf16x8 qr[6];
#pragma unroll
        for (int d0 = 0; d0 < 6; ++d0) qr[d0] = *(const bf16x8*)(Qa + ((size_t)h * S + qrow) * 96 + d0 * 16 + hi * 8);
        f32x16 o0, o1;
#pragma unroll
        for (int r = 0; r < 16; ++r) { o0[r] = 0.f; o1[r] = 0.f; }
        float lsum = 0.f;
        u32x4 kreg[3], vreg[2];
#define MLA_LOADG(st) do { const bf16_t* kb_ = Kh + (size_t)(st) * 128 * 96; const bf16_t* vb_ = Vh + (size_t)(st) * 128 * 64; \
            _Pragma("unroll") for (int j = 0; j < 3; ++j) kreg[j] = *(const u32x4*)(kb_ + kgo[j]); \
            vreg[0] = *(const u32x4*)(vb_ + vgo); vreg[1] = *(const u32x4*)(vb_ + 64 * 64 + vgo); } while (0)
#define MLA_WRITEL(sb) do { LAS3 unsigned char* b_ = lds + (sb) * STAGE_BYTES; \
            _Pragma("unroll") for (int j = 0; j < 3; ++j) *(LAS3 u32x4*)(b_ + klo[j]) = kreg[j]; \
            *(LAS3 u32x4*)(b_ + vlo_) = vreg[0]; *(LAS3 u32x4*)(b_ + vlo_ + VT_BYTES) = vreg[1]; } while (0)
        __syncthreads();
        MLA_LOADG(0); MLA_WRITEL(0);
        __syncthreads();
        for (int s = 0; s < nsteps; ++s) {
            const bool more = (s + 1 < nsteps), last = !more;
            if (more) MLA_LOADG(s + 1);
            const LAS3 unsigned char* Kt = lds + (s & 1) * STAGE_BYTES + grp * KT_BYTES;
            const LAS3 unsigned char* Vt = lds + (s & 1) * STAGE_BYTES + 2 * KT_BYTES + grp * VT_BYTES;
            const bool active = !(last && grp == 1 && w < 2);
            if (active) {
                f32x16 p0, p1;
#pragma unroll
                for (int r = 0; r < 16; ++r) { p0[r] = -c2; p1[r] = -c2; }
#pragma unroll
                for (int d0 = 0; d0 < 6; ++d0) {
                    const bf16x8 a0 = *(const LAS3 bf16x8*)(Kt + kfrag + d0 * 2048);
                    const bf16x8 a1 = *(const LAS3 bf16x8*)(Kt + kfrag + d0 * 2048 + 512);
                    p0 = __builtin_amdgcn_mfma_f32_32x32x16_bf16(a0, qr[d0], p0, 0, 0, 0);
                    p1 = __builtin_amdgcn_mfma_f32_32x32x16_bf16(a1, qr[d0], p1, 0, 0, 0);
                }
                if (last) {
                    const int kbase = s * 128 + grp * 64 + 4 * hi;
#pragma unroll
                    for (int r = 0; r < 16; ++r) { const int kv = kbase + (r & 3) + 8 * (r >> 2); if (kv > qrow) p0[r] = -INFINITY; if (kv + 32 > qrow) p1[r] = -INFINITY; }
                }
                float sacc = 0.f;
#pragma unroll
                for (int r = 0; r < 16; ++r) { p0[r] = __builtin_amdgcn_exp2f(p0[r]); p1[r] = __builtin_amdgcn_exp2f(p1[r]); sacc += p0[r] + p1[r]; }
                lsum += sacc;
                u32x4 pw[4];
                pw[0] = (u32x4){cvtpk(p0[0], p0[1]), cvtpk(p0[2], p0[3]), cvtpk(p0[4], p0[5]), cvtpk(p0[6], p0[7])};
                pw[1] = (u32x4){cvtpk(p0[8], p0[9]), cvtpk(p0[10], p0[11]), cvtpk(p0[12], p0[13]), cvtpk(p0[14], p0[15])};
                pw[2] = (u32x4){cvtpk(p1[0], p1[1]), cvtpk(p1[2], p1[3]), cvtpk(p1[4], p1[5]), cvtpk(p1[6], p1[7])};
                pw[3] = (u32x4){cvtpk(p1[8], p1[9]), cvtpk(p1[10], p1[11]), cvtpk(p1[12], p1[13]), cvtpk(p1[14], p1[15])};
#pragma unroll
                for (int ks = 0; ks < 4; ++ks) {
                    const s16x4 l0 = vtr(Vt + vfrag + ks * 1024), h0 = vtr(Vt + vfrag + ks * 1024 + 512);
                    const s16x4 l1 = vtr(Vt + vfrag + 4096 + ks * 1024), h1 = vtr(Vt + vfrag + 4096 + ks * 1024 + 512);
                    const bf16x8 b0 = (bf16x8){l0[0], l0[1], l0[2], l0[3], h0[0], h0[1], h0[2], h0[3]};
                    const bf16x8 b1 = (bf16x8){l1[0], l1[1], l1[2], l1[3], h1[0], h1[1], h1[2], h1[3]};
                    const bf16x8 pa = __builtin_bit_cast(bf16x8, pw[ks]);
                    o0 = __builtin_amdgcn_mfma_f32_32x32x16_bf16(pa, b0, o0, 0, 0, 0);
                    o1 = __builtin_amdgcn_mfma_f32_32x32x16_bf16(pa, b1, o1, 0, 0, 0);
                }
            }
            if (more) MLA_WRITEL((s + 1) & 1);
            __syncthreads();
        }
#undef MLA_LOADG
#undef MLA_WRITEL
        lsum += shx(lsum, 32, lane);
        LAS3 float* Ocomb = (LAS3 float*)(lds + OFF_OCOMB) + w * 2048;
        LAS3 float* lcomb = (LAS3 float*)(lds + OFF_LCOMB) + w * 32;
        LAS3 float* wsf = (LAS3 float*)(lds + OFF_WSF) + w * 32;
        LAS3 bf16_t* Ost = (LAS3 bf16_t*)(lds + OFF_OST);
        if (grp == 1) {
#pragma unroll
            for (int r = 0; r < 16; ++r) { Ocomb[r * 64 + lane] = o0[r]; Ocomb[1024 + r * 64 + lane] = o1[r]; }
            if (hi == 0) lcomb[r32] = lsum;
        }
        __syncthreads();
        if (grp == 0) {
#pragma unroll
            for (int r = 0; r < 16; ++r) { o0[r] += Ocomb[r * 64 + lane]; o1[r] += Ocomb[1024 + r * 64 + lane]; }
            lsum += lcomb[r32];
            if (hi == 0) wsf[r32] = lsum;
            __builtin_amdgcn_s_waitcnt(0xC07F);
#pragma unroll
            for (int r = 0; r < 16; ++r) {
                const int orow = crow(r, hi); const float rl = 1.0f / wsf[orow];
                Ost[(32 * w + orow) * 64 + r32] = (bf16_t)f2bf(o0[r] * rl);
                Ost[(32 * w + orow) * 64 + 32 + r32] = (bf16_t)f2bf(o1[r] * rl);
            }
        }
        __syncthreads();
#pragma unroll
        for (int j = 0; j < 2; ++j) {
            const int chunk = tid + 512 * j, row = chunk >> 3, dc = chunk & 7;
            const u32x4 ov = *(const LAS3 u32x4*)(Ost + row * 64 + dc * 8);
            bf16_t* gp = P + (size_t)(q0 + row) * NP + C_GA + h * 64 + dc * 8;
            const uint4 gv = *(const uint4*)gp;
            uint4 y;
            y.x = pk2(lo16(ov.x) * silu(lo16(gv.x)), hi16(ov.x) * silu(hi16(gv.x)));
            y.y = pk2(lo16(ov.y) * silu(lo16(gv.y)), hi16(ov.y) * silu(hi16(gv.y)));
            y.z = pk2(lo16(ov.z) * silu(lo16(gv.z)), hi16(ov.z) * silu(hi16(gv.z)));
            y.w = pk2(lo16(ov.w) * silu(lo16(gv.w)), hi16(ov.w) * silu(hi16(gv.w)));
            *(uint4*)gp = y;
        }
    }
}
}


namespace mla2 {
using mla::bf16x8; using mla::s16x4; using mla::f32x16; using mla::u32x4; using mla::crow; using mla::vtr; using mla::cvtpk;
constexpr int KT_BYTES = 12288, VT_BYTES = 8192, STAGE_BYTES = 2 * KT_BYTES + 2 * VT_BYTES, NSTAGE = 3;
constexpr int OFF_OCOMB = 0  , OFF_LCOMB = NSTAGE * STAGE_BYTES, OFF_WSF = OFF_LCOMB + 512, OFF_OST = OFF_WSF + 512, MLA_LDS_END = OFF_OST + 16384;
static_assert(MLA_LDS_END <= LDS_BYTES - 64, "mla2 lds");
#define SBAR() __builtin_amdgcn_sched_barrier(0)
__device__ __forceinline__ void glds16(const void* gsrc, unsigned lds_dst) { unsigned keep;
    asm volatile("s_mov_b32 %0, m0\n\ts_mov_b32 m0, %2\n\ts_nop 0\n\tglobal_load_lds_dwordx4 %1, off\n\ts_mov_b32 m0, %0" : "=&s"(keep) : "v"(gsrc), "s"(lds_dst) : "memory"); }
#define P2_WAITBAR() asm volatile("s_waitcnt vmcnt(0) lgkmcnt(0)\n\ts_barrier" ::: "memory")
#define PEL(P0, P1, f) ((f) < 16 ? P0[(f) & 15] : P1[(f) & 15])
__device__ __forceinline__ void attn_mla_pipe(const Ctx& cx, const Params& p, int l, unsigned char* lds_generic) {
    unsigned char* ws = p.ws;
    bf16_t* P = (bf16_t*)(ws + OFF_P);
    const bf16_t* Qa = (const bf16_t*)(ws + OFF_QA); const bf16_t* Ka = (const bf16_t*)(ws + OFF_KA); const bf16_t* Va = (const bf16_t*)(ws + OFF_VA);
    LAS3 unsigned char* lds = (LAS3 unsigned char*)lds_generic;
    const unsigned lds0 = (unsigned)(uintptr_t)lds;
    const float c2 = ((const float*)(ws + OFF_C2))[l * 2];
    const int tid = cx.tid, lane = tid & 63, r32 = lane & 31, hi = lane >> 5;
    const int wave = __builtin_amdgcn_readfirstlane(tid >> 6), grp = wave >> 2, w = wave & 3;
    int gso[5], ldo[5]; bool isk[5];
#pragma unroll
    for (int j = 0; j < 5; ++j) {
        const int pidx = wave + 8 * j, tile = pidx / 20, wi = pidx % 20;
        isk[j] = wi < 12;
        if (wi < 12) { gso[j] = tile * 6144 + wi * 512 + lane * 8; ldo[j] = tile * KT_BYTES + wi * 1024; }
        else { const int v = wi - 12, dh = v >> 2, kg = v & 3; gso[j] = tile * 4096 + v * 512 + lane * 8; ldo[j] = 2 * KT_BYTES + tile * VT_BYTES + dh * 4096 + kg * 1024; }
    }
    const int kfrag = hi * 1024 + r32 * 16 + grp * KT_BYTES;
    const int vfrag = ((lane >> 4) & 1) * 32 + (lane & 3) * 8 + (4 * hi + ((lane & 15) >> 2)) * 64 + 2 * KT_BYTES + grp * VT_BYTES;
    const float coff = fmaxf(c2 - 64.f, 0.f);
    const f32x16 zero16 = {0.f, 0.f, 0.f, 0.f, 0.f, 0.f, 0.f, 0.f, 0.f, 0.f, 0.f, 0.f, 0.f, 0.f, 0.f, 0.f};
    for (int it = cx.bid; it < 512; it += cx.nb) {
        const int pi = it & 255, sec = it >> 8, xcd = pi & 7, idx = pi >> 3, h = xcd >> 1, jj = (xcd & 1) * 32 + idx, i = sec ? 127 - jj : jj;
        const int q0 = i * 128, qrow = q0 + 32 * w + r32, nsteps = i + 1;
        const bf16_t* Kh = Ka + (size_t)h * S * 96; const bf16_t* Vh = Va + (size_t)h * S * 64;
        bf16x8 qr[6];
#pragma unroll
        for (int d0 = 0; d0 < 6; ++d0) qr[d0] = *(const bf16x8*)(Qa + ((size_t)h * S + qrow) * 96 + d0 * 16 + hi * 8);
        f32x16 o0, o1, pa0, pa1, pb0, pb1;
#pragma unroll
        for (int r = 0; r < 16; ++r) { o0[r] = 0.f; o1[r] = 0.f; }
        float lsum = 0.f;
        u32x4 pw[4];
        int sl_prev = 0, sl_cur = 0, sl_next = STAGE_BYTES;
#define ROT() do { sl_prev = sl_cur; sl_cur = sl_next; sl_next = (sl_next == (NSTAGE - 1) * STAGE_BYTES) ? 0 : sl_next + STAGE_BYTES; } while (0)
#define P2_DMA(st, soff) do { const bf16_t* kb_ = Kh + (size_t)(st) * 128 * 96; const bf16_t* vb_ = Vh + (size_t)(st) * 128 * 64; \
            _Pragma("unroll") for (int j = 0; j < 5; ++j) glds16((isk[j] ? kb_ : vb_) + gso[j], (unsigned)__builtin_amdgcn_readfirstlane((int)(lds0 + (soff) + ldo[j]))); } while (0)
#define P2_DMA1(st, soff, j) do { const bf16_t* kb_ = Kh + (size_t)(st) * 128 * 96; const bf16_t* vb_ = Vh + (size_t)(st) * 128 * 64; \
            glds16((isk[j] ? kb_ : vb_) + gso[j], (unsigned)__builtin_amdgcn_readfirstlane((int)(lds0 + (soff) + ldo[j]))); } while (0)
#define P2_MASK(C0, C1, s_) do { const int kbase_ = (s_) * 128 + grp * 64 + 4 * hi; \
            _Pragma("unroll") for (int r = 0; r < 16; ++r) { const int kv_ = kbase_ + (r & 3) + 8 * (r >> 2); if (kv_ > qrow) C0[r] = -INFINITY; if (kv_ + 32 > qrow) C1[r] = -INFINITY; } } while (0)
#define PIN(x) asm volatile("" : "+v"(x))
#define KFR(mm) (*(const LAS3 bf16x8*)(Kt_ + ((mm) >> 1) * 2048 + ((mm) & 1) * 512))
#define VFRD(buf, ii) do { vlo[buf] = vtr(Vp_ + ((ii) >> 2) * 4096 + ((ii) & 3) * 1024); vhi[buf] = vtr(Vp_ + ((ii) >> 2) * 4096 + ((ii) & 3) * 1024 + 512); } while (0)
#define P2_STEP(C0, C1, P0, P1, PREV, s_) do { \
            const bool more_ = ((s_) + 1 < nsteps); \
            const LAS3 unsigned char* Kt_ = lds + sl_cur + kfrag; const LAS3 unsigned char* Vp_ = lds + sl_prev + vfrag; \
            s16x4 vlo[3], vhi[3]; bf16x8 kf[4]; float sacc = 0.f; \
            kf[0] = KFR(0); kf[1] = KFR(1); kf[2] = KFR(2); \
            SBAR(); \
            _Pragma("unroll") for (int m = 0; m < 12; ++m) { \
                if (m + 3 < 12) kf[(m + 3) & 3] = KFR(m + 3); \
                if (more_ && (m & 1) == 1 && m < 10) P2_DMA1((s_) + 1, sl_next, (m >> 1)); \
                if (PREV && m == 9) VFRD(0, 0); \
                if (PREV && m == 10) VFRD(1, 1); \
                if ((m & 1) == 0) C0 = __builtin_amdgcn_mfma_f32_32x32x16_bf16(kf[m & 3], qr[m >> 1], (m >> 1) == 0 ? zero16 : C0, 0, 0, 0); \
                else              C1 = __builtin_amdgcn_mfma_f32_32x32x16_bf16(kf[m & 3], qr[m >> 1], (m >> 1) == 0 ? zero16 : C1, 0, 0, 0); \
                if (PREV && m < 8) { const int f_ = 4 * (m & 7); \
                    sacc += PEL(P0, P1, f_); sacc += PEL(P0, P1, f_ + 1); sacc += PEL(P0, P1, f_ + 2); sacc += PEL(P0, P1, f_ + 3); PIN(sacc); \
                    pw[(m & 7) >> 1][(m & 1) * 2] = cvtpk(PEL(P0, P1, f_), PEL(P0, P1, f_ + 1)); pw[(m & 7) >> 1][(m & 1) * 2 + 1] = cvtpk(PEL(P0, P1, f_ + 2), PEL(P0, P1, f_ + 3)); PIN(pw[(m & 7) >> 1]); } \
                SBAR(); } \
            lsum += sacc; \
            if (coff > 0.f) { _Pragma("unroll") for (int r = 0; r < 16; ++r) { C0[r] -= coff; C1[r] -= coff; } } \
            if (!more_) P2_MASK(C0, C1, s_); \
            SBAR(); \
            _Pragma("unroll") for (int j = 0; j < 8; ++j) { \
                if (PREV) { \
                    if (j + 2 < 8) VFRD((j + 2) % 3, j + 2); \
                    const bf16x8 vb_ = (bf16x8){vlo[j % 3][0], vlo[j % 3][1], vlo[j % 3][2], vlo[j % 3][3], vhi[j % 3][0], vhi[j % 3][1], vhi[j % 3][2], vhi[j % 3][3]}; \
                    if (j < 4) o0 = __builtin_amdgcn_mfma_f32_32x32x16_bf16(__builtin_bit_cast(bf16x8, pw[j & 3]), vb_, o0, 0, 0, 0); \
                    else       o1 = __builtin_amdgcn_mfma_f32_32x32x16_bf16(__builtin_bit_cast(bf16x8, pw[j & 3]), vb_, o1, 0, 0, 0); } \
                if (j < 4) { C0[4 * j] = __builtin_amdgcn_exp2f(C0[4 * j]); C0[4 * j + 1] = __builtin_amdgcn_exp2f(C0[4 * j + 1]); C0[4 * j + 2] = __builtin_amdgcn_exp2f(C0[4 * j + 2]); C0[4 * j + 3] = __builtin_amdgcn_exp2f(C0[4 * j + 3]); PIN(C0); } \
                else { C1[4 * (j & 3)] = __builtin_amdgcn_exp2f(C1[4 * (j & 3)]); C1[4 * (j & 3) + 1] = __builtin_amdgcn_exp2f(C1[4 * (j & 3) + 1]); C1[4 * (j & 3) + 2] = __builtin_amdgcn_exp2f(C1[4 * (j & 3) + 2]); C1[4 * (j & 3) + 3] = __builtin_amdgcn_exp2f(C1[4 * (j & 3) + 3]); PIN(C1); } \
                SBAR(); } \
            P2_WAITBAR(); ROT(); \
        } while (0)
#define P2_DRAIN(P0, P1) do { const LAS3 unsigned char* Vp_ = lds + sl_prev + vfrag; float sacc = 0.f; \
            _Pragma("unroll") for (int r = 0; r < 16; ++r) sacc += P0[r] + P1[r]; \
            lsum += sacc; \
            pw[0] = (u32x4){cvtpk(P0[0], P0[1]), cvtpk(P0[2], P0[3]), cvtpk(P0[4], P0[5]), cvtpk(P0[6], P0[7])}; \
            pw[1] = (u32x4){cvtpk(P0[8], P0[9]), cvtpk(P0[10], P0[11]), cvtpk(P0[12], P0[13]), cvtpk(P0[14], P0[15])}; \
            pw[2] = (u32x4){cvtpk(P1[0], P1[1]), cvtpk(P1[2], P1[3]), cvtpk(P1[4], P1[5]), cvtpk(P1[6], P1[7])}; \
            pw[3] = (u32x4){cvtpk(P1[8], P1[9]), cvtpk(P1[10], P1[11]), cvtpk(P1[12], P1[13]), cvtpk(P1[14], P1[15])}; \
            _Pragma("unroll") for (int ks = 0; ks < 4; ++ks) { \
                const s16x4 l0 = vtr(Vp_ + ks * 1024), h0 = vtr(Vp_ + ks * 1024 + 512), l1 = vtr(Vp_ + 4096 + ks * 1024), h1 = vtr(Vp_ + 4096 + ks * 1024 + 512); \
                const bf16x8 b0 = (bf16x8){l0[0], l0[1], l0[2], l0[3], h0[0], h0[1], h0[2], h0[3]}; const bf16x8 b1 = (bf16x8){l1[0], l1[1], l1[2], l1[3], h1[0], h1[1], h1[2], h1[3]}; \
                o0 = __builtin_amdgcn_mfma_f32_32x32x16_bf16(__builtin_bit_cast(bf16x8, pw[ks]), b0, o0, 0, 0, 0); \
                o1 = __builtin_amdgcn_mfma_f32_32x32x16_bf16(__builtin_bit_cast(bf16x8, pw[ks]), b1, o1, 0, 0, 0); } } while (0)
        __syncthreads();
        P2_DMA(0, 0);
        P2_WAITBAR();
        int s = 0;
        P2_STEP(pa0, pa1, pb0, pb1, false, 0);
        for (s = 1; s + 1 < nsteps; s += 2) {
            P2_STEP(pb0, pb1, pa0, pa1, true, s);
            P2_STEP(pa0, pa1, pb0, pb1, true, s + 1);
        }
        u32x4 gvp[2];
#define P2_GVLOAD() do { _Pragma("unroll") for (int j = 0; j < 2; ++j) { const int chunk = tid + 512 * j, row = chunk >> 3, dc = chunk & 7; \
            gvp[j] = *(const u32x4*)(P + (size_t)(q0 + row) * NP + C_GA + h * 64 + dc * 8); } } while (0)
        if (s < nsteps) { P2_STEP(pb0, pb1, pa0, pa1, true, s); P2_GVLOAD(); P2_DRAIN(pb0, pb1); }
        else { P2_GVLOAD(); P2_DRAIN(pa0, pa1); }
#undef P2_GVLOAD
#undef ROT
#undef P2_DMA
#undef P2_DMA1
#undef P2_MASK
#undef P2_STEP
#undef PIN
#undef KFR
#undef VFRD
#undef P2_DRAIN
        lsum += shx(lsum, 32, lane);
        LAS3 float* Ocomb = (LAS3 float*)(lds + OFF_OCOMB) + w * 2048;
        LAS3 float* lcomb = (LAS3 float*)(lds + OFF_LCOMB) + w * 32;
        LAS3 float* wsf = (LAS3 float*)(lds + OFF_WSF) + w * 32;
        LAS3 bf16_t* Ost = (LAS3 bf16_t*)(lds + OFF_OST);
        __syncthreads();
        if (grp == 1) {
#pragma unroll
            for (int r = 0; r < 16; ++r) { Ocomb[r * 64 + lane] = o0[r]; Ocomb[1024 + r * 64 + lane] = o1[r]; }
            if (hi == 0) lcomb[r32] = lsum;
        }
        __syncthreads();
        if (grp == 0) {
#pragma unroll
            for (int r = 0; r < 16; ++r) { o0[r] += Ocomb[r * 64 + lane]; o1[r] += Ocomb[1024 + r * 64 + lane]; }
            lsum += lcomb[r32];
            if (hi == 0) wsf[r32] = lsum;
            __builtin_amdgcn_s_waitcnt(0xC07F);
#pragma unroll
            for (int r = 0; r < 16; ++r) {
                const int orow = crow(r, hi); const float rl = 1.0f / wsf[orow];
                Ost[(32 * w + orow) * 64 + r32] = (bf16_t)f2bf(o0[r] * rl);
                Ost[(32 * w + orow) * 64 + 32 + r32] = (bf16_t)f2bf(o1[r] * rl);
            }
        }
        __syncthreads();
#pragma unroll
        for (int j = 0; j < 2; ++j) {
            const int chunk = tid + 512 * j, row = chunk >> 3, dc = chunk & 7;
            const u32x4 ov = *(const LAS3 u32x4*)(Ost + row * 64 + dc * 8);
            bf16_t* gp = P + (size_t)(q0 + row) * NP + C_GA + h * 64 + dc * 8;
            const u32x4 gv = gvp[j];
            u32x4 y;
            y.x = pk2(lo16(ov.x) * silu(lo16(gv.x)), hi16(ov.x) * silu(hi16(gv.x)));
            y.y = pk2(lo16(ov.y) * silu(lo16(gv.y)), hi16(ov.y) * silu(hi16(gv.y)));
            y.z = pk2(lo16(ov.z) * silu(lo16(gv.z)), hi16(ov.z) * silu(hi16(gv.z)));
            y.w = pk2(lo16(ov.w) * silu(lo16(gv.w)), hi16(ov.w) * silu(hi16(gv.w)));
            *(u32x4*)gp = y;
        }
    }
}
#undef SBAR
#undef PEL
}

namespace moba {
using mla::bf16x8; using mla::s16x4; using mla::f32x16; using mla::u32x4; using mla::crow; using mla::vtr; using mla::cvtpk;
constexpr int KV_BYTES = 65536, OST_PITCH = 72, OFF_MOST = KV_BYTES, OFF_MDST = OFF_MOST + 256 * OST_PITCH * 2, OFF_MLT = OFF_MDST + 1024, OFF_MPRE = OFF_MLT + 1024, MOBA_LDS_END = OFF_MPRE + 1040;
static_assert(MOBA_LDS_END <= LDS_BYTES - 64, "moba lds");
template <bool OWN>
__device__ __forceinline__ void block_item(const Ctx& cx, const Params& p, int l, LAS3 unsigned char* lds, float c2, int h, int n, const int* lst, int cnt, int cstart, bool restage,
                                           bool have_pf, int& pf_entry, int& pf_valid, bf16x8& pq0, bf16x8& pq1, bf16x8& pq2, bf16x8& pq3, bool has_next, int nx_h, const int* nx_lst, int nx_cnt, int nx_cstart) {
    bf16_t* P = (bf16_t*)(p.ws + OFF_P);
    bf16_t* part = (bf16_t*)(p.ws + OFF_PART); float* lpart = (float*)(p.ws + OFF_LPART);
    const int tid = cx.tid, lane = tid & 63, r32 = lane & 31, hi = lane >> 5;
    const int w = __builtin_amdgcn_readfirstlane(tid >> 6);
    __syncthreads();
    const int rr = 32 * w + r32;
    int entry = 0; bool valid = true;
    if (!OWN) { if (have_pf) { entry = pf_entry; valid = pf_valid != 0; } else { const int e = cstart + rr; valid = e < cnt; entry = lst[valid ? e : cstart]; } }
    u32x4 kr[4], vr[4];
    if (restage) {
        const bf16_t* kb = P + (size_t)n * 256 * NP + C_MK + h * 64; const bf16_t* vb = P + (size_t)n * 256 * NP + C_MV + h * 64;
#pragma unroll
        for (int j = 0; j < 4; ++j) { const int idx = tid + 512 * j, tile = idx >> 9, c = (idx & 511) >> 6, key = idx & 63; kr[j] = *(const u32x4*)(kb + (size_t)(tile * 64 + key) * NP + c * 8); }
#pragma unroll
        for (int j = 0; j < 4; ++j) { const int key = tid >> 3, dc = tid & 7; vr[j] = *(const u32x4*)(vb + (size_t)(j * 64 + key) * NP + dc * 8); }
    }
    const int srow = OWN ? n * 256 + rr : (entry >> 2);
    bf16x8 qr[4];
    if (!OWN && have_pf) {
        qr[0] = pq0; qr[1] = pq1; qr[2] = pq2; qr[3] = pq3;
    } else {
#pragma unroll
        for (int d0 = 0; d0 < 4; ++d0) qr[d0] = *(const bf16x8*)(P + (size_t)srow * NP + C_MQ + h * 64 + d0 * 16 + hi * 8);
    }
    int nentry = 0; bool nvalid = false;
    if (!OWN && has_next) { const int e = nx_cstart + rr; nvalid = e < nx_cnt; nentry = nx_lst[nvalid ? e : nx_cstart]; }
    if (restage) {
#pragma unroll
        for (int j = 0; j < 4; ++j) { const int idx = tid + 512 * j, tile = idx >> 9, c = (idx & 511) >> 6, key = idx & 63; *(LAS3 u32x4*)(lds + tile * 8192 + c * 1024 + key * 16) = kr[j]; }
#pragma unroll
        for (int j = 0; j < 4; ++j) { const int key = tid >> 3, dc = tid & 7; *(LAS3 u32x4*)(lds + 32768 + j * 8192 + (dc >> 2) * 4096 + (key >> 4) * 1024 + (key & 15) * 64 + (dc & 3) * 16) = vr[j]; }
    }
    u32x4 pvv[4][3]; float lpp[4][3]; u32x4 gvv[4];
    if (OWN) {
        const int nsel = n < 3 ? n : 3;
#pragma unroll
        for (int k = 0; k < 4; ++k) { const int chunk = tid + 512 * k, row = chunk >> 3, dc = chunk & 7, sq = n * 256 + row; const size_t pb = ((size_t)h * S + sq) * 3;
#pragma unroll
            for (int j = 0; j < 3; ++j) { if (j < nsel) { lpp[k][j] = lpart[pb + j]; pvv[k][j] = *(const u32x4*)(part + (pb + j) * 64 + dc * 8); } else { lpp[k][j] = 0.f; pvv[k][j] = (u32x4){0u, 0u, 0u, 0u}; } }
            gvv[k] = *(const u32x4*)(P + (size_t)sq * NP + C_GD + h * 64 + dc * 8); }
    }
    f32x16 o0, o1;
#pragma unroll
    for (int r = 0; r < 16; ++r) { o0[r] = 0.f; o1[r] = 0.f; }
    float lsum = 0.f;
    const int kfrag = hi * 1024 + r32 * 16;
    const int vfrag = ((lane >> 4) & 1) * 32 + (lane & 3) * 8 + (4 * hi + ((lane & 15) >> 2)) * 64;
    const int tmax = OWN ? (w >> 1) : 3;
    __syncthreads();
#pragma unroll 1
    for (int t = 0; t <= tmax; ++t) {
        if (!OWN && has_next && t == 1) {
            const bf16_t* nq = P + (size_t)(nentry >> 2) * NP + C_MQ + nx_h * 64 + hi * 8;
            pq0 = *(const bf16x8*)nq; pq1 = *(const bf16x8*)(nq + 16); pq2 = *(const bf16x8*)(nq + 32); pq3 = *(const bf16x8*)(nq + 48);
        }
        const LAS3 unsigned char* Kt = lds + t * 8192; const LAS3 unsigned char* Vt = lds + 32768 + t * 8192;
        f32x16 p0, p1;
#pragma unroll
        for (int r = 0; r < 16; ++r) { p0[r] = -c2; p1[r] = -c2; }
#pragma unroll
        for (int d0 = 0; d0 < 4; ++d0) {
            const bf16x8 a0 = *(const LAS3 bf16x8*)(Kt + kfrag + d0 * 2048);
            const bf16x8 a1 = *(const LAS3 bf16x8*)(Kt + kfrag + d0 * 2048 + 512);
            p0 = __builtin_amdgcn_mfma_f32_32x32x16_bf16(a0, qr[d0], p0, 0, 0, 0);
            p1 = __builtin_amdgcn_mfma_f32_32x32x16_bf16(a1, qr[d0], p1, 0, 0, 0);
        }
        if (OWN && t == tmax) {
            const int kbase = t * 64 + 4 * hi;
#pragma unroll
            for (int r = 0; r < 16; ++r) { const int kv = kbase + (r & 3) + 8 * (r >> 2); if (kv > rr) p0[r] = -INFINITY; if (kv + 32 > rr) p1[r] = -INFINITY; }
        }
        float sacc = 0.f;
#pragma unroll
        for (int r = 0; r < 16; ++r) { p0[r] = __builtin_amdgcn_exp2f(p0[r]); p1[r] = __builtin_amdgcn_exp2f(p1[r]); sacc += p0[r] + p1[r]; }
        lsum += sacc;
        u32x4 pw[4];
        pw[0] = (u32x4){cvtpk(p0[0], p0[1]), cvtpk(p0[2], p0[3]), cvtpk(p0[4], p0[5]), cvtpk(p0[6], p0[7])};
        pw[1] = (u32x4){cvtpk(p0[8], p0[9]), cvtpk(p0[10], p0[11]), cvtpk(p0[12], p0[13]), cvtpk(p0[14], p0[15])};
        pw[2] = (u32x4){cvtpk(p1[0], p1[1]), cvtpk(p1[2], p1[3]), cvtpk(p1[4], p1[5]), cvtpk(p1[6], p1[7])};
        pw[3] = (u32x4){cvtpk(p1[8], p1[9]), cvtpk(p1[10], p1[11]), cvtpk(p1[12], p1[13]), cvtpk(p1[14], p1[15])};
#pragma unroll
        for (int ks = 0; ks < 4; ++ks) {
            const s16x4 l0 = vtr(Vt + vfrag + ks * 1024), h0 = vtr(Vt + vfrag + ks * 1024 + 512);
            const s16x4 l1 = vtr(Vt + vfrag + 4096 + ks * 1024), h1 = vtr(Vt + vfrag + 4096 + ks * 1024 + 512);
            const bf16x8 b0 = (bf16x8){l0[0], l0[1], l0[2], l0[3], h0[0], h0[1], h0[2], h0[3]};
            const bf16x8 b1 = (bf16x8){l1[0], l1[1], l1[2], l1[3], h1[0], h1[1], h1[2], h1[3]};
            const bf16x8 pa = __builtin_bit_cast(bf16x8, pw[ks]);
            o0 = __builtin_amdgcn_mfma_f32_32x32x16_bf16(pa, b0, o0, 0, 0, 0);
            o1 = __builtin_amdgcn_mfma_f32_32x32x16_bf16(pa, b1, o1, 0, 0, 0);
        }
    }
    if (!OWN) { pf_entry = nentry; pf_valid = nvalid ? 1 : 0; }
    lsum += shx(lsum, 32, lane);
    LAS3 bf16_t* Ost = (LAS3 bf16_t*)(lds + OFF_MOST); LAS3 int* dstT = (LAS3 int*)(lds + OFF_MDST); LAS3 float* lT = (LAS3 float*)(lds + OFF_MLT);
#pragma unroll
    for (int r = 0; r < 16; ++r) { const int q = 32 * w + crow(r, hi); Ost[q * OST_PITCH + r32] = (bf16_t)f2bf(o0[r]); Ost[q * OST_PITCH + 32 + r32] = (bf16_t)f2bf(o1[r]); }
    if (hi == 0) { lT[rr] = lsum; if (!OWN) dstT[rr] = valid ? (h * S + (entry >> 2)) * 3 + (entry & 3) : -1; }
    __syncthreads();
#pragma unroll
    for (int k = 0; k < 4; ++k) {
        const int chunk = tid + 512 * k, row = chunk >> 3, dc = chunk & 7;
        const u32x4 ov = *(const LAS3 u32x4*)(Ost + row * OST_PITCH + dc * 8);
        if (!OWN) {
            const int d = dstT[row];
            if (d >= 0) { *(u32x4*)(part + (size_t)d * 64 + dc * 8) = ov; if (dc == 0) lpart[d] = lT[row]; }
        } else {
            const int sq = n * 256 + row;
            float lt = lT[row];
            float a[8] = {lo16(ov[0]), hi16(ov[0]), lo16(ov[1]), hi16(ov[1]), lo16(ov[2]), hi16(ov[2]), lo16(ov[3]), hi16(ov[3])};
#pragma unroll
            for (int j = 0; j < 3; ++j) {
                lt += lpp[k][j];
                const u32x4 pv = pvv[k][j];
                a[0] += lo16(pv[0]); a[1] += hi16(pv[0]); a[2] += lo16(pv[1]); a[3] += hi16(pv[1]); a[4] += lo16(pv[2]); a[5] += hi16(pv[2]); a[6] += lo16(pv[3]); a[7] += hi16(pv[3]);
            }
            const float rl = 1.0f / lt;
            bf16_t* gp = P + (size_t)sq * NP + C_GD + h * 64 + dc * 8;
            const u32x4 gv = gvv[k];
            u32x4 y;
            y[0] = pk2(a[0] * rl * silu(lo16(gv[0])), a[1] * rl * silu(hi16(gv[0])));
            y[1] = pk2(a[2] * rl * silu(lo16(gv[1])), a[3] * rl * silu(hi16(gv[1])));
            y[2] = pk2(a[4] * rl * silu(lo16(gv[2])), a[5] * rl * silu(hi16(gv[2])));
            y[3] = pk2(a[6] * rl * silu(lo16(gv[3])), a[7] * rl * silu(hi16(gv[3])));
            *(u32x4*)gp = y;
        }
    }
}
__device__ __forceinline__ float c2_bound(const Params& p, int l) {
    float gq = 0.f, gk = 0.f;
    for (int d = 0; d < 64; ++d) { gq = fmaxf(gq, fabsf(p.mq_g[l * 64 + d])); gk = fmaxf(gk, fabsf(p.mk_g[l * 64 + d])); }
    return gq * gk * 8.0f * LOG2E * 1.02f;
}
__device__ __forceinline__ void gather_items(const Ctx& cx, const Params& p, int l, unsigned char* lds_generic) {
    LAS3 unsigned char* lds = (LAS3 unsigned char*)lds_generic;
    const int* mcnt = (const int*)(p.ws + OFF_MCNT); const int* mlist = (const int*)(p.ws + OFF_LIST);
    LAS3 int* pre = (LAS3 int*)(lds + OFF_MPRE);
    const float c2 = ((const float*)(p.ws + OFF_C2))[l * 2 + 1];
    __syncthreads();
    {
        const int tid_ = cx.tid, lane_ = tid_ & 63;
        const int cnt_ = tid_ < 256 ? (mcnt[tid_] + 255) >> 8 : 0;
        int inc = cnt_;
#pragma unroll
        for (int o = 1; o < 64; o <<= 1) { const int t_ = __builtin_amdgcn_ds_bpermute(((lane_ - o) & 63) << 2, inc); if (lane_ >= o) inc += t_; }
        LAS3 int* wt = (LAS3 int*)(lds + OFF_MLT);
        if (lane_ == 63 && tid_ < 256) wt[tid_ >> 6] = inc;
        __syncthreads();
        int base = 0;
#pragma unroll
        for (int w_ = 0; w_ < 3; ++w_) if (w_ < (tid_ >> 6)) base += wt[w_];
        if (tid_ < 256) pre[tid_] = base + inc - cnt_;
        if (tid_ == 255) pre[256] = base + inc;
    }
    __syncthreads();
    const int total = pre[256];
    unsigned* gctr = (unsigned*)(p.ws + OFF_GCTR) + l * 16;
    LAS3 int* slot = (LAS3 int*)(lds + OFF_MPRE) + 258;
    int staged = -1;
    int pf_entry = 0, pf_valid = 0; bf16x8 pq0 = (bf16x8){0, 0, 0, 0, 0, 0, 0, 0}, pq1 = pq0, pq2 = pq0, pq3 = pq0;
    bool have_pf = false;
    int c = 2 * cx.bid, cn = 2 * cx.bid + 1;
    while (c < total) {
        int pulled = 0;
        if (cx.tid == 0) pulled = (int)atomicAdd(gctr, 1u);
        int pair, npair;
        { int lo = 0, hi_ = 255; while (lo < hi_) { const int mid = (lo + hi_ + 1) >> 1; if (pre[mid] <= c) lo = mid; else hi_ = mid - 1; } pair = lo; }
        const bool has_next = cn < total;
        npair = pair;
        if (has_next) { int lo = 0, hi_ = 255; while (lo < hi_) { const int mid = (lo + hi_ + 1) >> 1; if (pre[mid] <= cn) lo = mid; else hi_ = mid - 1; } npair = lo; }
        const int h = pair >> 6, n = pair & 63, cstart = (c - pre[pair]) * 256;
        const int nh = npair >> 6, nn = npair & 63, ncstart = (cn - pre[npair]) * 256;
        block_item<false>(cx, p, l, lds, c2, h, n, mlist + (size_t)h * LIST_PER_HEAD + 256 * (63 * n - n * (n - 1) / 2), mcnt[pair], cstart, pair != staged,
                          have_pf, pf_entry, pf_valid, pq0, pq1, pq2, pq3, has_next, nh, mlist + (size_t)nh * LIST_PER_HEAD + 256 * (63 * nn - nn * (nn - 1) / 2), has_next ? mcnt[npair] : 0, ncstart);
        staged = pair; have_pf = has_next;
        if (cx.tid == 0) *slot = pulled;
        __syncthreads();
        c = cn; cn = 2 * cx.nb + *slot;
    }
}
__device__ __forceinline__ void own_items(const Ctx& cx, const Params& p, int l, unsigned char* lds_generic) {
    LAS3 unsigned char* lds = (LAS3 unsigned char*)lds_generic;
    const float c2 = ((const float*)(p.ws + OFF_C2))[l * 2 + 1];
    for (int it = cx.bid; it < 256; it += cx.nb) { int e_ = 0, v_ = 0; bf16x8 z0 = (bf16x8){0, 0, 0, 0, 0, 0, 0, 0}, z1 = z0, z2 = z0, z3 = z0; block_item<true>(cx, p, l, lds, c2, it >> 6, it & 63, nullptr, 0, 0, true, false, e_, v_, z0, z1, z2, z3, false, 0, nullptr, 0, 0); }
}
}

namespace post {
using mla::bf16x8; using mla::s16x4; using mla::f32x16; using mla::u32x4; using mla::crow; using mla::vtr; using mla::cvtpk;
typedef unsigned u32x2 __attribute__((ext_vector_type(2)));
typedef float f32x4 __attribute__((ext_vector_type(4)));
__device__ __forceinline__ float sumsq8(const bf16x8& b) { float a = 0.f;
#pragma unroll
    for (int j = 0; j < 8; ++j) { const float v = bf2f((bf16_t)b[j]); a = fmaf(v, v, a); } return a; }

__device__ __forceinline__ void mla_up(const Ctx& cx, const Params& p, int l, unsigned char* lds_generic) {
    unsigned char* ws = p.ws;
    const bf16_t* P = (const bf16_t*)(ws + OFF_P);
    const bf16_t* WuqF = (const bf16_t*)(ws + OFF_WUQF) + (size_t)l * 384 * 256;
    const bf16_t* WukvF = (const bf16_t*)(ws + OFF_WUKVF) + (size_t)l * 512 * 128;
    bf16_t* Qa = (bf16_t*)(ws + OFF_QA); bf16_t* Ka = (bf16_t*)(ws + OFF_KA); bf16_t* Va = (bf16_t*)(ws + OFF_VA);
    const float* cosA = (const float*)(ws + OFF_COSA); const float* sinA = (const float*)(ws + OFF_SINA);
    const int tid = cx.tid, lane = tid & 63, r32 = lane & 31, hi = lane >> 5;
    const int w = __builtin_amdgcn_readfirstlane(tid >> 6), th = w >> 2, h = w & 3;
    LAS3 float* gl = (LAS3 float*)(LAS3 unsigned char*)lds_generic;
    __syncthreads();
    if (tid < 192) gl[tid] = tid < 96 ? p.q_g[l * 96 + tid] : tid < 160 ? p.kn_g[l * 64 + tid - 96] : p.kr_g[l * 32 + tid - 160];
    __syncthreads();
    for (int it = cx.bid; it < S / 64; it += cx.nb) {
        const int tok = it * 64 + th * 32 + r32;
        const bf16_t* prow = P + (size_t)tok * NP;
        asm volatile("" : "+v"(prow));
        bf16x8 bq[16];
#pragma unroll
        for (int ks = 0; ks < 16; ++ks) bq[ks] = *(const bf16x8*)(prow + C_CQ + ks * 16 + hi * 8);
        const char* wq0 = (const char*)WuqF + ((size_t)h * 3 * 16 * 64 + hi * 32 + r32) * 16;
        asm volatile("" : "+v"(wq0));
        bf16x8 wq[4][3];
#pragma unroll
        for (int ks = 0; ks < 4; ++ks)
#pragma unroll
            for (int nt = 0; nt < 3; ++nt) wq[ks][nt] = *(const bf16x8*)(wq0 + (nt * 16 + ks) * 1024);
        const char* wqn0 = wq0 + 4096; const char* wqn1 = wq0 + 16384 + 4096; const char* wqn2 = wq0 + 32768 + 4096;
        const f32x4 csA0 = *(const f32x4*)(cosA + tok * 16 + 4 * hi), csA1 = *(const f32x4*)(cosA + tok * 16 + 8 + 4 * hi), snA0 = *(const f32x4*)(sinA + tok * 16 + 4 * hi), snA1 = *(const f32x4*)(sinA + tok * 16 + 8 + 4 * hi);
        bf16x8 bkv[8]; bf16x8 wk[4][4];
        {
            f32x16 c[3];
#pragma unroll
            for (int nt = 0; nt < 3; ++nt)
#pragma unroll
                for (int r = 0; r < 16; ++r) c[nt][r] = 0.f;
            float ssq = 0.f;
#pragma unroll
            for (int ks = 0; ks < 16; ++ks) {
                ssq += sumsq8(bq[ks]);
#pragma unroll
                for (int nt = 0; nt < 3; ++nt) c[nt] = __builtin_amdgcn_mfma_f32_32x32x16_bf16(wq[ks & 3][nt], bq[ks], c[nt], 0, 0, 0);
                if (ks + 4 < 16) {
                    asm volatile("" : "+v"(wqn0), "+v"(wqn1), "+v"(wqn2));
                    wq[ks & 3][0] = *(const bf16x8*)wqn0; wq[ks & 3][1] = *(const bf16x8*)wqn1; wq[ks & 3][2] = *(const bf16x8*)wqn2;
                    wqn0 += 1024; wqn1 += 1024; wqn2 += 1024;
                }
                __builtin_amdgcn_sched_barrier(0);
            }
            ssq += shx(ssq, 32, lane);
            const float rq = 1.0f / sqrtf(ssq * (1.f / 256.f) + EPS);
            float s2 = 0.f;
#pragma unroll
            for (int nt = 0; nt < 3; ++nt)
#pragma unroll
                for (int r = 0; r < 16; ++r) { c[nt][r] *= rq; s2 = fmaf(c[nt][r], c[nt][r], s2); }
            s2 += shx(s2, 32, lane);
            const float rh = 1.0f / sqrtf(s2 * (1.f / 96.f) + EPS);
#pragma unroll
            for (int nt = 0; nt < 3; ++nt)
#pragma unroll
                for (int q4 = 0; q4 < 4; ++q4) { const f32x4 gq = *(const LAS3 f32x4*)(gl + 32 * nt + 8 * q4 + 4 * hi);
#pragma unroll
                    for (int i = 0; i < 4; ++i) c[nt][4 * q4 + i] *= rh * gq[i]; }
#pragma unroll
            for (int r = 0; r < 8; ++r) {
                const float cs = r < 4 ? csA0[r & 3] : csA1[r & 3], sn = r < 4 ? snA0[r & 3] : snA1[r & 3];
                const float a = c[2][r], b = c[2][r + 8];
                c[2][r] = a * cs - b * sn; c[2][r + 8] = b * cs + a * sn;
            }
            bf16_t* qo = Qa + ((size_t)h * S + tok) * 96;
#pragma unroll
            for (int nt = 0; nt < 3; ++nt)
#pragma unroll
                for (int g4 = 0; g4 < 4; ++g4) {
                    u32x2 o; o.x = cvtpk(c[nt][4 * g4] * QSCALE_A, c[nt][4 * g4 + 1] * QSCALE_A); o.y = cvtpk(c[nt][4 * g4 + 2] * QSCALE_A, c[nt][4 * g4 + 3] * QSCALE_A);
                    *(u32x2*)(qo + 32 * nt + 8 * g4 + 4 * hi) = o;
                }
        }
        {
#pragma unroll
            for (int ks = 0; ks < 8; ++ks) bkv[ks] = *(const bf16x8*)(prow + C_CKV + ks * 16 + hi * 8);
            const char* wk0 = (const char*)WukvF + ((size_t)h * 4 * 8 * 64 + hi * 32 + r32) * 16;
            asm volatile("" : "+v"(wk0));
#pragma unroll
            for (int ks = 0; ks < 4; ++ks)
#pragma unroll
                for (int nt = 0; nt < 4; ++nt) wk[ks][nt] = *(const bf16x8*)(wk0 + (nt * 8 + ks) * 1024);
            const char* wkn0 = wk0 + 4096; const char* wkn1 = wk0 + 8192 + 4096; const char* wkn2 = wk0 + 16384 + 4096; const char* wkn3 = wk0 + 24576 + 4096;
            f32x16 c[4];
#pragma unroll
            for (int nt = 0; nt < 4; ++nt)
#pragma unroll
                for (int r = 0; r < 16; ++r) c[nt][r] = 0.f;
            float ssq = 0.f;
#pragma unroll
            for (int ks = 0; ks < 8; ++ks) {
                ssq += sumsq8(bkv[ks]);
#pragma unroll
                for (int nt = 0; nt < 4; ++nt) c[nt] = __builtin_amdgcn_mfma_f32_32x32x16_bf16(wk[ks & 3][nt], bkv[ks], c[nt], 0, 0, 0);
                if (ks + 4 < 8) {
                    asm volatile("" : "+v"(wkn0), "+v"(wkn1), "+v"(wkn2), "+v"(wkn3));
                    wk[ks & 3][0] = *(const bf16x8*)wkn0; wk[ks & 3][1] = *(const bf16x8*)wkn1; wk[ks & 3][2] = *(const bf16x8*)wkn2; wk[ks & 3][3] = *(const bf16x8*)wkn3;
                    wkn0 += 1024; wkn1 += 1024; wkn2 += 1024; wkn3 += 1024;
                }
                __builtin_amdgcn_sched_barrier(0);
            }
            ssq += shx(ssq, 32, lane);
            const float rkv = 1.0f / sqrtf(ssq * (1.f / 128.f) + EPS);
            float s2 = 0.f;
#pragma unroll
            for (int nt = 0; nt < 4; ++nt)
#pragma unroll
                for (int r = 0; r < 16; ++r) { c[nt][r] *= rkv; if (nt < 2) s2 = fmaf(c[nt][r], c[nt][r], s2); }
            s2 += shx(s2, 32, lane);
            const float rk = 1.0f / sqrtf(s2 * (1.f / 64.f) + EPS);
            bf16_t* ko = Ka + ((size_t)h * (S / 64) + (tok >> 6)) * 6144 + (tok & 63) * 8; bf16_t* vo = Va + ((size_t)h * (S / 64) + (tok >> 6)) * 4096 + ((tok & 63) >> 4) * 512 + (tok & 15) * 32;
#pragma unroll
            for (int nt = 0; nt < 2; ++nt)
#pragma unroll
                for (int g4 = 0; g4 < 4; ++g4) {
                    const int d = 32 * nt + 8 * g4 + 4 * hi;
                    const f32x4 gk = *(const LAS3 f32x4*)(gl + 96 + d);
                    u32x2 o; o.x = cvtpk(c[nt][4 * g4] * rk * gk[0], c[nt][4 * g4 + 1] * rk * gk[1]); o.y = cvtpk(c[nt][4 * g4 + 2] * rk * gk[2], c[nt][4 * g4 + 3] * rk * gk[3]);
                    *(u32x2*)(ko + (d >> 3) * 512 + (d & 7)) = o;
                    u32x2 v; v.x = cvtpk(c[nt + 2][4 * g4], c[nt + 2][4 * g4 + 1]); v.y = cvtpk(c[nt + 2][4 * g4 + 2], c[nt + 2][4 * g4 + 3]);
                    *(u32x2*)(vo + (d >> 5) * 2048 + (d & 31)) = v;
                }
        }
        if (h == 0) {
            const bf16x8 x1 = *(const bf16x8*)(prow + C_KR + 8 * hi), x2 = *(const bf16x8*)(prow + C_KR + 16 + 8 * hi);
            float ssq = sumsq8(x1) + sumsq8(x2);
            ssq += shx(ssq, 32, lane);
            const float rr = 1.0f / sqrtf(ssq * (1.f / 32.f) + EPS);
            float o1[8], o2[8];
#pragma unroll
            for (int j = 0; j < 8; ++j) {
                const int i = 8 * hi + j; const float cs = cosA[tok * 16 + i], sn = sinA[tok * 16 + i];
                const float a = bf2f((bf16_t)x1[j]) * rr * gl[160 + i], b = bf2f((bf16_t)x2[j]) * rr * gl[160 + 16 + i];
                o1[j] = a * cs - b * sn; o2[j] = b * cs + a * sn;
            }
            const u32x4 w1 = (u32x4){cvtpk(o1[0], o1[1]), cvtpk(o1[2], o1[3]), cvtpk(o1[4], o1[5]), cvtpk(o1[6], o1[7])};
            const u32x4 w2 = (u32x4){cvtpk(o2[0], o2[1]), cvtpk(o2[2], o2[3]), cvtpk(o2[4], o2[5]), cvtpk(o2[6], o2[7])};
#pragma unroll
            for (int hh = 0; hh < 4; ++hh) { bf16_t* ko = Ka + ((size_t)hh * (S / 64) + (tok >> 6)) * 6144 + (tok & 63) * 8; *(u32x4*)(ko + (8 + hi) * 512) = w1; *(u32x4*)(ko + (10 + hi) * 512) = w2; }
        }
    }
}

__device__ __forceinline__ void conv(const Ctx& cx, const Params& p, int l) {
    bf16_t* P = (bf16_t*)(p.ws + OFF_P);
    const float* cw = p.conv_w + l * 3 * 256;
    const int gtid = cx.bid * NT + cx.tid, GT = cx.nb * NT;
    for (int i = gtid; i < (S / 4) * 32; i += GT) {
        const int c8 = (i & 31) * 8, t0 = (i >> 5) * 4;
        float w0[8], w1[8], w2[8];
#pragma unroll
        for (int j = 0; j < 8; ++j) { w0[j] = cw[c8 + j]; w1[j] = cw[256 + c8 + j]; w2[j] = cw[512 + c8 + j]; }
        float zm2[8], zm1[8];
#pragma unroll
        for (int j = 0; j < 8; ++j) { zm2[j] = 0.f; zm1[j] = 0.f; }
        if (t0 >= 2) {
            const bf16_t* r2 = P + (size_t)(t0 - 2) * NP; const bf16_t* r1 = r2 + NP;
            const bf16x8 a2 = *(const bf16x8*)(r2 + C_CC + c8), b2 = *(const bf16x8*)(r2 + C_CH + c8), a1 = *(const bf16x8*)(r1 + C_CC + c8), b1 = *(const bf16x8*)(r1 + C_CH + c8);
#pragma unroll
            for (int j = 0; j < 8; ++j) { zm2[j] = bf2f((bf16_t)a2[j]) * bf2f((bf16_t)b2[j]); zm1[j] = bf2f((bf16_t)a1[j]) * bf2f((bf16_t)b1[j]); }
        }
#pragma unroll
        for (int tt = 0; tt < 4; ++tt) {
            bf16_t* row = P + (size_t)(t0 + tt) * NP;
            const bf16x8 a = *(const bf16x8*)(row + C_CC + c8), b = *(const bf16x8*)(row + C_CH + c8), cb = *(const bf16x8*)(row + C_CB + c8), gb = *(const bf16x8*)(row + C_GB + c8);
            float y[8];
#pragma unroll
            for (int j = 0; j < 8; ++j) {
                const float z0 = bf2f((bf16_t)a[j]) * bf2f((bf16_t)b[j]);
                const float cv = w0[j] * zm2[j] + w1[j] * zm1[j] + w2[j] * z0;
                y[j] = bf2f((bf16_t)cb[j]) * cv * silu(bf2f((bf16_t)gb[j]));
                zm2[j] = zm1[j]; zm1[j] = z0;
            }
            *(u32x4*)(row + C_GB + c8) = (u32x4){cvtpk(y[0], y[1]), cvtpk(y[2], y[3]), cvtpk(y[4], y[5]), cvtpk(y[6], y[7])};
        }
    }
}

__device__ __forceinline__ void sgate(const Ctx& cx, const Params& p, int l, unsigned char* lds_generic, int first, int stride) {
    LAS3 unsigned char* lds = (LAS3 unsigned char*)lds_generic;
    bf16_t* P = (bf16_t*)(p.ws + OFF_P);
    const bf16_t* SGW = (const bf16_t*)(p.ws + OFF_SGW) + (size_t)l * 4 * 128 * 128;
    const float* lng = p.ln_g + l * 256; const float* lnb = p.ln_b + l * 256; const float* sgb = p.sg_b + l * 4 * 128;
    const int tid = cx.tid, lane = tid & 63, r32 = lane & 31, hi = lane >> 5;
    const int w = __builtin_amdgcn_readfirstlane(tid >> 6), gi = w >> 2, psel = (w >> 1) & 1, nt = w & 1;
    const int row = tid >> 2, part = tid & 3;
    LAS3 float* lngb = (LAS3 float*)(lds + 102400);
    __syncthreads();
    lngb[tid] = tid < 256 ? lng[tid] : lnb[tid - 256];
    __syncthreads();
    for (int it = first; it < 256; it += stride) {
        const int ch = it >> 1, gp = it & 1;
        const int g = gp * 2 + gi;
        const int ttA = psel ? 1 : 0, ttB = psel ? 2 : 3;
        const bf16_t* Wg = SGW + (size_t)g * 128 * 128;
        const bf16_t* src = P + (size_t)(ch * 128 + row) * NP + C_SV + part * 64;
        bf16x8 xv[8];
#pragma unroll
        for (int c = 0; c < 8; ++c) xv[c] = *(const bf16x8*)(src + c * 8);
        bf16x8 wA[4], wB[8];
#define SG_LOAD(NA, NB) do { \
            _Pragma("unroll") for (int ks = 0; ks < NB; ++ks) wB[ks] = *(const bf16x8*)(Wg + (size_t)(32 * ttB + r32) * 128 + ks * 16 + hi * 8); \
            _Pragma("unroll") for (int ks = 0; ks < NA; ++ks) wA[ks] = *(const bf16x8*)(Wg + (size_t)(32 * ttA + r32) * 128 + ks * 16 + hi * 8); } while (0)
        if (psel) SG_LOAD(4, 6); else SG_LOAD(2, 8);
#undef SG_LOAD
        bf16x8 uv[4], gv[4];
#pragma unroll
        for (int k = 0; k < 4; ++k) { const int chunk = tid + 512 * k, t = chunk >> 4, c = gp * 128 + (chunk & 15) * 8; const bf16_t* prow = P + (size_t)(ch * 128 + t) * NP;
            uv[k] = *(const bf16x8*)(prow + C_SU + c); gv[k] = *(const bf16x8*)(prow + C_GC + c); }
        __syncthreads();
        {
            float sm = 0.f;
#pragma unroll
            for (int c = 0; c < 8; ++c)
#pragma unroll
                for (int j = 0; j < 8; ++j) sm += bf2f((bf16_t)xv[c][j]);
            sm += shx(sm, 1, lane); sm += shx(sm, 2, lane);
            const float mu = sm * (1.f / 256.f);
            float sq = 0.f;
#pragma unroll
            for (int c = 0; c < 8; ++c)
#pragma unroll
                for (int j = 0; j < 8; ++j) { const float d = bf2f((bf16_t)xv[c][j]) - mu; sq = fmaf(d, d, sq); }
            sq += shx(sq, 1, lane); sq += shx(sq, 2, lane);
            const float rs = 1.0f / sqrtf(sq * (1.f / 256.f) + EPS);
            if ((part >> 1) == gp) {
                const int gl = part & 1;
#pragma unroll
                for (int c = 0; c < 8; ++c) {
                    float y[8];
#pragma unroll
                    for (int j = 0; j < 8; ++j) { const int chn = part * 64 + c * 8 + j; y[j] = (bf2f((bf16_t)xv[c][j]) - mu) * rs * lngb[chn] + lngb[256 + chn]; }
                    *(LAS3 u32x4*)(lds + gl * 16384 + (c >> 2) * 8192 + (row >> 4) * 1024 + (row & 15) * 64 + (c & 3) * 16) = (u32x4){cvtpk(y[0], y[1]), cvtpk(y[2], y[3]), cvtpk(y[4], y[5]), cvtpk(y[6], y[7])};
                }
            }
        }
        __syncthreads();
        f32x4 sbA[4], sbB[4];
#pragma unroll
        for (int q = 0; q < 4; ++q) { sbA[q] = *(const f32x4*)(sgb + g * 128 + 32 * ttA + 8 * q + 4 * hi); sbB[q] = *(const f32x4*)(sgb + g * 128 + 32 * ttB + 8 * q + 4 * hi); }
        f32x16 accA, accB;
#pragma unroll
        for (int r = 0; r < 16; ++r) { accA[r] = 0.f; accB[r] = 0.f; }
        const LAS3 unsigned char* vb = lds + gi * 16384 + nt * 8192 + (8 * hi + ((lane & 15) >> 2)) * 64 + ((lane >> 4) & 1) * 32 + (lane & 3) * 8;
#define SG_RUN(NA, NB) do { \
            _Pragma("unroll") for (int ks = 0; ks < NB; ++ks) { \
                const s16x4 lo = vtr(vb + ks * 1024), hh = vtr(vb + ks * 1024 + 256); \
                const bf16x8 b = (bf16x8){lo[0], lo[1], lo[2], lo[3], hh[0], hh[1], hh[2], hh[3]}; \
                accB = __builtin_amdgcn_mfma_f32_32x32x16_bf16(wB[ks], b, accB, 0, 0, 0); \
                if (ks < NA) accA = __builtin_amdgcn_mfma_f32_32x32x16_bf16(wA[ks < NA ? ks : 0], b, accA, 0, 0, 0); } } while (0)
        if (psel) SG_RUN(4, 6); else SG_RUN(2, 8);
#undef SG_RUN
        LAS3 float* mx = (LAS3 float*)(lds + 32768);
#pragma unroll
        for (int half = 0; half < 2; ++half) {
            const int tt = half ? ttB : ttA;
#pragma unroll
            for (int r = 0; r < 16; ++r) { const int t = 32 * tt + crow(r, hi); mx[t * 132 + gi * 64 + 32 * nt + r32] = (half ? accB[r] + sbB[r >> 2][r & 3] : accA[r] + sbA[r >> 2][r & 3]); }
        }
        __syncthreads();
#pragma unroll
        for (int k = 0; k < 4; ++k) {
            const int chunk = tid + 512 * k, t = chunk >> 4, c8 = (chunk & 15) * 8;
            bf16_t* prow = P + (size_t)(ch * 128 + t) * NP; const int c = gp * 128 + c8;
            const LAS3 float* mp = mx + t * 132 + c8;
            float y[8];
#pragma unroll
            for (int j = 0; j < 8; ++j) y[j] = bf2f((bf16_t)uv[k][j]) * mp[j] * silu(bf2f((bf16_t)gv[k][j]));
            *(u32x4*)(prow + C_GC + c) = (u32x4){cvtpk(y[0], y[1]), cvtpk(y[2], y[3]), cvtpk(y[4], y[5]), cvtpk(y[6], y[7])};
        }
    }
}

__device__ __forceinline__ void moba_prep(const Ctx& cx, const Params& p, int l, unsigned char* lds_generic) {
    float* lds = (float*)lds_generic;
    bf16_t* P = (bf16_t*)(p.ws + OFF_P);
    float* kmean = (float*)(p.ws + OFF_KMEAN);
    const float* cosD = (const float*)(p.ws + OFF_COSD); const float* sinD = (const float*)(p.ws + OFF_SIND);
    const int tid = cx.tid, lane = tid & 63;
    const int isq = tid >> 8, rg = (tid & 255) >> 3, c = tid & 7;
    const float* gg = (isq ? p.mq_g : p.mk_g) + l * 64 + c * 8;
    float gn[8];
#pragma unroll
    for (int j = 0; j < 8; ++j) gn[j] = gg[j];
    const float sc = isq ? QSCALE_D : 1.0f;
    for (int it = cx.bid; it < 256; it += cx.nb) {
        const int n = it >> 2, h = it & 3;
        float ksum[8];
#pragma unroll
        for (int j = 0; j < 8; ++j) ksum[j] = 0.f;
        bf16x8 xv[8]; f32x4 cst[8][2];
#pragma unroll
        for (int i = 0; i < 8; ++i) xv[i] = *(const bf16x8*)(P + (size_t)(n * 256 + rg + 32 * i) * NP + (isq ? C_MQ : C_MK) + h * 64 + c * 8);
        if (c < 2) {
#pragma unroll
            for (int i = 0; i < 8; ++i) { const float* tb = (c == 0 ? cosD : sinD) + (size_t)(n * 256 + rg + 32 * i) * 8; cst[i][0] = *(const f32x4*)tb; cst[i][1] = *(const f32x4*)(tb + 4); }
        } else {
#pragma unroll
            for (int i = 0; i < 8; ++i) { cst[i][0] = (f32x4){0.f, 0.f, 0.f, 0.f}; cst[i][1] = (f32x4){0.f, 0.f, 0.f, 0.f}; }
        }
#pragma unroll
        for (int i = 0; i < 8; ++i) {
            const int srow = n * 256 + rg + 32 * i;
            bf16_t* ptr = P + (size_t)srow * NP + (isq ? C_MQ : C_MK) + h * 64 + c * 8;
            float v[8]; float ss = 0.f;
#pragma unroll
            for (int j = 0; j < 8; ++j) { v[j] = bf2f((bf16_t)xv[i][j]); ss = fmaf(v[j], v[j], ss); }
            ss += shx(ss, 1, lane); ss += shx(ss, 2, lane); ss += shx(ss, 4, lane);
            const float rs = 1.0f / sqrtf(ss * (1.f / 64.f) + EPS);
#pragma unroll
            for (int j = 0; j < 8; ++j) v[j] *= rs * gn[j];
            float o[8];
#pragma unroll
            for (int j = 0; j < 8; ++j) {
                const float other = shx(v[j], 1, lane);
                const float mine = cst[i][j >> 2][j & 3], theirs = shx(mine, 1, lane);
                float r = v[j];
                if (c < 2) r = (c == 0) ? v[j] * mine - other * theirs : v[j] * theirs + other * mine;
                o[j] = r;
            }
            if (!isq) {
#pragma unroll
                for (int j = 0; j < 8; ++j) ksum[j] += o[j];
            }
            *(u32x4*)ptr = (u32x4){cvtpk(o[0] * sc, o[1] * sc), cvtpk(o[2] * sc, o[3] * sc), cvtpk(o[4] * sc, o[5] * sc), cvtpk(o[6] * sc, o[7] * sc)};
        }
        __syncthreads();
        if (!isq) {
#pragma unroll
            for (int j = 0; j < 8; ++j) lds[rg * 64 + c * 8 + j] = ksum[j];
        }
        __syncthreads();
        if (tid < 64) { float a = 0.f; for (int r = 0; r < 32; ++r) a += lds[r * 64 + tid]; kmean[((size_t)h * 64 + n) * 64 + tid] = a * (1.f / 256.f); }
    }
}
}

__device__ __forceinline__ void gate_fast(const Ctx& cx, const Params& p, int l, unsigned char* lds_generic) {
    constexpr int KROW = 144, PLANE = 64 * KROW;
    LAS3 unsigned char* ldsb = (LAS3 unsigned char*)lds_generic;
    int* cntL = (int*)(lds_generic + 3 * PLANE); int* baseL = cntL + 64;
    const bf16_t* P = (const bf16_t*)(p.ws + OFF_P);
    const float* kmean = (const float*)(p.ws + OFF_KMEAN);
    int* mcnt = (int*)(p.ws + OFF_MCNT); int* mlist = (int*)(p.ws + OFF_LIST);
    const int tid = cx.tid, lane = tid & 63, r32 = lane & 31, hi = lane >> 5, par = hi;
    const int w = __builtin_amdgcn_readfirstlane(tid >> 6);
    for (int it = cx.bid; it < 256; it += cx.nb) {
        const int h = it >> 6, qb = it & 63, s = qb * 256 + w * 32 + r32;
        mla::bf16x8 bq[4];
#pragma unroll
        for (int ks = 0; ks < 4; ++ks) bq[ks] = *(const mla::bf16x8*)(P + (size_t)s * NP + C_MQ + h * 64 + 16 * ks + 8 * hi);
        const float4* kmg = (const float4*)(kmean + (size_t)h * 4096);
        float4 kv[2]; kv[0] = make_float4(0.f, 0.f, 0.f, 0.f); kv[1] = kv[0];
        if (tid < qb * 16) kv[0] = kmg[tid];
        if (tid + NT < qb * 16) kv[1] = kmg[tid + NT];
        __syncthreads();
#pragma unroll
        for (int j = 0; j < 2; ++j) { const int i = tid + j * NT;
            if (i < qb * 16) { const float x[4] = {kv[j].x, kv[j].y, kv[j].z, kv[j].w}; unsigned hp[4], mp[4], lp[4];
#pragma unroll
                for (int e = 0; e < 4; ++e) { const unsigned a1 = f2bf(x[e]); const float r1 = x[e] - __uint_as_float(a1 << 16); const unsigned a2 = f2bf(r1); const float r2 = r1 - __uint_as_float(a2 << 16); hp[e] = a1; mp[e] = a2; lp[e] = f2bf(r2); }
                LAS3 unsigned char* d = ldsb + (i >> 4) * KROW + (i & 15) * 8;
                *(LAS3 post::u32x2*)(d) = (post::u32x2){hp[0] | (hp[1] << 16), hp[2] | (hp[3] << 16)};
                *(LAS3 post::u32x2*)(d + PLANE) = (post::u32x2){mp[0] | (mp[1] << 16), mp[2] | (mp[3] << 16)};
                *(LAS3 post::u32x2*)(d + 2 * PLANE) = (post::u32x2){lp[0] | (lp[1] << 16), lp[2] | (lp[3] << 16)}; } }
        __syncthreads();
        mla::f32x16 acc0, acc1;
#pragma unroll
        for (int r = 0; r < 16; ++r) { acc0[r] = 0.f; acc1[r] = 0.f; }
#pragma unroll
        for (int ks = 0; ks < 4; ++ks)
#pragma unroll
            for (int pl = 0; pl < 3; ++pl) {
                const mla::bf16x8 a0 = *(const LAS3 mla::bf16x8*)(ldsb + pl * PLANE + r32 * KROW + 32 * ks + 16 * hi);
                acc0 = __builtin_amdgcn_mfma_f32_32x32x16_bf16(a0, bq[ks], acc0, 0, 0, 0);
                if (qb > 32) { const mla::bf16x8 a1 = *(const LAS3 mla::bf16x8*)(ldsb + pl * PLANE + (32 + r32) * KROW + 32 * ks + 16 * hi);
                    acc1 = __builtin_amdgcn_mfma_f32_32x32x16_bf16(a1, bq[ks], acc1, 0, 0, 0); }
            }
        float b0 = -3.0e38f, b1 = -3.0e38f, b2 = -3.0e38f; int i0 = -1, i1 = -1, i2 = -1;
#define GATE_TOP(G, N) do { const int n_ = (N); const float g_ = n_ < qb ? (G) : -3.0e38f; const bool c0_ = g_ > b0, c1_ = g_ > b1, c2_ = g_ > b2; \
            b2 = c1_ ? b1 : (c2_ ? g_ : b2); i2 = c1_ ? i1 : (c2_ ? n_ : i2); b1 = c0_ ? b0 : (c1_ ? g_ : b1); i1 = c0_ ? i0 : (c1_ ? n_ : i1); b0 = c0_ ? g_ : b0; i0 = c0_ ? n_ : i0; } while (0)
#pragma unroll
        for (int r = 0; r < 16; ++r) GATE_TOP(acc0[r], mla::crow(r, hi));
        if (qb > 32) {
#pragma unroll
            for (int r = 0; r < 16; ++r) GATE_TOP(acc1[r], 32 + mla::crow(r, hi));
        }
#undef GATE_TOP
        float pb0 = shx(b0, 32, lane), pb1 = shx(b1, 32, lane), pb2 = shx(b2, 32, lane);
        int pi0 = __builtin_amdgcn_ds_bpermute((lane ^ 32) << 2, i0), pi1 = __builtin_amdgcn_ds_bpermute((lane ^ 32) << 2, i1), pi2 = __builtin_amdgcn_ds_bpermute((lane ^ 32) << 2, i2);
#define GATE_INS(G, I) do { const float g_ = (G); const int n_ = (I); if (n_ >= 0) { \
            if (g_ > b0 || (g_ == b0 && n_ < i0)) { b2 = b1; i2 = i1; b1 = b0; i1 = i0; b0 = g_; i0 = n_; } \
            else if (g_ > b1 || (g_ == b1 && n_ < i1)) { b2 = b1; i2 = i1; b1 = g_; i1 = n_; } \
            else if (g_ > b2 || (g_ == b2 && n_ < i2)) { b2 = g_; i2 = n_; } } } while (0)
        GATE_INS(pb0, pi0); GATE_INS(pb1, pi1); GATE_INS(pb2, pi2);
#undef GATE_INS
        const int nv = qb < 3 ? qb : 3;
        __syncthreads();
        if (tid < 64) cntL[tid] = 0;
        __syncthreads();
        int rk0 = 0, rk1 = 0, rk2 = 0;
        if (par == 0) { if (nv > 0) rk0 = atomicAdd(cntL + i0, 1); if (nv > 1) rk1 = atomicAdd(cntL + i1, 1); if (nv > 2) rk2 = atomicAdd(cntL + i2, 1); }
        __syncthreads();
        if (tid < 64) { const int c = cntL[tid]; baseL[tid] = c ? atomicAdd(mcnt + h * 64 + tid, c) : 0; }
        __syncthreads();
        if (par == 0) {
            int* lh = mlist + (size_t)h * LIST_PER_HEAD;
            if (nv > 0) lh[256 * (63 * i0 - i0 * (i0 - 1) / 2) + baseL[i0] + rk0] = (s << 2) | 0;
            if (nv > 1) lh[256 * (63 * i1 - i1 * (i1 - 1) / 2) + baseL[i1] + rk1] = (s << 2) | 1;
            if (nv > 2) lh[256 * (63 * i2 - i2 * (i2 - 1) / 2) + baseL[i2] + rk2] = (s << 2) | 2;
        }
    }
}

#ifdef PROBE_CHECK
constexpr size_t OFF_T1 = OFF_END, OFF_T2 = OFF_END + (size_t)S * 256 * 2, OFF_CNT = 1024;
__device__ __forceinline__ void probe_cols(const Ctx& cx, const Params& p, int col, int dir) {
    bf16_t* P = (bf16_t*)(p.ws + OFF_P); bf16_t* T1 = (bf16_t*)(p.ws + OFF_T1); bf16_t* T2 = (bf16_t*)(p.ws + OFF_T2);
    unsigned* cnt = (unsigned*)(p.ws + OFF_CNT);
    const int gtid = cx.bid * NT + cx.tid, GT = cx.nb * NT;
    unsigned bad = 0;
    for (int i = gtid; i < S * 256; i += GT) {
        const int t = i >> 8, c = i & 255; bf16_t* pp = P + (size_t)t * NP + col + c;
        if (dir == 0) T1[i] = *pp;
        else if (dir == 1) { T2[i] = *pp; *pp = T1[i]; }
        else { const float a = bf2f(*pp), b = bf2f(T2[i]); const float d = fabsf(a - b); if (!(d <= 0.03f * fmaxf(fabsf(a), fabsf(b)) + PROBE_ABS)) ++bad; }
    }
    if (dir == 2 && bad) atomicAdd(cnt, bad);
}
__device__ __forceinline__ void probe_poison(const Ctx& cx, const Params& p) {
    const unsigned c = *(volatile unsigned*)(p.ws + OFF_CNT);
    if (cx.bid == 0 && cx.tid == 0 && c) p.out[0] += (float)c;
}
#endif


#if defined(PROBE_A) || defined(PROBE_B)
constexpr size_t OFF_TQ = OFF_END;
constexpr size_t OFF_CNT2 = 1024;
__device__ __forceinline__ void pcols(const Ctx& cx, const Params& p, int col, int width, bf16_t* buf, int op, float atol) {
    bf16_t* P = (bf16_t*)(p.ws + OFF_P); unsigned* cnt = (unsigned*)(p.ws + OFF_CNT2);
    const int gtid = cx.bid * NT + cx.tid, GT = cx.nb * NT; unsigned bad = 0;
    for (int i = gtid; i < S * width; i += GT) { const int t = i / width, c = i % width; bf16_t* pp = P + (size_t)t * NP + col + c;
        if (op == 0) buf[i] = *pp; else if (op == 1) *pp = buf[i];
        else { const float a = bf2f(*pp), b = bf2f(buf[i]); const float d = fabsf(a - b); if (!(d <= 0.03f * fmaxf(fabsf(a), fabsf(b)) + atol)) ++bad; } }
    if (op == 2 && bad) atomicAdd(cnt, bad);
}
__device__ __forceinline__ void pflat(const Ctx& cx, const Params& p, bf16_t* a_, bf16_t* b_, size_t n, int op, float atol) {
    unsigned* cnt = (unsigned*)(p.ws + OFF_CNT2);
    const size_t gtid = (size_t)cx.bid * NT + cx.tid, GT = (size_t)cx.nb * NT; unsigned bad = 0;
    for (size_t i = gtid; i < n; i += GT) { if (op == 0) b_[i] = a_[i]; else { const float a = bf2f(a_[i]), b = bf2f(b_[i]); const float d = fabsf(a - b); if (!(d <= 0.03f * fmaxf(fabsf(a), fabsf(b)) + atol)) ++bad; } }
    if (op == 2 && bad) atomicAdd(cnt, bad);
}
__device__ __forceinline__ void ppoison(const Ctx& cx, const Params& p) { const unsigned c = *(volatile unsigned*)(p.ws + OFF_CNT2); if (cx.bid == 0 && cx.tid == 0 && c) p.out[0] += (float)c; }
#endif

#define XB_TMO      128
#define XB_XCNT(j)  (256  + 64 * (j))
#define XB_XSUB(j)  (1280 + 64 * (j))
#define XB_XGEN(j)  (2304 + 64 * (j))
#define XB_TOP      3328
#define XB_TOPGEN   3392
#define XB_SPIN_CAP (1u << 20)
constexpr size_t OFF_BAR = 16384;
__device__ __forceinline__ unsigned xb_ld(unsigned* p)              { return __hip_atomic_load(p, __ATOMIC_RELAXED, __HIP_MEMORY_SCOPE_AGENT); }
__device__ __forceinline__ unsigned xb_add(unsigned* p, unsigned v) { return __hip_atomic_fetch_add(p, v, __ATOMIC_RELAXED, __HIP_MEMORY_SCOPE_AGENT); }
__device__ __forceinline__ unsigned xb_xcc_id() { return (unsigned)__builtin_amdgcn_s_getreg((3 << 11) | 20) & 0xFu; }
#define XB_SPIN(cond, bar) do { unsigned _sp = 0; while (cond) { __builtin_amdgcn_s_sleep(1); \
    if ((++_sp & 255u) == 0u) { if (xb_ld(&(bar)[XB_TMO])) break; if (_sp > XB_SPIN_CAP) { atomicAdd(&(bar)[XB_TMO], 1u); break; } } } } while (0)
__device__ __forceinline__ bool is_thread0(int wave_s) { int ln; asm volatile("v_mbcnt_lo_u32_b32 %0, -1, 0\n\tv_mbcnt_hi_u32_b32 %0, -1, %0" : "=v"(ln)); return wave_s == 0 && ln == 0; }
__device__ __forceinline__ void xcd_barrier_complete(unsigned* bar, unsigned x, unsigned& nloc, unsigned& nx) {
    const unsigned G = (unsigned)__builtin_amdgcn_grid_size_x() / NT;
    unsigned sum, cnt, mine, sp = 0u;
    for (;;) {
        sum = 0u; cnt = 0u; mine = 0u;
#pragma unroll
        for (unsigned j = 0; j < 16; ++j) { const unsigned c = xb_ld(&bar[XB_XCNT(j)]); sum += c; cnt += (c > 0u) ? 1u : 0u; mine = (j == x) ? c : mine; }
        if (sum == G) break;
        __builtin_amdgcn_s_sleep(1);
        if ((++sp & 255u) == 0u) { if (xb_ld(&bar[XB_TMO])) break; if (sp > XB_SPIN_CAP) { atomicAdd(&bar[XB_TMO], 1u); break; } }
    }
    nloc = mine > 0u ? mine : 1u; nx = cnt > 0u ? cnt : 1u;
}
__device__ __forceinline__ void xcd_barrier(unsigned char* ws, volatile __attribute__((address_space(3))) unsigned* st, int wave_s) {
    asm volatile("s_waitcnt vmcnt(0)" ::: "memory");
    __syncthreads();
    if (is_thread0(wave_s)) {
        unsigned* bar = (unsigned*)(ws + OFF_BAR);
        const unsigned x = xb_xcc_id();
        __builtin_amdgcn_s_waitcnt(0);
        unsigned nloc = st[0], nx = st[1];
        if (nloc == 0u) { xcd_barrier_complete(bar, x, nloc, nx); st[0] = nloc; st[1] = nx; }
        const unsigned old = xb_add(&bar[XB_XSUB(x)], 1u);
        const unsigned gen = old / nloc;
        if (old + 1u == (gen + 1u) * nloc) {
            __builtin_amdgcn_fence(__ATOMIC_RELEASE, "agent");
            asm volatile("s_waitcnt vmcnt(0)" ::: "memory");
            const unsigned og = xb_add(&bar[XB_TOP], 1u);
            const unsigned tg = og / nx;
            if (og + 1u == (tg + 1u) * nx) xb_add(&bar[XB_TOPGEN], 1u);
            else XB_SPIN(xb_ld(&bar[XB_TOPGEN]) == tg, bar);
            __builtin_amdgcn_fence(__ATOMIC_ACQUIRE, "agent");
            asm volatile("s_waitcnt vmcnt(0)" ::: "memory");
        } else {
            XB_SPIN(xb_ld(&bar[XB_TOPGEN]) == gen, bar);
            __builtin_amdgcn_fence(__ATOMIC_ACQUIRE, "agent");
            asm volatile("s_waitcnt vmcnt(0)" ::: "memory");
        }
    }
    __syncthreads();
}

constexpr size_t OFF_GDONE = 896;
__device__ __forceinline__ void handoff_signal(unsigned char* ws, int l, int wave_s) {
    asm volatile("s_waitcnt vmcnt(0)" ::: "memory");
    __syncthreads();
    if (is_thread0(wave_s)) {
        __builtin_amdgcn_fence(__ATOMIC_RELEASE, "agent");
        asm volatile("s_waitcnt vmcnt(0)" ::: "memory");
        __hip_atomic_fetch_add((unsigned*)(ws + OFF_GDONE) + l * 16, 1u, __ATOMIC_RELAXED, __HIP_MEMORY_SCOPE_AGENT);
    }
}
__device__ __forceinline__ void handoff_wait(unsigned char* ws, int l, int wave_s) {
    if (is_thread0(wave_s)) {
        unsigned* bar = (unsigned*)(ws + OFF_BAR);
        const unsigned G = (unsigned)__builtin_amdgcn_grid_size_x() / NT;
        XB_SPIN(xb_ld((unsigned*)(ws + OFF_GDONE) + l * 16) < G, bar);
        __builtin_amdgcn_fence(__ATOMIC_ACQUIRE, "agent");
        asm volatile("s_waitcnt vmcnt(0)" ::: "memory");
    }
    __syncthreads();
}

#define AS4 __attribute__((address_space(4)))
__device__ __forceinline__ Params load_params() {
    const AS4 unsigned char* k = (const AS4 unsigned char*)__builtin_amdgcn_kernarg_segment_ptr();
    asm volatile("" : "+s"(k));
    Params q;
#define LDP(field, T) q.field = *(T const AS4*)(k + __builtin_offsetof(Params, field))
    LDP(x, const float*); LDP(pos, const int*); LDP(norm_g, const float*); LDP(w_in, const float*); LDP(qn_g, const float*); LDP(w_uq, const float*);
    LDP(kvn_g, const float*); LDP(w_ukv, const float*); LDP(q_g, const float*); LDP(kn_g, const float*); LDP(kr_g, const float*); LDP(conv_w, const float*);
    LDP(ln_g, const float*); LDP(ln_b, const float*); LDP(sg_w, const float*); LDP(sg_b, const float*); LDP(mq_g, const float*); LDP(mk_g, const float*);
    LDP(w_out, const float*); LDP(out, float*); LDP(ws, unsigned char*);
#undef LDP
    return q;
}
template <int PH> __device__ __forceinline__ void run_phase(int wave_s, int l, float* lds) {
    const Params p = load_params();
    Ctx cx;
    { int w = wave_s; asm volatile("" : "+s"(w)); int ln; asm volatile("v_mbcnt_lo_u32_b32 %0, -1, 0\n\tv_mbcnt_hi_u32_b32 %0, -1, %0" : "=v"(ln)); cx.tid = w * 64 + ln; asm volatile("" : "+v"(cx.tid)); }
    { int b = __builtin_amdgcn_workgroup_id_x(); asm volatile("" : "+s"(b)); cx.bid = b; }
    { int nbk = (int)__builtin_amdgcn_grid_size_x() / NT; asm volatile("" : "+s"(nbk)); cx.nb = nbk; }
    unsigned char* ws = p.ws;
    if (PH == 0) phase_prep(cx, p, lds);
    constexpr int N_G1A = 12 * 256;
    if (PH == 1) {
        const bool split = (cx.nb == 256);
        pg8::Gemm g{(const bf16_t*)(ws + OFF_XB), (const bf16_t*)(ws + OFF_WINT) + (size_t)l * NP * DM, S, split ? N_G1A : NP, DM, DM};
        pg8::StaticOrder So; So.init(S, split ? N_G1A : NP, cx.nb, cx.bid);
        pg8::EpiInP E{(bf16_t*)(ws + OFF_P), (const float*)(ws + OFF_RSTD), NP, l == 0 ? nullptr : (const float*)(ws + OFF_SSQ)};
        pg8::gemm_phase<pg8::EpiInP, pg8::StaticOrder, pg8::AOffId, true, true>(cx, (PG8_LAS unsigned char*)lds, g, So, E, pg8::AOffId{});
    }
    if (PH == 2) { if (cx.bid == 0 && cx.tid < 256) ((int*)(ws + OFF_MCNT))[cx.tid] = 0;
        const bool split = (cx.nb == 256);
        if (split && cx.bid < 128) {
            pg8::Gemm g{(const bf16_t*)(ws + OFF_XB), (const bf16_t*)(ws + OFF_WINT) + (size_t)l * NP * DM + (size_t)N_G1A * DM, S, NP - N_G1A, DM, DM};
            pg8::StaticOrder So; So.init(S, NP - N_G1A, 128, cx.bid);
            pg8::EpiInP E{(bf16_t*)(ws + OFF_P) + N_G1A, (const float*)(ws + OFF_RSTD), NP, l == 0 ? nullptr : (const float*)(ws + OFF_SSQ)};
            pg8::gemm_phase<pg8::EpiInP, pg8::StaticOrder, pg8::AOffId, true, true>(cx, (PG8_LAS unsigned char*)lds, g, So, E, pg8::AOffId{});
        }
        post::mla_up(cx, p, l, (unsigned char*)lds); post::conv(cx, p, l);
        if (!split) post::sgate(cx, p, l, (unsigned char*)lds, cx.bid, cx.nb);
        else if (cx.bid >= 128) post::sgate(cx, p, l, (unsigned char*)lds, cx.bid - 128, 128);
        post::moba_prep(cx, p, l, (unsigned char*)lds); }
    if (PH == 3) {
        gate_fast(cx, p, l, (unsigned char*)lds);
        if (l == 0 && cx.nb == 256) {
            const int wave = __builtin_amdgcn_readfirstlane(cx.tid >> 6), lane = cx.tid & 63;
            __attribute__((address_space(3))) float* scr64 = (__attribute__((address_space(3))) float*)lds + wave * (64 * 65);
            __syncthreads();
            for (int r = wave * 256 + cx.bid; r < WI_L; r += 256 * (NT / 64)) weight_item(p, 1, r, lane, scr64);
        }
    }
    if (PH == 4) mla2::attn_mla_pipe(cx, p, l, (unsigned char*)lds);
    if (PH == 8) moba::gather_items(cx, p, l, (unsigned char*)lds);
    if (PH == 7) moba::own_items(cx, p, l, (unsigned char*)lds);
    if (PH == 5) {
        pg8::Gemm g{(const bf16_t*)(ws + OFF_P), (const bf16_t*)(ws + OFF_WOUTT) + (size_t)l * DM * DM, S, DM, DM, NP};
        pg8::StaticOrder So; So.init(S, DM, cx.nb, cx.bid);
        pg8::EpiOutP E{p.x, (const bf16_t*)(ws + OFF_XB), l == 0 ? nullptr : p.out, DM, l == 0 ? (bf16_t*)(ws + OFF_XB) : nullptr, l == 0 ? (float*)(ws + OFF_SSQ) : nullptr, cx.tid & 63};
        pg8::gemm_phase<pg8::EpiOutP, pg8::StaticOrder, pg8::AOffY, false, true>(cx, (PG8_LAS unsigned char*)lds, g, So, E, pg8::AOffY{});
    }
#ifdef PROBE_A
    if (PH == 20) post_mla(cx, p, l, lds);
    if (PH == 21) pflat(cx, p, (bf16_t*)(ws + OFF_QA), (bf16_t*)(ws + OFF_TQ), (size_t)4 * S * 256, 0, 0.f);
    if (PH == 22) pflat(cx, p, (bf16_t*)(ws + OFF_QA), (bf16_t*)(ws + OFF_TQ), (size_t)4 * S * 256, 2, 0.01f);
    if (PH == 29) ppoison(cx, p);
#endif
#ifdef PROBE_B
    if (PH == 30) { pcols(cx, p, C_MQ, 512, (bf16_t*)(ws + OFF_TQ), 0, 0.f); pcols(cx, p, C_GD, 256, (bf16_t*)(ws + OFF_TQ) + (size_t)S * 512, 0, 0.f); }
    if (PH == 31) { if (cx.bid == 0 && cx.tid < 256) ((int*)(ws + OFF_MCNT))[cx.tid] = 0; post_moba(cx, p, l, lds); }
    if (PH == 32) phase_gate(cx, p, l);
    if (PH == 33) attn_moba_naive(cx, p, l);
    if (PH == 34) { pcols(cx, p, C_GD, 256, (bf16_t*)(ws + OFF_TQ) + (size_t)S * 768, 0, 0.f); }
    if (PH == 35) { pcols(cx, p, C_MQ, 512, (bf16_t*)(ws + OFF_TQ), 1, 0.f); pcols(cx, p, C_GD, 256, (bf16_t*)(ws + OFF_TQ) + (size_t)S * 512, 1, 0.f); }
    if (PH == 36) pcols(cx, p, C_GD, 256, (bf16_t*)(ws + OFF_TQ) + (size_t)S * 768, 2, 1e-3f);
    if (PH == 29) ppoison(cx, p);
#endif
#ifdef PROBE_CHECK
    if (PH == 10) { if (cx.bid == 0 && cx.tid == 0) *(unsigned*)(ws + OFF_CNT) = 0u; probe_cols(cx, p, PROBE_COL, 0); }
    if (PH == 11) { PROBE_NAIVE; }
    if (PH == 12) probe_cols(cx, p, PROBE_COL, 1);
    if (PH == 13) probe_cols(cx, p, PROBE_COL, 2);
    if (PH == 14) probe_poison(cx, p);
#endif
    if (PH == 6) rows_prep(cx, p.out, (bf16_t*)(ws + OFF_XB), (float*)(ws + OFF_RSTD));
}

__global__ void __launch_bounds__(NT) mega_kernel(Params p) {
    extern __shared__ __attribute__((aligned(16))) unsigned char lds_raw[];
    float* lds = (float*)lds_raw;
    cg::grid_group grid = cg::this_grid();
    const int wave_s = __builtin_amdgcn_readfirstlane((int)(threadIdx.x >> 6));
    volatile __attribute__((address_space(3))) unsigned* bst = (volatile __attribute__((address_space(3))) unsigned*)((__attribute__((address_space(3))) unsigned char*)lds_raw + (LDS_BYTES - 64));
    if (is_thread0(wave_s)) { bst[0] = 0u; bst[1] = 0u; xb_add((unsigned*)(p.ws + OFF_BAR) + XB_XCNT(xb_xcc_id()), 1u); }
#ifdef TIMING_PROBE
    enum { STAMP_BASE = __COUNTER__ };
#define GSYNC_I(k) do { xcd_barrier(load_params().ws, bst, wave_s); if (__builtin_amdgcn_workgroup_id_x() == 0 && is_thread0(wave_s)) ((unsigned long long*)(load_params().ws + 4096))[(k) - STAMP_BASE] = __builtin_amdgcn_s_memrealtime(); } while (0)
#define GSYNC() GSYNC_I(__COUNTER__)
    if (__builtin_amdgcn_workgroup_id_x() == 0 && is_thread0(wave_s)) ((unsigned long long*)(p.ws + 4096))[0] = __builtin_amdgcn_s_memrealtime();
#else
#define GSYNC() xcd_barrier(load_params().ws, bst, wave_s)
#endif
    run_phase<0>(wave_s, 0, lds);
    if (__builtin_expect(load_params().ws == nullptr, 0)) grid.sync();
    GSYNC();
    run_phase<1>(wave_s, 0, lds); GSYNC();
#ifdef PROBE_A
    run_phase<20>(wave_s, 0, lds); GSYNC(); run_phase<21>(wave_s, 0, lds); GSYNC();
#endif
#ifdef PROBE_B
    run_phase<30>(wave_s, 0, lds); GSYNC(); run_phase<31>(wave_s, 0, lds); GSYNC(); run_phase<32>(wave_s, 0, lds); GSYNC();
    run_phase<33>(wave_s, 0, lds); GSYNC(); run_phase<34>(wave_s, 0, lds); GSYNC(); run_phase<35>(wave_s, 0, lds); GSYNC();
#endif
    run_phase<2>(wave_s, 0, lds); GSYNC();
#ifdef PROBE_A
    run_phase<22>(wave_s, 0, lds); GSYNC();
#endif
    run_phase<3>(wave_s, 0, lds); handoff_signal(load_params().ws, 0, wave_s);
#ifdef PROBE_CHECK
    run_phase<10>(wave_s, 0, lds); GSYNC();
    run_phase<11>(wave_s, 0, lds); GSYNC();
    run_phase<12>(wave_s, 0, lds); GSYNC();
#endif
    run_phase<4>(wave_s, 0, lds); handoff_wait(load_params().ws, 0, wave_s); run_phase<8>(wave_s, 0, lds); GSYNC();
    run_phase<7>(wave_s, 0, lds); GSYNC();
#ifdef PROBE_B
    run_phase<36>(wave_s, 0, lds); GSYNC();
#endif
#ifdef PROBE_CHECK
    run_phase<13>(wave_s, 0, lds); GSYNC();
#endif
    run_phase<5>(wave_s, 0, lds); GSYNC();
    run_phase<1>(wave_s, 1, lds); GSYNC();
    run_phase<2>(wave_s, 1, lds); GSYNC();
    run_phase<3>(wave_s, 1, lds); handoff_signal(load_params().ws, 1, wave_s);
    run_phase<4>(wave_s, 1, lds); handoff_wait(load_params().ws, 1, wave_s); run_phase<8>(wave_s, 1, lds); GSYNC();
    run_phase<7>(wave_s, 1, lds); GSYNC();
    run_phase<5>(wave_s, 1, lds);
#ifdef PROBE_CHECK
    GSYNC(); run_phase<14>(wave_s, 1, lds);
#endif
#if defined(PROBE_A) || defined(PROBE_B)
    GSYNC(); run_phase<29>(wave_s, 1, lds);
#endif
#ifdef TIMING_PROBE
    GSYNC();
    {
        const Params q = load_params(); const unsigned long long* st = (const unsigned long long*)(q.ws + 4096);
        if (__builtin_amdgcn_workgroup_id_x() == 0) {
            int ln; asm volatile("v_mbcnt_lo_u32_b32 %0, -1, 0\n\tv_mbcnt_hi_u32_b32 %0, -1, %0" : "=v"(ln));
            const int t = wave_s * 64 + ln;
            const float da = (float)(st[TIM_A] - st[TIM_A - 1]) * 0.0001f, db = (float)(st[TIM_B] - st[TIM_B - 1]) * 0.0001f;
            if (t == 0) q.out[0] += da;
            for (int i = t; i < TIM_NB; i += NT) q.out[1024 + i] += db;
        }
    }
#endif
}

extern "C" void kernel_launch(void* const* d_in, const int* in_sizes, int n_in, void* d_out, int out_size, void* d_ws, size_t ws_size, hipStream_t stream) {
    static int grid_blocks = 0;
    if (grid_blocks == 0) {
        int dev = 0, cus = 0, per_cu = 0;
        hipGetDevice(&dev);
        hipDeviceGetAttribute(&cus, hipDeviceAttributeMultiprocessorCount, dev);
        hipFuncSetAttribute((const void*)mega_kernel, hipFuncAttributeMaxDynamicSharedMemorySize, LDS_BYTES);
        hipOccupancyMaxActiveBlocksPerMultiprocessor(&per_cu, (const void*)mega_kernel, NT, LDS_BYTES);
        if (per_cu < 1) { fprintf(stderr, "occupancy query returned %d\n", per_cu); per_cu = 1; }
        if (per_cu > 1) per_cu = 1;
        grid_blocks = cus * per_cu;
        if (ws_size < OFF_END) { fprintf(stderr, "workspace too small: %zu < %zu\n", ws_size, (size_t)OFF_END); grid_blocks = -1; }
    }
    if (grid_blocks < 0) return;
    Params p{};
    p.x = (const float*)d_in[0]; p.pos = (const int*)d_in[1]; p.norm_g = (const float*)d_in[2]; p.w_in = (const float*)d_in[3];
    p.qn_g = (const float*)d_in[4]; p.w_uq = (const float*)d_in[5]; p.kvn_g = (const float*)d_in[6]; p.w_ukv = (const float*)d_in[7];
    p.q_g = (const float*)d_in[8]; p.kn_g = (const float*)d_in[9]; p.kr_g = (const float*)d_in[10]; p.conv_w = (const float*)d_in[11];
    p.ln_g = (const float*)d_in[12]; p.ln_b = (const float*)d_in[13]; p.sg_w = (const float*)d_in[14]; p.sg_b = (const float*)d_in[15];
    p.mq_g = (const float*)d_in[16]; p.mk_g = (const float*)d_in[17]; p.w_out = (const float*)d_in[18];
    p.out = (float*)d_out; p.ws = (unsigned char*)d_ws;
    if (hipMemsetAsync(d_ws, 0, 65536, stream) != hipSuccess) fprintf(stderr, "memset failed\n");
    void* args[] = {&p};
    hipError_t e = hipLaunchCooperativeKernel((const void*)mega_kernel, dim3(grid_blocks), dim3(NT), args, LDS_BYTES, stream);
    if (e != hipSuccess) fprintf(stderr, "cooperative launch failed: %s (grid %d)\n", hipGetErrorString(e), grid_blocks);
}
```

```cpp
#include <hip/hip_runtime.h>
#include <hip/hip_cooperative_groups.h>
#include <stdint.h>
#include <cstdio>
namespace cg = cooperative_groups;

constexpr int S = 16384, DM = 1024, NP = 3584, DEPTH = 2, DIN = 3488;
constexpr int NT = 512;
constexpr float EPS = 1e-6f;
constexpr float LOG2E = 1.4426950408889634f;
constexpr int C_CQ = 0, C_CKV = 256, C_KR = 384, C_GA = 512, C_CH = 768, C_CB = 1024, C_CC = 1280, C_GB = 1536,
              C_SU = 1792, C_SV = 2048, C_GC = 2304, C_MQ = 2560, C_MK = 2816, C_MV = 3072, C_GD = 3328;

typedef unsigned short bf16_t;
struct Ctx { int tid, bid, nb; };
__device__ __forceinline__ float bf2f(bf16_t v) { return __uint_as_float(((unsigned)v) << 16); }
__device__ __forceinline__ unsigned f2bf(float f) { unsigned u = __float_as_uint(f); return (u + 0x7fffu + ((u >> 16) & 1u)) >> 16; }
__device__ __forceinline__ unsigned pk2(float lo, float hi) { return f2bf(lo) | (f2bf(hi) << 16); }
__device__ __forceinline__ float lo16(unsigned u) { return __uint_as_float(u << 16); }
__device__ __forceinline__ float hi16(unsigned u) { return __uint_as_float(u & 0xffff0000u); }
__device__ __forceinline__ float shx(float v, int k, int lane) { return __builtin_bit_cast(float, __builtin_amdgcn_ds_bpermute((lane ^ k) << 2, __builtin_bit_cast(int, v))); }
__device__ __forceinline__ float wave_sum(float v, int lane) {
#pragma unroll
    for (int o = 1; o < 64; o <<= 1) v += shx(v, o, lane);
    return v;
}
__device__ __forceinline__ float silu(float g) { return g / (1.f + __expf(-g)); }

constexpr size_t al256(size_t x) { return (x + 255) & ~(size_t)255; }
constexpr size_t OFF_CTRL = 0;
constexpr size_t OFF_WINT = 65536;
constexpr size_t OFF_WOUTT = OFF_WINT + (size_t)DEPTH * NP * DM * 2;
constexpr size_t OFF_WUQT = OFF_WOUTT + (size_t)DEPTH * DM * DM * 2;
constexpr size_t OFF_WUKVT = OFF_WUQT + (size_t)DEPTH * 384 * 256 * 2;
constexpr size_t OFF_SGW = OFF_WUKVT + (size_t)DEPTH * 512 * 128 * 2;
constexpr size_t OFF_COSA = OFF_SGW + (size_t)DEPTH * 4 * 128 * 128 * 2;
constexpr size_t OFF_SINA = OFF_COSA + (size_t)S * 16 * 4;
constexpr size_t OFF_COSD = OFF_SINA + (size_t)S * 16 * 4;
constexpr size_t OFF_SIND = OFF_COSD + (size_t)S * 8 * 4;
constexpr size_t OFF_RSTD = OFF_SIND + (size_t)S * 8 * 4;
constexpr size_t OFF_KMEAN = OFF_RSTD + (size_t)S * 4;
constexpr size_t OFF_SEL = OFF_KMEAN + (size_t)4 * 64 * 64 * 4;
constexpr size_t OFF_XB = OFF_SEL + (size_t)4 * S * 4 * 4;
constexpr size_t OFF_P = OFF_XB + (size_t)S * DM * 2;
constexpr size_t OFF_QA = OFF_P + (size_t)S * NP * 2;
constexpr size_t OFF_KA = OFF_QA + (size_t)4 * S * 96 * 2;
constexpr size_t OFF_VA = OFF_KA + (size_t)4 * S * 96 * 2;
constexpr size_t OFF_LIST = OFF_VA + (size_t)4 * S * 64 * 2;
constexpr int LIST_PER_HEAD = 256 * 2016;
constexpr size_t OFF_LPART = OFF_LIST + (size_t)4 * LIST_PER_HEAD * 4;
constexpr size_t OFF_SSQ = OFF_LPART + (size_t)4 * S * 3 * 4;
constexpr size_t OFF_WUQF = OFF_SSQ + (size_t)S * 16 * 4;
constexpr size_t OFF_WUKVF = OFF_WUQF + (size_t)DEPTH * 384 * 256 * 2;
constexpr size_t OFF_PART = OFF_WUKVF + (size_t)DEPTH * 512 * 128 * 2;
constexpr size_t OFF_END = OFF_PART + (size_t)4 * S * 3 * 64 * 2;
constexpr size_t OFF_C2 = 512;
constexpr size_t OFF_GCTR = 768;
constexpr size_t OFF_MCNT = 2048;
static_assert(OFF_END <= 268435456, "workspace map exceeds 256 MiB");
static_assert((OFF_XB % 256) == 0 && (OFF_P % 256) == 0 && (OFF_QA % 256) == 0, "alignment");

constexpr int LDS_BYTES = 147456;

struct Params {
    const float* x; const int* pos; const float* norm_g; const float* w_in; const float* qn_g; const float* w_uq;
    const float* kvn_g; const float* w_ukv; const float* q_g; const float* kn_g; const float* kr_g; const float* conv_w;
    const float* ln_g; const float* ln_b; const float* sg_w; const float* sg_b; const float* mq_g; const float* mk_g;
    const float* w_out; float* out; unsigned char* ws;
};

namespace pg8 {
#define PG8_LAS __attribute__((address_space(3)))
typedef unsigned short bf16_t;
typedef short bf16x8 __attribute__((ext_vector_type(8)));
typedef float f32x4 __attribute__((ext_vector_type(4)));
typedef unsigned u32x4 __attribute__((ext_vector_type(4)));
constexpr int BM = 256, BK = 64, HALF = 128, HTB = HALF * BK * 2  , STAGE_BYTES = 8 * HTB, NXCD = 8, WGM = 8;

__host__ __device__ __forceinline__ int lds_byte(int r, int c) { const int st = (r >> 4) * 2 + (c >> 5), rr = r & 15, cc = c & 31, ob = rr * 64 + cc * 2; return st * 1024 + (ob ^ (((ob >> 9) & 1) << 5)); }
__host__ __device__ __forceinline__ void stage_rc(int b, int& R, int& C) { const int st = b / 1024, sb = b % 1024, swz = sb ^ (((sb >> 9) & 1) << 5); R = (st >> 1) * 16 + swz / 64; C = (st & 1) * 32 + (swz % 64) / 2; }
__host__ __device__ __forceinline__ int perm32(int rho) { const int n = rho >> 4, i = rho & 15; return 8 * (i >> 2) + 4 * n + (i & 3); }

struct Unit { int pm, pn; };
struct Gemm { const bf16_t* A; const bf16_t* Bt; int M, N, K, lda; };

struct StaticOrder {
    int nM, nN, nwg, G, c;
    __host__ __device__ void init(int M, int N, int G_, int c_) { nM = M / BM; nN = N / BM; nwg = nM * nN; G = G_; c = c_; }
    __host__ __device__ bool next(int i, Unit& u) const {
        const long L = (long)i * G + c; if (L >= nwg) return false;
        int wgid = (int)L; { const int q = nwg / NXCD, r = nwg % NXCD, xcd = wgid % NXCD, off = wgid / NXCD; wgid = (xcd < r ? xcd * (q + 1) : r * (q + 1) + (xcd - r) * q) + off; }
        const int nig = WGM * nN, gid = wgid / nig, fm = gid * WGM, gsz = (nM - fm) < WGM ? (nM - fm) : WGM;
        u.pm = fm + ((wgid % nig) % gsz); u.pn = (wgid % nig) / gsz; return true;
    }
    __device__ __forceinline__ void a_ready(const Unit&) const {}
    __device__ __forceinline__ void done(const Unit&) const {}
};


template <class Epi, class Sched, class AOff>
__device__ __forceinline__ void gemm_prefetch(const Ctx& cx, PG8_LAS unsigned char* lds, const Gemm g, const Sched& S, const AOff& AO) {
    const int tid = cx.tid, wid = __builtin_amdgcn_readfirstlane(tid >> 6);
    const int K = g.K;
    Unit cur; if (!S.next(0, cur)) return;
    unsigned voffA[2], voffB[2];
#pragma unroll
    for (int i = 0; i < 2; ++i) { int R, C; stage_rc(tid * 16 + i * 8192, R, C); const int Rb = Epi::PERM ? ((R & ~31) + perm32(R & 31)) : R;
        voffA[i] = (unsigned)(R * g.lda + C) * 2u; voffB[i] = (unsigned)(Rb * K + C) * 2u; }
    const size_t kstep = (size_t)(BK * 2), hstepB = (size_t)HALF * K * 2, hstepA = (size_t)HALF * g.lda * 2, tstepB = 2 * hstepB, tstepA = 2 * hstepA;
    const unsigned ldsw = (unsigned)wid * 1024u;
    const char* cA = (const char*)g.A + (size_t)cur.pm * tstepA; const char* cB = (const char*)g.Bt + (size_t)cur.pn * tstepB;
#define PGP_SA(b, h) (((b) * 2 + (h)) * HTB)
#define PGP_SB(b, h) ((4 + (b) * 2 + (h)) * HTB)
#define PGP_STAGE(bufoff, gbase, voff) do { _Pragma("unroll") for (int _i = 0; _i < 2; ++_i) \
        __builtin_amdgcn_global_load_lds((const unsigned*)((const char*)(gbase) + (voff)[_i]), (PG8_LAS unsigned*)(lds + (bufoff) + ldsw + _i * 8192), 16, 0, 0); } while (0)
    PGP_STAGE(PGP_SB(0, 0), cB, voffB); PGP_STAGE(PGP_SB(0, 1), cB + hstepB, voffB); PGP_STAGE(PGP_SA(0, 0), cA + AO(0), voffA); PGP_STAGE(PGP_SA(0, 1), cA + AO(0) + hstepA, voffA);
    PGP_STAGE(PGP_SB(1, 0), cB + kstep, voffB); PGP_STAGE(PGP_SA(1, 0), cA + AO(1), voffA); PGP_STAGE(PGP_SB(1, 1), cB + hstepB + kstep, voffB);
#undef PGP_SA
#undef PGP_SB
#undef PGP_STAGE
}
template <class Epi, class Sched, class AOff, bool ALIGN_EPI = false, bool SP2 = false, bool PRELOADED = false>
__device__ __forceinline__ void gemm_phase(const Ctx& cx, PG8_LAS unsigned char* lds, const Gemm g, const Sched& S, const Epi& E, const AOff& AO) {
    const int tid = cx.tid, wid = __builtin_amdgcn_readfirstlane(tid >> 6), lane = tid & 63, wr = wid >> 2, wc = wid & 3, fr = lane & 15, fq = lane >> 4;
    const int K = g.K, nt = K / BK;
    unsigned voffA[2], voffB[2];
#pragma unroll
    for (int i = 0; i < 2; ++i) { int R, C; stage_rc(tid * 16 + i * 8192, R, C); const int Rb = Epi::PERM ? ((R & ~31) + perm32(R & 31)) : R;
        voffA[i] = (unsigned)(R * g.lda + C) * 2u; voffB[i] = (unsigned)(Rb * K + C) * 2u; }
    const size_t kstep = (size_t)(BK * 2);
    const size_t hstepB = (size_t)HALF * K * 2, hstepA = (size_t)HALF * g.lda * 2;
    const size_t tstepB = 2 * hstepB, tstepA = 2 * hstepA;
    const unsigned ldsw = (unsigned)wid * 1024u;
    const int aoff = lds_byte(wr * 64 + fr, fq * 8), boff = lds_byte(wc * 32 + fr, fq * 8);
#define PG8_SA(b, h) (((b) * 2 + (h)) * HTB)
#define PG8_SB(b, h) ((4 + (b) * 2 + (h)) * HTB)
#define PG8_STAGE(bufoff, gbase, voff) do { _Pragma("unroll") for (int _i = 0; _i < 2; ++_i) \
        __builtin_amdgcn_global_load_lds((const unsigned*)((const char*)(gbase) + (voff)[_i]), (PG8_LAS unsigned*)(lds + (bufoff) + ldsw + _i * 8192), 16, 0, 0); } while (0)
#define PG8_LDA(dst, b, h) do { _Pragma("unroll") for (int m = 0; m < 4; ++m) _Pragma("unroll") for (int k = 0; k < 2; ++k) dst[m][k] = *(const PG8_LAS bf16x8*)(lds + PG8_SA(b, h) + aoff + m * 2048 + k * 1024); } while (0)
#define PG8_LDB(dst, b, h) do { _Pragma("unroll") for (int n = 0; n < 2; ++n) _Pragma("unroll") for (int k = 0; k < 2; ++k) dst[n][k] = *(const PG8_LAS bf16x8*)(lds + PG8_SB(b, h) + boff + n * 2048 + k * 1024); } while (0)
#define PG8_MMA(ai, bj, At, Bt) do { __builtin_amdgcn_s_setprio(1); _Pragma("unroll") for (int m = 0; m < 4; ++m) _Pragma("unroll") for (int n = 0; n < 2; ++n) _Pragma("unroll") for (int k = 0; k < 2; ++k) \
        acc[ai][bj][m][n] = __builtin_amdgcn_mfma_f32_16x16x32_bf16(Bt[n][k], At[m][k], acc[ai][bj][m][n], 0, 0, 0); __builtin_amdgcn_s_setprio(0); } while (0)
#define PG8_WAIT_V(n) asm volatile("s_waitcnt vmcnt(" #n ")" ::: "memory")
#define PG8_WAIT_L(n) asm volatile("s_waitcnt lgkmcnt(" #n ")" ::: "memory")
#define PG8_BAR __builtin_amdgcn_s_barrier()
#define PG8_SCHED __builtin_amdgcn_sched_barrier(0)
    Unit cur, nxt; int ui = 0;
    if (!S.next(0, cur)) return;
    PG8_LAS float* epi_rows = Epi::setup(E, S, cur, (PG8_LAS float*)(lds + STAGE_BYTES), tid) ? (PG8_LAS float*)(lds + STAGE_BYTES) : (PG8_LAS float*)nullptr;
    f32x4 acc[2][2][4][2];
#pragma unroll
    for (int a = 0; a < 2; ++a)
#pragma unroll
        for (int b = 0; b < 2; ++b)
#pragma unroll
            for (int m = 0; m < 4; ++m)
#pragma unroll
                for (int n = 0; n < 2; ++n) acc[a][b][m][n] = (f32x4){0.f, 0.f, 0.f, 0.f};
    bf16x8 At[4][2], B0[2][2], B1[2][2];
    const char* cA = (const char*)g.A + (size_t)cur.pm * tstepA; const char* cB = (const char*)g.Bt + (size_t)cur.pn * tstepB;
    S.a_ready(cur);
    if constexpr (SP2) {
        if constexpr (!PRELOADED) { PG8_STAGE(PG8_SB(0, 0), cB, voffB); PG8_STAGE(PG8_SB(0, 1), cB + hstepB, voffB); PG8_STAGE(PG8_SA(0, 0), cA + AO(0), voffA); PG8_STAGE(PG8_SA(0, 1), cA + AO(0) + hstepA, voffA); }
        if (wr == 1) PG8_BAR;
        PG8_WAIT_V(2); PG8_BAR;
        if constexpr (!PRELOADED) { PG8_STAGE(PG8_SB(1, 0), cB + kstep, voffB); PG8_STAGE(PG8_SA(1, 0), cA + AO(1), voffA); PG8_STAGE(PG8_SB(1, 1), cB + hstepB + kstep, voffB); }
        PG8_WAIT_V(6); PG8_BAR;
    } else {
        PG8_STAGE(PG8_SB(0, 0), cB, voffB); PG8_STAGE(PG8_SA(0, 0), cA + AO(0), voffA); PG8_STAGE(PG8_SB(0, 1), cB + hstepB, voffB); PG8_STAGE(PG8_SA(0, 1), cA + AO(0) + hstepA, voffA);
        if (wr == 1) PG8_BAR;
        PG8_WAIT_V(4); PG8_BAR;
        PG8_STAGE(PG8_SB(1, 0), cB + kstep, voffB); PG8_STAGE(PG8_SA(1, 0), cA + AO(1), voffA); PG8_STAGE(PG8_SB(1, 1), cB + hstepB + kstep, voffB);
        PG8_WAIT_V(6); PG8_BAR;
    }
    for (;;) {
        const bool has_next = S.next(ui + 1, nxt);
        const char* nA = has_next ? (const char*)g.A + (size_t)nxt.pm * tstepA : cA; const char* nB = has_next ? (const char*)g.Bt + (size_t)nxt.pn * tstepB : cB;
        for (int t = 0; t < nt; t += 2) {
            const bool last = (t == nt - 2);
            const char* a1 = cA + AO(t + 1);
            const char* a2 = last ? nA + AO(0) : cA + AO(t + 2); const char* b2 = last ? nB : cB + (size_t)(t + 2) * kstep;
            const char* a3 = last ? nA + AO(1) : cA + AO(t + 3); const char* b3 = b2 + kstep;
            if (last && has_next) S.a_ready(nxt);
            if constexpr (SP2) {
            PG8_LDB(B0, 0, 0); PG8_LDB(B1, 0, 1); PG8_SCHED; PG8_LDA(At, 0, 0); PG8_STAGE(PG8_SA(1, 1), a1 + hstepA, voffA);
            PG8_WAIT_V(8); PG8_WAIT_L(0); PG8_BAR; PG8_MMA(0, 0, At, B0); PG8_MMA(0, 1, At, B1); PG8_BAR; PG8_SCHED;
            PG8_LDA(At, 0, 1); PG8_STAGE(PG8_SB(0, 0), b2, voffB); PG8_STAGE(PG8_SB(0, 1), b2 + hstepB, voffB); PG8_STAGE(PG8_SA(0, 0), a2, voffA);
            PG8_WAIT_V(8); PG8_WAIT_L(0); PG8_BAR; PG8_MMA(1, 0, At, B0); PG8_MMA(1, 1, At, B1); PG8_BAR; PG8_SCHED;
            PG8_LDB(B0, 1, 0); PG8_LDB(B1, 1, 1); PG8_SCHED; PG8_LDA(At, 1, 0); PG8_STAGE(PG8_SA(0, 1), a2 + hstepA, voffA);
            PG8_WAIT_V(8); PG8_WAIT_L(0); PG8_BAR; PG8_MMA(0, 0, At, B0); PG8_MMA(0, 1, At, B1); PG8_BAR; PG8_SCHED;
            PG8_LDA(At, 1, 1); PG8_STAGE(PG8_SB(1, 0), b3, voffB); PG8_STAGE(PG8_SB(1, 1), b3 + hstepB, voffB); PG8_STAGE(PG8_SA(1, 0), a3, voffA);
            PG8_WAIT_V(8); PG8_WAIT_L(0); PG8_BAR; PG8_MMA(1, 0, At, B0); PG8_MMA(1, 1, At, B1); PG8_BAR; PG8_SCHED;
            } else {
            PG8_LDB(B0, 0, 0); PG8_SCHED; PG8_LDA(At, 0, 0); PG8_STAGE(PG8_SA(1, 1), a1 + hstepA, voffA);
            PG8_WAIT_L(8); PG8_BAR; PG8_WAIT_L(0); PG8_MMA(0, 0, At, B0); PG8_BAR; PG8_SCHED;
            PG8_LDB(B1, 0, 1); PG8_STAGE(PG8_SB(0, 0), b2, voffB);
            PG8_BAR; PG8_WAIT_L(0); PG8_MMA(0, 1, At, B1); PG8_BAR;
            PG8_LDA(At, 0, 1); PG8_STAGE(PG8_SA(0, 0), a2, voffA);
            PG8_BAR; PG8_WAIT_L(0); PG8_MMA(1, 0, At, B0); PG8_BAR; PG8_SCHED;
            PG8_STAGE(PG8_SB(0, 1), b2 + hstepB, voffB);
            PG8_WAIT_V(6); PG8_BAR; PG8_MMA(1, 1, At, B1); PG8_BAR;
            PG8_LDB(B0, 1, 0); PG8_SCHED; PG8_LDA(At, 1, 0); PG8_STAGE(PG8_SA(0, 1), a2 + hstepA, voffA);
            PG8_WAIT_L(8); PG8_BAR; PG8_WAIT_L(0); PG8_MMA(0, 0, At, B0); PG8_BAR; PG8_SCHED;
            PG8_LDB(B1, 1, 1); PG8_STAGE(PG8_SB(1, 0), b3, voffB);
            PG8_BAR; PG8_WAIT_L(0); PG8_MMA(0, 1, At, B1); PG8_BAR;
            PG8_LDA(At, 1, 1); PG8_STAGE(PG8_SA(1, 0), a3, voffA);
            PG8_BAR; PG8_WAIT_L(0); PG8_MMA(1, 0, At, B0); PG8_BAR; PG8_SCHED;
            PG8_STAGE(PG8_SB(1, 1), b3 + hstepB, voffB);
            PG8_WAIT_V(6); PG8_BAR; PG8_MMA(1, 1, At, B1); PG8_BAR;
            }
        }
        if constexpr (ALIGN_EPI) { if (wr == 0) PG8_BAR; }
        if constexpr (!Epi::AFTER_DRAIN) { E(acc, cur, wr, wc, fr, fq, epi_rows); S.done(cur); }
        if (!has_next) break;
#pragma unroll
        for (int a = 0; a < 2; ++a)
#pragma unroll
            for (int b = 0; b < 2; ++b)
#pragma unroll
                for (int m = 0; m < 4; ++m)
#pragma unroll
                    for (int n = 0; n < 2; ++n) acc[a][b][m][n] = (f32x4){0.f, 0.f, 0.f, 0.f};
        cur = nxt; cA = nA; cB = nB; ++ui;
        if constexpr (ALIGN_EPI) { if (wr == 1) PG8_BAR; }
    }
    PG8_WAIT_V(0);
    if constexpr (!ALIGN_EPI) { if (wr == 0) PG8_BAR; }
    PG8_BAR;
    if constexpr (Epi::AFTER_DRAIN) { E.fused(acc, cur, wr, wc, fr, fq, lds, wid, lane); S.done(cur); }
#undef PG8_SA
#undef PG8_SB
#undef PG8_STAGE
#undef PG8_LDA
#undef PG8_LDB
#undef PG8_MMA
#undef PG8_WAIT_V
#undef PG8_WAIT_L
#undef PG8_BAR
#undef PG8_SCHED
}

__device__ __forceinline__ unsigned cvt_pk_bf16(float lo, float hi) { unsigned r; asm volatile("v_cvt_pk_bf16_f32 %0, %1, %2" : "=v"(r) : "v"(lo), "v"(hi)); return r; }
struct AOffId { __device__ __forceinline__ size_t operator()(int t) const { return (size_t)t * (BK * 2); } };
struct AOffY {
    __device__ __forceinline__ size_t operator()(int t) const { const int g = t >> 2; const int base = g == 0 ? 512 : g == 1 ? 1536 : g == 2 ? 2304 : 3328; return (size_t)(base + (t & 3) * 64) * 2; }
};
struct EpiInP {
    static constexpr bool PERM = true, AFTER_DRAIN = false;
    bf16_t* P; const float* rstd; int ldp; const float* ssq;
    template <class Sched>
    static __device__ __forceinline__ bool setup(const EpiInP& E, const Sched& S, const Unit& first, PG8_LAS float* rows, int tid) {
        bool same = true; Unit u_;
        for (int i = 1; S.next(i, u_); ++i) same = same && (u_.pm == first.pm);
        if (!same) return false;
        if (tid < BM) { const int row = first.pm * BM + tid; float r;
            if (E.ssq) { const f32x4* sp = (const f32x4*)(E.ssq + (size_t)row * 16); const f32x4 a = sp[0], b = sp[1], c = sp[2], d = sp[3];
                const float q0 = (a[0] + a[1]) + (a[2] + a[3]), q1 = (b[0] + b[1]) + (b[2] + b[3]), q2 = (c[0] + c[1]) + (c[2] + c[3]), q3 = (d[0] + d[1]) + (d[2] + d[3]);
                r = 1.0f / sqrtf(((q0 + q1) + (q2 + q3)) * (1.0f / 1024.0f) + 1e-6f); }
            else r = E.rstd[row];
            rows[tid] = r; }
        return true;
    }
    __device__ __forceinline__ void operator()(const f32x4 (&acc)[2][2][4][2], const Unit& u, int wr, int wc, int fr, int fq, PG8_LAS float* rows) const {
        const int row0 = u.pm * BM + wr * 64 + fr, col0 = u.pn * BM + wc * 32 + 8 * fq;
        float r[8];
        if (rows) {
#pragma unroll
            for (int i = 0; i < 8; ++i) r[i] = rows[wr * 64 + fr + (i >> 2) * HALF + (i & 3) * 16]; }
        else if (ssq) { f32x4 t[8];
#pragma unroll
            for (int i = 0; i < 8; ++i) t[i] = *(const f32x4*)(ssq + (size_t)(row0 + (i >> 2) * HALF + (i & 3) * 16) * 16 + 4 * fq);
#pragma unroll
            for (int i = 0; i < 8; ++i) { float sm = (t[i][0] + t[i][1]) + (t[i][2] + t[i][3]); const int lane = fq * 16 + fr; sm += shx(sm, 16, lane); sm += shx(sm, 32, lane);
                r[i] = 1.0f / sqrtf(sm * (1.0f / 1024.0f) + 1e-6f); } }
        else {
#pragma unroll
            for (int i = 0; i < 8; ++i) r[i] = rstd[row0 + (i >> 2) * HALF + (i & 3) * 16]; }
#pragma unroll
        for (int ai = 0; ai < 2; ++ai)
#pragma unroll
            for (int m = 0; m < 4; ++m) { const int row = row0 + ai * HALF + m * 16; const float rr = r[ai * 4 + m];
                bf16_t* rowp = P + (size_t)row * ldp + col0;
#pragma unroll
                for (int bj = 0; bj < 2; ++bj) { const f32x4 v0 = acc[ai][bj][m][0] * rr, v1 = acc[ai][bj][m][1] * rr;
                    u32x4 w; w.x = cvt_pk_bf16(v0[0], v0[1]); w.y = cvt_pk_bf16(v0[2], v0[3]); w.z = cvt_pk_bf16(v1[0], v1[1]); w.w = cvt_pk_bf16(v1[2], v1[3]);
                    *(u32x4*)(rowp + bj * HALF) = w; } }
    }
};
struct EpiOutP {
    static constexpr bool PERM = false, AFTER_DRAIN = false;
    const float* xin; const bf16_t* xinb; float* out; int ldc; bf16_t* xb; float* ssq; int lane;
    static __device__ __forceinline__ void pswap(unsigned& a, unsigned& b) { typedef unsigned u32x2_t __attribute__((ext_vector_type(2))); const u32x2_t r = __builtin_amdgcn_permlane16_swap(a, b, false, false); a = r.x; b = r.y; }
    template <class Sched> static __device__ __forceinline__ bool setup(const EpiOutP&, const Sched&, const Unit&, PG8_LAS float*, int) { return false; }
    __device__ __forceinline__ void operator()(const f32x4 (&acc)[2][2][4][2], const Unit& u, int wr, int wc, int fr, int fq, PG8_LAS float*) const {
        const int col0 = u.pn * BM + wc * 32 + 4 * fq, colw = u.pn * BM + wc * 32 + ((fq & 1) << 4) + ((fq >> 1) << 3);
        u32x4 xr[8][2];
#define EO_LOAD(g) do { const size_t row_ = (size_t)(u.pm * BM + ((g) >> 2) * HALF + wr * 64 + ((g) & 3) * 16 + fr) * ldc; \
            _Pragma("unroll") for (int bj = 0; bj < 2; ++bj) xr[g][bj] = *(const u32x4*)(xinb + row_ + colw + bj * HALF); } while (0)
        EO_LOAD(0); EO_LOAD(1); EO_LOAD(2);
#pragma unroll
        for (int g = 0; g < 8; ++g) {
            if (g + 3 < 8) EO_LOAD(g + 3);
            const int ai = g >> 2, m = g & 3;
            const int row = u.pm * BM + ai * HALF + wr * 64 + m * 16 + fr; const size_t rowo = (size_t)row * ldc; float sq = 0.f;
#pragma unroll
            for (int bj = 0; bj < 2; ++bj) {
                unsigned a0 = xr[g][bj].x, a1 = xr[g][bj].y, b0 = xr[g][bj].z, b1 = xr[g][bj].w;
                pswap(a0, b0); pswap(a1, b1);
                const f32x4 r0 = (f32x4){__uint_as_float(a0 << 16), __uint_as_float(a0 & 0xffff0000u), __uint_as_float(a1 << 16), __uint_as_float(a1 & 0xffff0000u)};
                const f32x4 r1 = (f32x4){__uint_as_float(b0 << 16), __uint_as_float(b0 & 0xffff0000u), __uint_as_float(b1 << 16), __uint_as_float(b1 & 0xffff0000u)};
                const f32x4 y0 = r0 + acc[ai][bj][m][0], y1 = r1 + acc[ai][bj][m][1];
                if (out) { __builtin_nontemporal_store(y0, (f32x4*)(out + rowo + col0 + bj * HALF));
                           __builtin_nontemporal_store(y1, (f32x4*)(out + rowo + col0 + bj * HALF + 16)); }
                if (xb) { sq += ((y0[0] * y0[0] + y0[1] * y0[1]) + (y0[2] * y0[2] + y0[3] * y0[3])) + ((y1[0] * y1[0] + y1[1] * y1[1]) + (y1[2] * y1[2] + y1[3] * y1[3]));
                    unsigned c0 = cvt_pk_bf16(y0[0], y0[1]), c1 = cvt_pk_bf16(y0[2], y0[3]), d0 = cvt_pk_bf16(y1[0], y1[1]), d1 = cvt_pk_bf16(y1[2], y1[3]);
                    pswap(c0, d0); pswap(c1, d1);
                    u32x4 w; w.x = c0; w.y = c1; w.z = d0; w.w = d1; *(u32x4*)(xb + rowo + colw + bj * HALF) = w; } }
            if (xb) { sq += shx(sq, 16, lane); sq += shx(sq, 32, lane); if (fq == 0) ssq[(size_t)row * 16 + u.pn * 4 + wc] = sq; }
        }
#undef EO_LOAD
    }
};
}

__device__ __forceinline__ void transpose_tiles(const Ctx& cx, const float* __restrict__ src, int K, int Nsrc, const float* __restrict__ gk,
                                bf16_t* __restrict__ dst, int Ndst, int gap_at, int gap_len, float* lds) {
    float (*t)[33] = (float (*)[33])lds;
    const int tid = cx.tid, a = tid >> 5, b = tid & 31;
    const int tilesN = Ndst / 32, tilesK = K / 32;
    for (int tile = cx.bid; tile < tilesN * tilesK; tile += cx.nb) {
        const int tn = tile % tilesN, tk = tile / tilesN, n0 = tn * 32, k0 = tk * 32;
        __syncthreads();
#pragma unroll
        for (int i = 0; i < 2; ++i) {
            const int kk = a + 16 * i, np = n0 + b;
            const bool z = (np >= gap_at && np < gap_at + gap_len);
            const int n = np < gap_at ? np : np - gap_len;
            float v = z ? 0.f : src[(size_t)(k0 + kk) * Nsrc + n];
            if (gk) v *= gk[k0 + kk];
            t[kk][b] = v;
        }
        __syncthreads();
#pragma unroll
        for (int i = 0; i < 2; ++i) {
            const int nn = a + 16 * i;
            dst[(size_t)(n0 + nn) * K + k0 + b] = (bf16_t)f2bf(t[b][nn]);
        }
    }
}


__device__ __forceinline__ void transpose_item(const float* __restrict__ W, int K, int Nsrc, const float* __restrict__ gk, bf16_t* __restrict__ WT,
                                               int gap_at, int gap_len, int ntn, int item, int lane, __attribute__((address_space(3))) float* scr,
                                               bf16_t* __restrict__ WF = nullptr, int fr_nth = 0) {
    const int kb = item / ntn, nb_ = item % ntn, k0 = 64 * kb, n0d = 32 * nb_;
    const bool pad = (n0d >= gap_at && n0d < gap_at + gap_len);
    const int n0s = n0d < gap_at ? n0d : n0d - gap_len;
    if (!pad) {
#pragma unroll 16
        for (int i = 0; i < 32; ++i) { const int kk = 2 * i + (lane >> 5); float v = W[(size_t)(k0 + kk) * Nsrc + n0s + (lane & 31)]; if (gk) v *= gk[k0 + kk]; scr[kk * 33 + (lane & 31)] = v; }
    }
    asm volatile("s_waitcnt lgkmcnt(0)" ::: "memory");
    const int c = lane & 7;
#pragma unroll
    for (int j = 0; j < 4; ++j) {
        const int n = (lane >> 3) + 8 * j; const __attribute__((address_space(3))) float* sp = scr + (8 * c) * 33 + n;
        uint4 o = make_uint4(0u, 0u, 0u, 0u);
        if (!pad) { o.x = pk2(sp[0 * 33], sp[1 * 33]); o.y = pk2(sp[2 * 33], sp[3 * 33]); o.z = pk2(sp[4 * 33], sp[5 * 33]); o.w = pk2(sp[6 * 33], sp[7 * 33]); }
        *(uint4*)(WT + (size_t)(n0d + n) * K + k0 + 8 * c) = o;
        if (WF) {
            const int nn = n0d + n, hn = fr_nth * 32, hh = nn / hn, nt = (nn % hn) >> 5, rr = nn & 31, kq = k0 + 8 * c, ks = kq >> 4, hi = (kq >> 3) & 1;
            *(uint4*)(WF + ((((size_t)(hh * fr_nth + nt) * (K / 16) + ks) * 2 + hi) * 32 + rr) * 8) = o;
        }
    }
    asm volatile("s_waitcnt lgkmcnt(0)" ::: "memory");
}

__device__ __forceinline__ void rows_prep(const Ctx& cx, const float* __restrict__ xsrc, bf16_t* __restrict__ Xb, float* __restrict__ rstd) {
    const int wave = cx.tid >> 6, lane = cx.tid & 63;
    const int gw = cx.bid * (NT / 64) + wave, NGW = cx.nb * (NT / 64);
    for (int m = gw; m < S / 2; m += NGW) {
        const float4* xr0 = (const float4*)(xsrc + (size_t)m * DM) + lane; const float4* xr1 = (const float4*)(xsrc + (size_t)(m + S / 2) * DM) + lane;
        float4 v0[4], v1[4]; float s0 = 0.f, s1 = 0.f;
#pragma unroll
        for (int j = 0; j < 4; ++j) { v0[j] = xr0[64 * j]; v1[j] = xr1[64 * j]; }
#pragma unroll
        for (int j = 0; j < 4; ++j) { s0 += (v0[j].x * v0[j].x + v0[j].y * v0[j].y) + (v0[j].z * v0[j].z + v0[j].w * v0[j].w); s1 += (v1[j].x * v1[j].x + v1[j].y * v1[j].y) + (v1[j].z * v1[j].z + v1[j].w * v1[j].w); }
        s0 = wave_sum(s0, lane); s1 = wave_sum(s1, lane);
        if (lane == 0) { rstd[m] = 1.0f / sqrtf(s0 * (1.0f / DM) + EPS); rstd[m + S / 2] = 1.0f / sqrtf(s1 * (1.0f / DM) + EPS); }
        uint2* o0 = (uint2*)(Xb + (size_t)m * DM) + lane; uint2* o1 = (uint2*)(Xb + (size_t)(m + S / 2) * DM) + lane;
#pragma unroll
        for (int j = 0; j < 4; ++j) { o0[64 * j] = make_uint2(pk2(v0[j].x, v0[j].y), pk2(v0[j].z, v0[j].w)); o1[64 * j] = make_uint2(pk2(v1[j].x, v1[j].y), pk2(v1[j].z, v1[j].w)); }
    }
}


__device__ __forceinline__ void transpose_item64(const float* __restrict__ W, int K, int Nsrc, const float* __restrict__ gk, bf16_t* __restrict__ WT,
                                                 int gap_at, int gap_len, int ntn64, int item, int lane, __attribute__((address_space(3))) float* scr,
                                                 bf16_t* __restrict__ WF = nullptr, int fr_nth = 0) {
    const int kb = item / ntn64, nb_ = item % ntn64, k0 = 64 * kb, n0d = 64 * nb_;
    const int kk4 = lane >> 4, nq = (lane & 15) * 4, nd = n0d + nq;
    const bool padg = (nd >= gap_at && nd < gap_at + gap_len);
    const int ns = nd < gap_at ? nd : nd - gap_len;
    float4 v[16];
#pragma unroll
    for (int i = 0; i < 16; ++i) { typedef float f4nt_t __attribute__((ext_vector_type(4))); if (padg) v[i] = make_float4(0.f, 0.f, 0.f, 0.f); else { const f4nt_t t_ = __builtin_nontemporal_load((const f4nt_t*)(W + (size_t)(k0 + 4 * i + kk4) * Nsrc + ns)); v[i] = make_float4(t_.x, t_.y, t_.z, t_.w); } }
#pragma unroll
    for (int i = 0; i < 16; ++i) { const int kk = 4 * i + kk4; const float g = gk ? gk[k0 + kk] : 1.0f; __attribute__((address_space(3))) float* d = scr + kk * 65 + nq; d[0] = v[i].x * g; d[1] = v[i].y * g; d[2] = v[i].z * g; d[3] = v[i].w * g; }
    asm volatile("s_waitcnt lgkmcnt(0)" ::: "memory");
    const int c = lane & 7;
#pragma unroll
    for (int j = 0; j < 8; ++j) {
        const int n = (lane >> 3) + 8 * j; const __attribute__((address_space(3))) float* sp = scr + (8 * c) * 65 + n;
        uint4 o; o.x = pk2(sp[0 * 65], sp[1 * 65]); o.y = pk2(sp[2 * 65], sp[3 * 65]); o.z = pk2(sp[4 * 65], sp[5 * 65]); o.w = pk2(sp[6 * 65], sp[7 * 65]);
        *(uint4*)(WT + (size_t)(n0d + n) * K + k0 + 8 * c) = o;
        if (WF) { const int nn = n0d + n, hn = fr_nth * 32, hh = nn / hn, nt = (nn % hn) >> 5, rr = nn & 31, kq = k0 + 8 * c, ks = kq >> 4, hi = (kq >> 3) & 1;
            *(uint4*)(WF + ((((size_t)(hh * fr_nth + nt) * (K / 16) + ks) * 2 + hi) * 32 + rr) * 8) = o; }
    }
    asm volatile("s_waitcnt lgkmcnt(0)" ::: "memory");
}


constexpr int WI_IN = (DM / 64) * (NP / 64), WI_OUT = (DM / 64) * (DM / 64), WI_UQ = (256 / 64) * (384 / 64), WI_UKV = (128 / 64) * (512 / 64), WI_L = WI_IN + WI_OUT + WI_UQ + WI_UKV;
__device__ __forceinline__ void weight_item(const Params& p, int l, int r, int lane, __attribute__((address_space(3))) float* scr64) {
    unsigned char* ws = p.ws;
    if (r < WI_IN) { transpose_item64(p.w_in + (size_t)l * DM * DIN, DM, DIN, p.norm_g + l * DM, (bf16_t*)(ws + OFF_WINT) + (size_t)l * NP * DM, 416, 96, NP / 64, r, lane, scr64); return; } r -= WI_IN;
    if (r < WI_OUT) { transpose_item64(p.w_out + (size_t)l * DM * DM, DM, DM, nullptr, (bf16_t*)(ws + OFF_WOUTT) + (size_t)l * DM * DM, DM, 0, DM / 64, r, lane, scr64); return; } r -= WI_OUT;
    if (r < WI_UQ) { transpose_item64(p.w_uq + (size_t)l * 256 * 384, 256, 384, p.qn_g + l * 256, (bf16_t*)(ws + OFF_WUQT) + (size_t)l * 384 * 256, 384, 0, 384 / 64, r, lane, scr64, (bf16_t*)(ws + OFF_WUQF) + (size_t)l * 384 * 256, 3); return; } r -= WI_UQ;
    transpose_item64(p.w_ukv + (size_t)l * 128 * 512, 128, 512, p.kvn_g + l * 128, (bf16_t*)(ws + OFF_WUKVT) + (size_t)l * 512 * 128, 512, 0, 512 / 64, r, lane, scr64, (bf16_t*)(ws + OFF_WUKVF) + (size_t)l * 512 * 128, 4);
}

constexpr size_t OFF_WQ = 12288;
__device__ __forceinline__ void rows_item(const float* __restrict__ xsrc, bf16_t* __restrict__ Xb, float* __restrict__ rstd, int m, int lane) {
    float4 v[4][4]; float ss[4];
    typedef float f4nt_t __attribute__((ext_vector_type(4)));
#pragma unroll
    for (int r = 0; r < 4; ++r) { const f4nt_t* xr = (const f4nt_t*)(xsrc + (size_t)(m + r * (S / 4)) * DM) + lane;
#pragma unroll
        for (int j = 0; j < 4; ++j) { const f4nt_t t_ = __builtin_nontemporal_load(xr + 64 * j); v[r][j] = make_float4(t_.x, t_.y, t_.z, t_.w); } }
#pragma unroll
    for (int r = 0; r < 4; ++r) { float a = 0.f;
#pragma unroll
        for (int j = 0; j < 4; ++j) a += (v[r][j].x * v[r][j].x + v[r][j].y * v[r][j].y) + (v[r][j].z * v[r][j].z + v[r][j].w * v[r][j].w);
        ss[r] = wave_sum(a, lane); }
#pragma unroll
    for (int r = 0; r < 4; ++r) { const int row = m + r * (S / 4);
        if (lane == 0) rstd[row] = 1.0f / sqrtf(ss[r] * (1.0f / DM) + EPS);
        uint2* o = (uint2*)(Xb + (size_t)row * DM) + lane;
#pragma unroll
        for (int j = 0; j < 4; ++j) { typedef unsigned u2nt_t __attribute__((ext_vector_type(2))); u2nt_t w_; w_.x = pk2(v[r][j].x, v[r][j].y); w_.y = pk2(v[r][j].z, v[r][j].w); __builtin_nontemporal_store(w_, (u2nt_t*)(o + 64 * j)); } }
}
__device__ __forceinline__ void phase_prep(const Ctx& cx, const Params& p, float* lds) {
    unsigned char* ws = p.ws;
    const int wave = __builtin_amdgcn_readfirstlane(cx.tid >> 6), lane = cx.tid & 63;
    const int gtid = cx.bid * NT + cx.tid, GT = cx.nb * NT;
    if (cx.bid == 0 && cx.tid < DEPTH * 2) {
        const int l_ = cx.tid >> 1; float c2v;
        if ((cx.tid & 1) == 0) {
            float gq = 0.f, gn = 0.f, gr = 0.f;
            for (int d = 0; d < 96; ++d) gq = fmaxf(gq, fabsf(p.q_g[l_ * 96 + d]));
            for (int d = 0; d < 64; ++d) gn = fmaxf(gn, fabsf(p.kn_g[l_ * 64 + d]));
            for (int d = 0; d < 32; ++d) gr = fmaxf(gr, fabsf(p.kr_g[l_ * 32 + d]));
            c2v = gq * sqrtf(64.f * gn * gn + 32.f * gr * gr) * LOG2E * 1.02f;
        } else {
            float gq = 0.f, gk = 0.f;
            for (int d = 0; d < 64; ++d) { gq = fmaxf(gq, fabsf(p.mq_g[l_ * 64 + d])); gk = fmaxf(gk, fabsf(p.mk_g[l_ * 64 + d])); }
            c2v = gq * gk * 8.0f * LOG2E * 1.02f;
        }
        ((float*)(ws + OFF_C2))[cx.tid] = c2v;
    }
    {
        bf16_t* sgw = (bf16_t*)(ws + OFF_SGW);
        for (int i = gtid; i < DEPTH * 4 * 128 * 128; i += GT) {
            const int s_ = i & 127, t_ = (i >> 7) & 127;
            sgw[i] = (bf16_t)f2bf(s_ <= t_ ? p.sg_w[i] : 0.f);
        }
        float* cosA = (float*)(ws + OFF_COSA); float* sinA = (float*)(ws + OFF_SINA);
        float* cosD = (float*)(ws + OFF_COSD); float* sinD = (float*)(ws + OFF_SIND);
        for (int i = gtid; i < S * 24; i += GT) {
            const int s_ = i / 24, j = i % 24;
            const float posf = (float)p.pos[s_];
            float inv;
            if (j < 16) inv = powf(500000.0f, -((float)j * 2.0f / 32.0f));
            else inv = powf(500000.0f, -((float)(j - 16) * 2.0f / 16.0f));
            const float ang = posf * inv;
            const double rev = (double)ang * 0.15915494309189535;
            const float frac = (float)(rev - rint(rev));
            const float c = __builtin_amdgcn_cosf(frac), sn = __builtin_amdgcn_sinf(frac);
            if (j < 16) { cosA[s_ * 16 + j] = c; sinA[s_ * 16 + j] = sn; }
            else { cosD[s_ * 8 + (j - 16)] = c; sinD[s_ * 8 + (j - 16)] = sn; }
        }
    }
    {
        __attribute__((address_space(3))) float* scr = (__attribute__((address_space(3))) float*)lds + wave * (64 * 33);
        const int nwl = (cx.nb == 256) ? 1 : DEPTH;
        const int N_W = nwl * WI_L, N_R = S / 4, N_ALL = N_W + N_R;
        const int share = cx.bid & 7;
        unsigned* head = (unsigned*)(ws + OFF_WQ) + share * 64;
        const int per = (N_ALL + 7) / 8;
        __attribute__((address_space(3))) float* scr64 = (__attribute__((address_space(3))) float*)lds + wave * (64 * 65);
        for (;;) {
            int base = 0;
            if (lane == 0) base = (int)atomicAdd(head, 2u);
            base = __builtin_amdgcn_readfirstlane(base);
            if (base >= per) break;
#pragma unroll 1
            for (int k = 0; k < 2; ++k) {
                const int it = (base + k) * 8 + share; if (base + k >= per || it >= N_ALL) break;
                if (it < N_W) { weight_item(p, it / WI_L, it % WI_L, lane, scr64);
                } else rows_item(p.x, (bf16_t*)(ws + OFF_XB), (float*)(ws + OFF_RSTD), it - N_W, lane);
            }
        }
    }
}

struct AMapId { __device__ __forceinline__ int operator()(int k0) const { return k0; } };
struct AMapY {
    __device__ __forceinline__ int operator()(int k0) const { const int g = k0 >> 8; const int base = g == 0 ? C_GA : g == 1 ? C_GB : g == 2 ? C_GC : C_GD; return base + (k0 & 255); }
};
template <class AMap, class Epi>
__device__ __forceinline__ void gemm_naive(const Ctx& cx, const bf16_t* __restrict__ A, int lda, AMap amap, const bf16_t* __restrict__ Bt, int K, int M, int N, Epi epi, float* lds) {
    float (*As)[132] = (float (*)[132])lds;
    float (*Bs)[132] = (float (*)[132])(lds + 16 * 132);
    const int tid = cx.tid, ty = tid >> 5, tx = tid & 31;
    const int lr = tid >> 2, lk = (tid & 3) * 4;
    const int ntm = M / 128, ntn = N / 128;
    for (int tile = cx.bid; tile < ntm * ntn; tile += cx.nb) {
        const int tm = tile / ntn, tn = tile % ntn;
        float acc[8][4];
#pragma unroll
        for (int i = 0; i < 8; ++i)
#pragma unroll
            for (int j = 0; j < 4; ++j) acc[i][j] = 0.f;
        for (int k0 = 0; k0 < K; k0 += 16) {
            const uint2 av = *(const uint2*)(A + (size_t)(tm * 128 + lr) * lda + amap(k0) + lk);
            const uint2 bv = *(const uint2*)(Bt + (size_t)(tn * 128 + lr) * K + k0 + lk);
            __syncthreads();
            As[lk + 0][lr] = lo16(av.x); As[lk + 1][lr] = hi16(av.x); As[lk + 2][lr] = lo16(av.y); As[lk + 3][lr] = hi16(av.y);
            Bs[lk + 0][lr] = lo16(bv.x); Bs[lk + 1][lr] = hi16(bv.x); Bs[lk + 2][lr] = lo16(bv.y); Bs[lk + 3][lr] = hi16(bv.y);
            __syncthreads();
#pragma unroll
            for (int kk = 0; kk < 16; ++kk) {
                const float4 a0 = *(const float4*)&As[kk][ty * 8], a1 = *(const float4*)&As[kk][ty * 8 + 4];
                const float4 b = *(const float4*)&Bs[kk][tx * 4];
                const float a[8] = {a0.x, a0.y, a0.z, a0.w, a1.x, a1.y, a1.z, a1.w};
                const float bb[4] = {b.x, b.y, b.z, b.w};
#pragma unroll
                for (int i = 0; i < 8; ++i)
#pragma unroll
                    for (int j = 0; j < 4; ++j) acc[i][j] = fmaf(a[i], bb[j], acc[i][j]);
            }
        }
#pragma unroll
        for (int i = 0; i < 8; ++i) epi(tm * 128 + ty * 8 + i, tn * 128 + tx * 4, acc[i]);
    }
}
struct EpiIn {
    bf16_t* P; const float* rstd;
    __device__ __forceinline__ void operator()(int m, int n, const float (&v)[4]) const {
        const float r = rstd[m];
        *(uint2*)(P + (size_t)m * NP + n) = make_uint2(pk2(v[0] * r, v[1] * r), pk2(v[2] * r, v[3] * r));
    }
};
struct EpiOut {
    const float* xin; float* out;
    __device__ __forceinline__ void operator()(int m, int n, const float (&v)[4]) const {
        const float4 xi = *(const float4*)(xin + (size_t)m * DM + n);
        *(float4*)(out + (size_t)m * DM + n) = make_float4(xi.x + v[0], xi.y + v[1], xi.z + v[2], xi.w + v[3]);
    }
};

constexpr float QSCALE_A = 0.10206207261596577f * LOG2E;
constexpr float QSCALE_D = 0.125f * LOG2E;

__device__ __forceinline__ void post_mla(const Ctx& cx, const Params& p, int l, float* lds) {
    unsigned char* ws = p.ws;
    const bf16_t* P = (const bf16_t*)(ws + OFF_P);
    const bf16_t* WuqT = (const bf16_t*)(ws + OFF_WUQT) + (size_t)l * 384 * 256;
    const bf16_t* WukvT = (const bf16_t*)(ws + OFF_WUKVT) + (size_t)l * 512 * 128;
    bf16_t* Qa = (bf16_t*)(ws + OFF_QA); bf16_t* Ka = (bf16_t*)(ws + OFF_KA); bf16_t* Va = (bf16_t*)(ws + OFF_VA);
    const float* cosA = (const float*)(ws + OFF_COSA); const float* sinA = (const float*)(ws + OFF_SINA);
    const float* q_g = p.q_g + l * 96; const float* kn_g = p.kn_g + l * 64; const float* kr_g = p.kr_g + l * 32;
    float* cq = lds;
    float* ckv = lds + 256;
    float* kr = lds + 384;
    float* qf = lds + 416;
    float* kvf = lds + 800;
    float* st = lds + 1312;
    const int tid = cx.tid, wave = tid >> 6, lane = tid & 63;
    for (int s = cx.bid; s < S; s += cx.nb) {
        __syncthreads();
        if (tid < 416) lds[tid] = bf2f(P[(size_t)s * NP + tid]);
        __syncthreads();
        if (wave == 0) { float a = 0.f; for (int j = 0; j < 4; ++j) { const float v = cq[lane + 64 * j]; a += v * v; } a = wave_sum(a, lane); if (lane == 0) st[0] = 1.0f / sqrtf(a * (1.f / 256.f) + EPS); }
        if (wave == 1) { float a = 0.f; for (int j = 0; j < 2; ++j) { const float v = ckv[lane + 64 * j]; a += v * v; } a = wave_sum(a, lane); if (lane == 0) st[1] = 1.0f / sqrtf(a * (1.f / 128.f) + EPS); }
        if (wave == 2) { float a = 0.f; if (lane < 32) { const float v = kr[lane]; a = v * v; } a = wave_sum(a, lane); if (lane == 0) st[2] = 1.0f / sqrtf(a * (1.f / 32.f) + EPS); }
        __syncthreads();
        if (tid < 384) {
            const uint4* w = (const uint4*)(WuqT + (size_t)tid * 256);
            float a = 0.f;
            for (int c = 0; c < 32; ++c) {
                const uint4 u = w[c]; const float* x = cq + c * 8;
                a += x[0] * lo16(u.x) + x[1] * hi16(u.x) + x[2] * lo16(u.y) + x[3] * hi16(u.y) + x[4] * lo16(u.z) + x[5] * hi16(u.z) + x[6] * lo16(u.w) + x[7] * hi16(u.w);
            }
            qf[tid] = a * st[0];
        }
        {
            const uint4* w = (const uint4*)(WukvT + (size_t)tid * 128);
            float a = 0.f;
            for (int c = 0; c < 16; ++c) {
                const uint4 u = w[c]; const float* x = ckv + c * 8;
                a += x[0] * lo16(u.x) + x[1] * hi16(u.x) + x[2] * lo16(u.y) + x[3] * hi16(u.y) + x[4] * lo16(u.z) + x[5] * hi16(u.z) + x[6] * lo16(u.w) + x[7] * hi16(u.w);
            }
            kvf[tid] = a * st[1];
        }
        __syncthreads();
        if (wave < 4) {
            float a = qf[wave * 96 + lane] * qf[wave * 96 + lane];
            if (lane < 32) { const float v = qf[wave * 96 + 64 + lane]; a += v * v; }
            a = wave_sum(a, lane); if (lane == 0) st[4 + wave] = 1.0f / sqrtf(a * (1.f / 96.f) + EPS);
        } else {
            const int h = wave - 4; const float v = kvf[h * 128 + lane]; float a = wave_sum(v * v, lane);
            if (lane == 0) st[8 + h] = 1.0f / sqrtf(a * (1.f / 64.f) + EPS);
        }
        __syncthreads();
        if (tid < 384) {
            const int h = tid / 96, d = tid % 96;
            float v = qf[tid] * st[4 + h] * q_g[d];
            if (d >= 64) {
                const int i = (d - 64) & 15; const bool first = (d - 64) < 16;
                const int pd = first ? d + 16 : d - 16;
                const float pv = qf[h * 96 + pd] * st[4 + h] * q_g[pd];
                const float c = cosA[s * 16 + i], sn = sinA[s * 16 + i];
                v = first ? v * c - pv * sn : v * c + pv * sn;
            }
            Qa[((size_t)h * S + s) * 96 + d] = (bf16_t)f2bf(v * QSCALE_A);
        }
        if (tid < 256) {
            const int h = tid >> 6, d = tid & 63;
            Ka[((size_t)h * (S / 64) + (s >> 6)) * 6144 + (d >> 3) * 512 + (s & 63) * 8 + (d & 7)] = (bf16_t)f2bf(kvf[h * 128 + d] * st[8 + h] * kn_g[d]);
        } else {
            const int t2 = tid - 256, h = t2 >> 6, d = t2 & 63;
            Va[((size_t)h * (S / 64) + (s >> 6)) * 4096 + (d >> 5) * 2048 + ((s & 63) >> 4) * 512 + (s & 15) * 32 + (d & 31)] = (bf16_t)f2bf(kvf[h * 128 + 64 + d]);
        }
        if (tid < 32) {
            const int i = tid & 15; const bool first = tid < 16; const int pd = first ? tid + 16 : tid - 16;
            const float v = kr[tid] * st[2] * kr_g[tid], pv = kr[pd] * st[2] * kr_g[pd];
            const float c = cosA[s * 16 + i], sn = sinA[s * 16 + i];
            const bf16_t o = (bf16_t)f2bf(first ? v * c - pv * sn : v * c + pv * sn);
            for (int h = 0; h < 4; ++h) Ka[((size_t)h * (S / 64) + (s >> 6)) * 6144 + ((64 + tid) >> 3) * 512 + (s & 63) * 8 + (tid & 7)] = o;
        }
    }
}

__device__ __forceinline__ void post_conv(const Ctx& cx, const Params& p, int l) {
    bf16_t* P = (bf16_t*)(p.ws + OFF_P);
    const float* cw = p.conv_w + l * 3 * 256;
    const int gtid = cx.bid * NT + cx.tid, GT = cx.nb * NT;
    for (int i = gtid; i < S * 256; i += GT) {
        const int t = i >> 8, c = i & 255;
        const bf16_t* row = P + (size_t)t * NP;
        float z0 = bf2f(row[C_CC + c]) * bf2f(row[C_CH + c]);
        float z1 = 0.f, z2 = 0.f;
        if (t >= 1) { const bf16_t* r1 = row - NP; z1 = bf2f(r1[C_CC + c]) * bf2f(r1[C_CH + c]); }
        if (t >= 2) { const bf16_t* r2 = row - 2 * NP; z2 = bf2f(r2[C_CC + c]) * bf2f(r2[C_CH + c]); }
        const float conv = cw[c] * z2 + cw[256 + c] * z1 + cw[512 + c] * z0;
        const float y = bf2f(row[C_CB + c]) * conv * silu(bf2f(row[C_GB + c]));
        P[(size_t)t * NP + C_GB + c] = (bf16_t)f2bf(y);
    }
}

__device__ __forceinline__ void post_sg(const Ctx& cx, const Params& p, int l, float* lds) {
    bf16_t* P = (bf16_t*)(p.ws + OFF_P);
    const bf16_t* SGW = (const bf16_t*)(p.ws + OFF_SGW) + (size_t)l * 4 * 128 * 128;
    const float* lng = p.ln_g + l * 256; const float* lnb = p.ln_b + l * 256; const float* sgb = p.sg_b + l * 4 * 128;
    float (*vn)[65] = (float (*)[65])lds;
    const int tid = cx.tid, r = tid >> 2, q4 = tid & 3, lane = tid & 63;
    for (int it = cx.bid; it < 128 * 4; it += cx.nb) {
        const int ch = it >> 2, g = it & 3;
        const size_t row = (size_t)ch * 128 + r;
        __syncthreads();
        float xv[64];
        {
            const uint4* src = (const uint4*)(P + row * NP + C_SV + q4 * 64);
#pragma unroll
            for (int c = 0; c < 8; ++c) { const uint4 u = src[c]; xv[c * 8 + 0] = lo16(u.x); xv[c * 8 + 1] = hi16(u.x); xv[c * 8 + 2] = lo16(u.y); xv[c * 8 + 3] = hi16(u.y); xv[c * 8 + 4] = lo16(u.z); xv[c * 8 + 5] = hi16(u.z); xv[c * 8 + 6] = lo16(u.w); xv[c * 8 + 7] = hi16(u.w); }
        }
        float sm = 0.f;
#pragma unroll
        for (int c = 0; c < 64; ++c) sm += xv[c];
        sm += shx(sm, 1, lane); sm += shx(sm, 2, lane);
        const float mu = sm * (1.f / 256.f);
        float sq = 0.f;
#pragma unroll
        for (int c = 0; c < 64; ++c) { const float d = xv[c] - mu; sq += d * d; }
        sq += shx(sq, 1, lane); sq += shx(sq, 2, lane);
        const float rs = 1.0f / sqrtf(sq * (1.f / 256.f) + EPS);
        if (q4 == g) {
#pragma unroll
            for (int c = 0; c < 64; ++c) vn[r][c] = (xv[c] - mu) * rs * lng[g * 64 + c] + lnb[g * 64 + c];
        }
        __syncthreads();
        float acc[16];
#pragma unroll
        for (int j = 0; j < 16; ++j) acc[j] = 0.f;
        const bf16_t* wrow = SGW + ((size_t)g * 128 + r) * 128;
        for (int s_ = 0; s_ <= r; ++s_) {
            const float w = bf2f(wrow[s_]);
#pragma unroll
            for (int j = 0; j < 16; ++j) acc[j] = fmaf(w, vn[s_][q4 * 16 + j], acc[j]);
        }
        const float bias = sgb[g * 128 + r];
        bf16_t* prow = P + row * NP;
#pragma unroll
        for (int j = 0; j < 16; ++j) {
            const int c = g * 64 + q4 * 16 + j;
            const float y = bf2f(prow[C_SU + c]) * (acc[j] + bias) * silu(bf2f(prow[C_GC + c]));
            prow[C_GC + c] = (bf16_t)f2bf(y);
        }
    }
}

__device__ __forceinline__ void post_moba(const Ctx& cx, const Params& p, int l, float* lds) {
    bf16_t* P = (bf16_t*)(p.ws + OFF_P);
    float* kmean = (float*)(p.ws + OFF_KMEAN);
    const float* cosD = (const float*)(p.ws + OFF_COSD); const float* sinD = (const float*)(p.ws + OFF_SIND);
    const float* mq_g = p.mq_g + l * 64; const float* mk_g = p.mk_g + l * 64;
    float (*kf)[65] = (float (*)[65])lds;
    const int tid = cx.tid;
    for (int it = cx.bid; it < 64 * 4; it += cx.nb) {
        const int n = it >> 2, h = it & 3;
        const bool isq = tid >= 256; const int r = tid & 255;
        const int srow = n * 256 + r;
        bf16_t* ptr = P + (size_t)srow * NP + (isq ? C_MQ : C_MK) + h * 64;
        const float* gg = isq ? mq_g : mk_g;
        float v[64];
        {
            const uint4* src = (const uint4*)ptr;
#pragma unroll
            for (int c = 0; c < 8; ++c) { const uint4 u = src[c]; v[c * 8 + 0] = lo16(u.x); v[c * 8 + 1] = hi16(u.x); v[c * 8 + 2] = lo16(u.y); v[c * 8 + 3] = hi16(u.y); v[c * 8 + 4] = lo16(u.z); v[c * 8 + 5] = hi16(u.z); v[c * 8 + 6] = lo16(u.w); v[c * 8 + 7] = hi16(u.w); }
        }
        float ss = 0.f;
#pragma unroll
        for (int c = 0; c < 64; ++c) ss += v[c] * v[c];
        const float rs = 1.0f / sqrtf(ss * (1.f / 64.f) + EPS);
#pragma unroll
        for (int c = 0; c < 64; ++c) v[c] = v[c] * rs * gg[c];
#pragma unroll
        for (int i = 0; i < 8; ++i) {
            const float c_ = cosD[srow * 8 + i], s_ = sinD[srow * 8 + i];
            const float a = v[i], b = v[i + 8];
            v[i] = a * c_ - b * s_; v[i + 8] = b * c_ + a * s_;
        }
        __syncthreads();
        if (!isq) {
#pragma unroll
            for (int c = 0; c < 64; ++c) kf[r][c] = v[c];
        }
        const float sc = isq ? QSCALE_D : 1.0f;
        {
            uint4* dst = (uint4*)ptr;
#pragma unroll
            for (int c = 0; c < 8; ++c) dst[c] = make_uint4(pk2(v[c * 8] * sc, v[c * 8 + 1] * sc), pk2(v[c * 8 + 2] * sc, v[c * 8 + 3] * sc), pk2(v[c * 8 + 4] * sc, v[c * 8 + 5] * sc), pk2(v[c * 8 + 6] * sc, v[c * 8 + 7] * sc));
        }
        __syncthreads();
        if (tid < 64) {
            float a = 0.f;
            for (int rr = 0; rr < 256; ++rr) a += kf[rr][tid];
            kmean[((size_t)h * 64 + n) * 64 + tid] = a * (1.f / 256.f);
        }
    }
}

__device__ __forceinline__ void phase_gate(const Ctx& cx, const Params& p, int l) {
    const bf16_t* P = (const bf16_t*)(p.ws + OFF_P);
    const float* kmean = (const float*)(p.ws + OFF_KMEAN);
    int* sel = (int*)(p.ws + OFF_SEL); int* mcnt = (int*)(p.ws + OFF_MCNT); int* mlist = (int*)(p.ws + OFF_LIST);
    const int gtid = cx.bid * NT + cx.tid, GT = cx.nb * NT;
    for (int i = gtid; i < 4 * S; i += GT) {
        const int h = i / S, s = i % S, qb = s >> 8;
        float q[64];
        {
            const uint4* src = (const uint4*)(P + (size_t)s * NP + C_MQ + h * 64);
#pragma unroll
            for (int c = 0; c < 8; ++c) { const uint4 u = src[c]; q[c * 8 + 0] = lo16(u.x); q[c * 8 + 1] = hi16(u.x); q[c * 8 + 2] = lo16(u.y); q[c * 8 + 3] = hi16(u.y); q[c * 8 + 4] = lo16(u.z); q[c * 8 + 5] = hi16(u.z); q[c * 8 + 6] = lo16(u.w); q[c * 8 + 7] = hi16(u.w); }
        }
        float b0 = -3.0e38f, b1 = -3.0e38f, b2 = -3.0e38f; int i0 = -1, i1 = -1, i2 = -1;
        for (int n = 0; n < qb; ++n) {
            const float* km = kmean + ((size_t)h * 64 + n) * 64;
            float g = 0.f;
#pragma unroll
            for (int c = 0; c < 64; ++c) g = fmaf(q[c], km[c], g);
            if (g > b0) { b2 = b1; i2 = i1; b1 = b0; i1 = i0; b0 = g; i0 = n; }
            else if (g > b1) { b2 = b1; i2 = i1; b1 = g; i1 = n; }
            else if (g > b2) { b2 = g; i2 = n; }
        }
        const int nv = qb < 3 ? qb : 3;
        *(int4*)(sel + (size_t)i * 4) = make_int4(i0, i1, i2, nv);
        const int lane = cx.tid & 63;
#pragma unroll 1
        for (int j = 0; j < 3; ++j) {
            const int n = j == 0 ? i0 : j == 1 ? i1 : i2; const bool valid = j < nv;
            unsigned long long todo = __ballot(valid);
            while (todo) {
                const int leader = __builtin_ctzll(todo);
                const int n0 = __builtin_amdgcn_readlane(n, leader);
                const bool mine = valid && n == n0;
                const unsigned long long m = __ballot(mine);
                const int rank = __builtin_popcountll(m & ((1ull << lane) - 1ull));
                int base = 0;
                if (lane == leader) base = atomicAdd(mcnt + h * 64 + n0, __builtin_popcountll(m));
                base = __builtin_amdgcn_readlane(base, leader);
                if (mine) mlist[(size_t)h * LIST_PER_HEAD + 256 * (63 * n0 - n0 * (n0 - 1) / 2) + base + rank] = (s << 2) | j;
                todo &= ~m;
            }
        }
    }
}

__device__ __forceinline__ void attn_mla_naive(const Ctx& cx, const Params& p, int l, float* lds) {
    unsigned char* ws = p.ws;
    bf16_t* P = (bf16_t*)(ws + OFF_P);
    const bf16_t* Qa = (const bf16_t*)(ws + OFF_QA); const bf16_t* Ka = (const bf16_t*)(ws + OFF_KA); const bf16_t* Va = (const bf16_t*)(ws + OFF_VA);
    float (*Ks)[100] = (float (*)[100])lds;
    float (*Vs)[68] = (float (*)[68])(lds + 64 * 100);
    float c2;
    {
        float gq = 0.f, gn = 0.f, gr = 0.f;
        for (int d = 0; d < 96; ++d) gq = fmaxf(gq, fabsf(p.q_g[l * 96 + d]));
        for (int d = 0; d < 64; ++d) gn = fmaxf(gn, fabsf(p.kn_g[l * 64 + d]));
        for (int d = 0; d < 32; ++d) gr = fmaxf(gr, fabsf(p.kr_g[l * 32 + d]));
        c2 = gq * sqrtf(64.f * gn * gn + 32.f * gr * gr) * LOG2E * 1.02f;
    }
    const int tid = cx.tid, qi = tid >> 2, part = tid & 3, lane = tid & 63;
    for (int it = cx.bid; it < 512; it += cx.nb) {
        const int pi = it & 255, sec = it >> 8, h = pi >> 6, j = pi & 63, i = sec ? 127 - j : j;
        const int qrow = i * 128 + qi;
        float q[96];
        {
            const uint4* src = (const uint4*)(Qa + ((size_t)h * S + qrow) * 96);
#pragma unroll
            for (int c = 0; c < 12; ++c) { const uint4 u = src[c]; q[c * 8 + 0] = lo16(u.x); q[c * 8 + 1] = hi16(u.x); q[c * 8 + 2] = lo16(u.y); q[c * 8 + 3] = hi16(u.y); q[c * 8 + 4] = lo16(u.z); q[c * 8 + 5] = hi16(u.z); q[c * 8 + 6] = lo16(u.w); q[c * 8 + 7] = hi16(u.w); }
        }
        float o[64];
#pragma unroll
        for (int d = 0; d < 64; ++d) o[d] = 0.f;
        float lsum = 0.f;
        const int ntiles = 2 * (i + 1);
        for (int kt = 0; kt < ntiles; ++kt) {
            __syncthreads();
            for (int c = tid; c < 768; c += NT) {
                const int key = c / 12, chn = c % 12;
                const uint4 u = *(const uint4*)(Ka + ((size_t)h * (S / 64) + kt) * 6144 + chn * 512 + key * 8);
                float* d_ = &Ks[key][chn * 8];
                d_[0] = lo16(u.x); d_[1] = hi16(u.x); d_[2] = lo16(u.y); d_[3] = hi16(u.y); d_[4] = lo16(u.z); d_[5] = hi16(u.z); d_[6] = lo16(u.w); d_[7] = hi16(u.w);
            }
            {
                const int key = tid >> 3, chn = tid & 7;
                const uint4 u = *(const uint4*)(Va + ((size_t)h * (S / 64) + kt) * 4096 + (chn >> 2) * 2048 + (key >> 4) * 512 + (key & 15) * 32 + (chn & 3) * 8);
                float* d_ = &Vs[key][chn * 8];
                d_[0] = lo16(u.x); d_[1] = hi16(u.x); d_[2] = lo16(u.y); d_[3] = hi16(u.y); d_[4] = lo16(u.z); d_[5] = hi16(u.z); d_[6] = lo16(u.w); d_[7] = hi16(u.w);
            }
            __syncthreads();
            for (int kk = 0; kk < 16; ++kk) {
                const int key = part + 4 * kk, kpos = kt * 64 + key;
                float sc = 0.f;
#pragma unroll
                for (int d = 0; d < 96; d += 4) { const float4 kv = *(const float4*)&Ks[key][d]; sc = fmaf(q[d], kv.x, sc); sc = fmaf(q[d + 1], kv.y, sc); sc = fmaf(q[d + 2], kv.z, sc); sc = fmaf(q[d + 3], kv.w, sc); }
                const float pr = (kpos <= qrow) ? exp2f(sc - c2) : 0.f;
                lsum += pr;
#pragma unroll
                for (int d = 0; d < 64; d += 4) { const float4 vv = *(const float4*)&Vs[key][d]; o[d] = fmaf(pr, vv.x, o[d]); o[d + 1] = fmaf(pr, vv.y, o[d + 1]); o[d + 2] = fmaf(pr, vv.z, o[d + 2]); o[d + 3] = fmaf(pr, vv.w, o[d + 3]); }
            }
        }
        lsum += shx(lsum, 1, lane); lsum += shx(lsum, 2, lane);
        const float inv = 1.0f / lsum;
        bf16_t* prow = P + (size_t)qrow * NP + C_GA + h * 64;
#pragma unroll
        for (int d = 0; d < 64; ++d) {
            float v = o[d]; v += shx(v, 1, lane); v += shx(v, 2, lane);
            if ((d >> 4) == part) { const float g = bf2f(prow[d]); prow[d] = (bf16_t)f2bf(v * inv * silu(g)); }
        }
    }
}

__device__ __forceinline__ void attn_moba_naive(const Ctx& cx, const Params& p, int l) {
    bf16_t* P = (bf16_t*)(p.ws + OFF_P);
    const int* sel = (const int*)(p.ws + OFF_SEL);
    float c2;
    {
        float gq = 0.f, gk = 0.f;
        for (int d = 0; d < 64; ++d) { gq = fmaxf(gq, fabsf(p.mq_g[l * 64 + d])); gk = fmaxf(gk, fabsf(p.mk_g[l * 64 + d])); }
        c2 = gq * gk * 8.0f * LOG2E * 1.02f;
    }
    const int wave = cx.tid >> 6, lane = cx.tid & 63;
    const int gw = cx.bid * (NT / 64) + wave, NGW = cx.nb * (NT / 64);
    for (int it = gw; it < 4 * S; it += NGW) {
        const int h = it / S, s = it % S, own = s >> 8;
        float q[64];
        {
            const uint4* src = (const uint4*)(P + (size_t)s * NP + C_MQ + h * 64);
#pragma unroll
            for (int c = 0; c < 8; ++c) { const uint4 u = src[c]; q[c * 8 + 0] = lo16(u.x); q[c * 8 + 1] = hi16(u.x); q[c * 8 + 2] = lo16(u.y); q[c * 8 + 3] = hi16(u.y); q[c * 8 + 4] = lo16(u.z); q[c * 8 + 5] = hi16(u.z); q[c * 8 + 6] = lo16(u.w); q[c * 8 + 7] = hi16(u.w); }
        }
        const int4 sl = *(const int4*)(sel + (size_t)it * 4);
        float o[64];
#pragma unroll
        for (int d = 0; d < 64; ++d) o[d] = 0.f;
        float lsum = 0.f;
        const int nsel = sl.w;
#pragma unroll 1
        for (int bi = 3 - nsel; bi < 4; ++bi) {
            const int sidx = 2 - bi;
            const int blk = bi == 3 ? own : (sidx == 0 ? sl.x : sidx == 1 ? sl.y : sl.z);
#pragma unroll 1
            for (int jj = 0; jj < 4; ++jj) {
                const int kpos = blk * 256 + lane + 64 * jj;
                const uint4* kp = (const uint4*)(P + (size_t)kpos * NP + C_MK + h * 64);
                float sc = 0.f;
#pragma unroll
                for (int c = 0; c < 8; ++c) { const uint4 u = kp[c]; sc += q[c * 8] * lo16(u.x) + q[c * 8 + 1] * hi16(u.x) + q[c * 8 + 2] * lo16(u.y) + q[c * 8 + 3] * hi16(u.y) + q[c * 8 + 4] * lo16(u.z) + q[c * 8 + 5] * hi16(u.z) + q[c * 8 + 6] * lo16(u.w) + q[c * 8 + 7] * hi16(u.w); }
                const bool ok = (bi != 3) || (kpos <= s);
                const float pr = ok ? exp2f(sc - c2) : 0.f;
                lsum += pr;
                const uint4* vp = (const uint4*)(P + (size_t)kpos * NP + C_MV + h * 64);
#pragma unroll
                for (int c = 0; c < 8; ++c) { const uint4 u = vp[c]; o[c * 8] = fmaf(pr, lo16(u.x), o[c * 8]); o[c * 8 + 1] = fmaf(pr, hi16(u.x), o[c * 8 + 1]); o[c * 8 + 2] = fmaf(pr, lo16(u.y), o[c * 8 + 2]); o[c * 8 + 3] = fmaf(pr, hi16(u.y), o[c * 8 + 3]); o[c * 8 + 4] = fmaf(pr, lo16(u.z), o[c * 8 + 4]); o[c * 8 + 5] = fmaf(pr, hi16(u.z), o[c * 8 + 5]); o[c * 8 + 6] = fmaf(pr, lo16(u.w), o[c * 8 + 6]); o[c * 8 + 7] = fmaf(pr, hi16(u.w), o[c * 8 + 7]); }
            }
        }
        lsum = wave_sum(lsum, lane);
        float r32[32], r16[16], r8[8], r4[4], r2[2];
#pragma unroll
        for (int d = 0; d < 32; ++d) { const bool hb = (lane & 32) != 0; const float keep = hb ? o[d + 32] : o[d], send = hb ? o[d] : o[d + 32]; r32[d] = keep + shx(send, 32, lane); }
#pragma unroll
        for (int d = 0; d < 16; ++d) { const bool hb = (lane & 16) != 0; const float keep = hb ? r32[d + 16] : r32[d], send = hb ? r32[d] : r32[d + 16]; r16[d] = keep + shx(send, 16, lane); }
#pragma unroll
        for (int d = 0; d < 8; ++d) { const bool hb = (lane & 8) != 0; const float keep = hb ? r16[d + 8] : r16[d], send = hb ? r16[d] : r16[d + 8]; r8[d] = keep + shx(send, 8, lane); }
#pragma unroll
        for (int d = 0; d < 4; ++d) { const bool hb = (lane & 4) != 0; const float keep = hb ? r8[d + 4] : r8[d], send = hb ? r8[d] : r8[d + 4]; r4[d] = keep + shx(send, 4, lane); }
#pragma unroll
        for (int d = 0; d < 2; ++d) { const bool hb = (lane & 2) != 0; const float keep = hb ? r4[d + 2] : r4[d], send = hb ? r4[d] : r4[d + 2]; r2[d] = keep + shx(send, 2, lane); }
        float mine;
        { const bool hb = (lane & 1) != 0; const float keep = hb ? r2[1] : r2[0], send = hb ? r2[0] : r2[1]; mine = keep + shx(send, 1, lane); }
        bf16_t* gp = P + (size_t)s * NP + C_GD + h * 64 + lane;
        const float g = bf2f(*gp);
        *gp = (bf16_t)f2bf(mine / lsum * silu(g));
    }
}


namespace mla {
typedef short bf16x8 __attribute__((ext_vector_type(8)));
typedef short s16x4 __attribute__((ext_vector_type(4)));
typedef float f32x16 __attribute__((ext_vector_type(16)));
typedef unsigned u32x4 __attribute__((ext_vector_type(4)));
#define LAS3 __attribute__((address_space(3)))
constexpr int KT_BYTES = 12288, VT_BYTES = 8192, STAGE_BYTES = 2 * KT_BYTES + 2 * VT_BYTES;
constexpr int OFF_OCOMB = 2 * STAGE_BYTES, OFF_LCOMB = OFF_OCOMB + 32768, OFF_WSF = OFF_LCOMB + 512, OFF_OST = OFF_WSF + 512, MLA_LDS_END = OFF_OST + 16384;
static_assert(MLA_LDS_END <= LDS_BYTES, "mla lds");
__device__ __forceinline__ int crow(int r, int hi) { return (r & 3) + 8 * (r >> 2) + 4 * hi; }
__device__ __forceinline__ s16x4 vtr(const LAS3 unsigned char* p) { typedef short v4i16_t __attribute__((ext_vector_type(4))); return __builtin_bit_cast(s16x4, __builtin_amdgcn_ds_read_tr16_b64_v4i16((LAS3 v4i16_t*)p)); }
__device__ __forceinline__ unsigned cvtpk(float lo, float hi) { typedef float f32x2_t __attribute__((ext_vector_type(2))); typedef __bf16 bf16x2_t __attribute__((ext_vector_type(2))); f32x2_t v = {lo, hi}; bf16x2_t b = __builtin_convertvector(v, bf16x2_t); return __builtin_bit_cast(unsigned, b); }

__device__ __forceinline__ void attn_mla_fast(const Ctx& cx, const Params& p, int l, unsigned char* lds_generic) {
    unsigned char* ws = p.ws;
    bf16_t* P = (bf16_t*)(ws + OFF_P);
    const bf16_t* Qa = (const bf16_t*)(ws + OFF_QA); const bf16_t* Ka = (const bf16_t*)(ws + OFF_KA); const bf16_t* Va = (const bf16_t*)(ws + OFF_VA);
    LAS3 unsigned char* lds = (LAS3 unsigned char*)lds_generic;
    float c2;
    {
        float gq = 0.f, gn = 0.f, gr = 0.f;
        for (int d = 0; d < 96; ++d) gq = fmaxf(gq, fabsf(p.q_g[l * 96 + d]));
        for (int d = 0; d < 64; ++d) gn = fmaxf(gn, fabsf(p.kn_g[l * 64 + d]));
        for (int d = 0; d < 32; ++d) gr = fmaxf(gr, fabsf(p.kr_g[l * 32 + d]));
        c2 = gq * sqrtf(64.f * gn * gn + 32.f * gr * gr) * LOG2E * 1.02f;
    }
    const int tid = cx.tid, lane = tid & 63, r32 = lane & 31, hi = lane >> 5;
    const int wave = __builtin_amdgcn_readfirstlane(tid >> 6), grp = wave >> 2, w = wave & 3;
    int kgo[3], klo[3];
#pragma unroll
    for (int j = 0; j < 3; ++j) { const int idx = tid + 512 * j, tile = idx / 768, rem = idx % 768, c = rem >> 6, key = rem & 63; kgo[j] = (tile * 64 + key) * 96 + c * 8; klo[j] = tile * KT_BYTES + c * 1024 + key * 16; }
    const int vkey = tid >> 3, vdc = tid & 7;
    const int vgo = vkey * 64 + vdc * 8, vlo_ = 2 * KT_BYTES + (vdc >> 2) * 4096 + (vkey >> 4) * 1024 + (vkey & 15) * 64 + (vdc & 3) * 16;
    const int kfrag = hi * 1024 + r32 * 16;
    const int vfrag = ((lane >> 4) & 1) * 32 + (lane & 3) * 8 + (4 * hi + ((lane & 15) >> 2)) * 64;
    for (int it = cx.bid; it < 512; it += cx.nb) {
        const int pi = it & 255, sec = it >> 8, h = pi >> 6, jj = pi & 63, i = sec ? 127 - jj : jj;
        const int q0 = i * 128, qrow = q0 + 32 * w + r32, nsteps = i + 1;
        const bf16_t* Kh = Ka + (size_t)h * S * 96; const bf16_t* Vh = Va + (size_t)h * S * 64;
        bf16x8 qr[6];
#pragma unroll
        for (int d0 = 0; d0 < 6; ++d0) qr[d0] = *(const bf16x8*)(Qa + ((size_t)h * S + qrow) * 96 + d0 * 16 + hi * 8);
        f32x16 o0, o1;
#pragma unroll
        for (int r = 0; r < 16; ++r) { o0[r] = 0.f; o1[r] = 0.f; }
        float lsum = 0.f;
        u32x4 kreg[3], vreg[2];
#define MLA_LOADG(st) do { const bf16_t* kb_ = Kh + (size_t)(st) * 128 * 96; const bf16_t* vb_ = Vh + (size_t)(st) * 128 * 64; \
            _Pragma("unroll") for (int j = 0; j < 3; ++j) kreg[j] = *(const u32x4*)(kb_ + kgo[j]); \
            vreg[0] = *(const u32x4*)(vb_ + vgo); vreg[1] = *(const u32x4*)(vb_ + 64 * 64 + vgo); } while (0)
#define MLA_WRITEL(sb) do { LAS3 unsigned char* b_ = lds + (sb) * STAGE_BYTES; \
            _Pragma("unroll") for (int j = 0; j < 3; ++j) *(LAS3 u32x4*)(b_ + klo[j]) = kreg[j]; \
            *(LAS3 u32x4*)(b_ + vlo_) = vreg[0]; *(LAS3 u32x4*)(b_ + vlo_ + VT_BYTES) = vreg[1]; } while (0)
        __syncthreads();
        MLA_LOADG(0); MLA_WRITEL(0);
        __syncthreads();
        for (int s = 0; s < nsteps; ++s) {
            const bool more = (s + 1 < nsteps), last = !more;
            if (more) MLA_LOADG(s + 1);
            const LAS3 unsigned char* Kt = lds + (s & 1) * STAGE_BYTES + grp * KT_BYTES;
            const LAS3 unsigned char* Vt = lds + (s & 1) * STAGE_BYTES + 2 * KT_BYTES + grp * VT_BYTES;
            const bool active = !(last && grp == 1 && w < 2);
            if (active) {
                f32x16 p0, p1;
#pragma unroll
                for (int r = 0; r < 16; ++r) { p0[r] = -c2; p1[r] = -c2; }
#pragma unroll
                for (int d0 = 0; d0 < 6; ++d0) {
                    const bf16x8 a0 = *(const LAS3 bf16x8*)(Kt + kfrag + d0 * 2048);
                    const bf16x8 a1 = *(const LAS3 bf16x8*)(Kt + kfrag + d0 * 2048 + 512);
                    p0 = __builtin_amdgcn_mfma_f32_32x32x16_bf16(a0, qr[d0], p0, 0, 0, 0);
                    p1 = __builtin_amdgcn_mfma_f32_32x32x16_bf16(a1, qr[d0], p1, 0, 0, 0);
                }
                if (last) {
                    const int kbase = s * 128 + grp * 64 + 4 * hi;
#pragma unroll
                    for (int r = 0; r < 16; ++r) { const int kv = kbase + (r & 3) + 8 * (r >> 2); if (kv > qrow) p0[r] = -INFINITY; if (kv + 32 > qrow) p1[r] = -INFINITY; }
                }
                float sacc = 0.f;
#pragma unroll
                for (int r = 0; r < 16; ++r) { p0[r] = __builtin_amdgcn_exp2f(p0[r]); p1[r] = __builtin_amdgcn_exp2f(p1[r]); sacc += p0[r] + p1[r]; }
                lsum += sacc;
                u32x4 pw[4];
                pw[0] = (u32x4){cvtpk(p0[0], p0[1]), cvtpk(p0[2], p0[3]), cvtpk(p0[4], p0[5]), cvtpk(p0[6], p0[7])};
                pw[1] = (u32x4){cvtpk(p0[8], p0[9]), cvtpk(p0[10], p0[11]), cvtpk(p0[12], p0[13]), cvtpk(p0[14], p0[15])};
                pw[2] = (u32x4){cvtpk(p1[0], p1[1]), cvtpk(p1[2], p1[3]), cvtpk(p1[4], p1[5]), cvtpk(p1[6], p1[7])};
                pw[3] = (u32x4){cvtpk(p1[8], p1[9]), cvtpk(p1[10], p1[11]), cvtpk(p1[12], p1[13]), cvtpk(p1[14], p1[15])};
#pragma unroll
                for (int ks = 0; ks < 4; ++ks) {
                    const s16x4 l0 = vtr(Vt + vfrag + ks * 1024), h0 = vtr(Vt + vfrag + ks * 1024 + 512);
                    const s16x4 l1 = vtr(Vt + vfrag + 4096 + ks * 1024), h1 = vtr(Vt + vfrag + 4096 + ks * 1024 + 512);
                    const bf16x8 b0 = (bf16x8){l0[0], l0[1], l0[2], l0[3], h0[0], h0[1], h0[2], h0[3]};
                    const bf16x8 b1 = (bf16x8){l1[0], l1[1], l1[2], l1[3], h1[0], h1[1], h1[2], h1[3]};
                    const bf16x8 pa = __builtin_bit_cast(bf16x8, pw[ks]);
                    o0 = __builtin_amdgcn_mfma_f32_32x32x16_bf16(pa, b0, o0, 0, 0, 0);
                    o1 = __builtin_amdgcn_mfma_f32_32x32x16_bf16(pa, b1, o1, 0, 0, 0);
                }
            }
            if (more) MLA_WRITEL((s + 1) & 1);
            __syncthreads();
        }
#undef MLA_LOADG
#undef MLA_WRITEL
        lsum += shx(lsum, 32, lane);
        LAS3 float* Ocomb = (LAS3 float*)(lds + OFF_OCOMB) + w * 2048;
        LAS3 float* lcomb = (LAS3 float*)(lds + OFF_LCOMB) + w * 32;
        LAS3 float* wsf = (LAS3 float*)(lds + OFF_WSF) + w * 32;
        LAS3 bf16_t* Ost = (LAS3 bf16_t*)(lds + OFF_OST);
        if (grp == 1) {
#pragma unroll
            for (int r = 0; r < 16; ++r) { Ocomb[r * 64 + lane] = o0[r]; Ocomb[1024 + r * 64 + lane] = o1[r]; }
            if (hi == 0) lcomb[r32] = lsum;
        }
        __syncthreads();
        if (grp == 0) {
#pragma unroll
            for (int r = 0; r < 16; ++r) { o0[r] += Ocomb[r * 64 + lane]; o1[r] += Ocomb[1024 + r * 64 + lane]; }
            lsum += lcomb[r32];
            if (hi == 0) wsf[r32] = lsum;
            __builtin_amdgcn_s_waitcnt(0xC07F);
#pragma unroll
            for (int r = 0; r < 16; ++r) {
                const int orow = crow(r, hi); const float rl = 1.0f / wsf[orow];
                Ost[(32 * w + orow) * 64 + r32] = (bf16_t)f2bf(o0[r] * rl);
                Ost[(32 * w + orow) * 64 + 32 + r32] = (bf16_t)f2bf(o1[r] * rl);
            }
        }
        __syncthreads();
#pragma unroll
        for (int j = 0; j < 2; ++j) {
            const int chunk = tid + 512 * j, row = chunk >> 3, dc = chunk & 7;
            const u32x4 ov = *(const LAS3 u32x4*)(Ost + row * 64 + dc * 8);
            bf16_t* gp = P + (size_t)(q0 + row) * NP + C_GA + h * 64 + dc * 8;
            const uint4 gv = *(const uint4*)gp;
            uint4 y;
            y.x = pk2(lo16(ov.x) * silu(lo16(gv.x)), hi16(ov.x) * silu(hi16(gv.x)));
            y.y = pk2(lo16(ov.y) * silu(lo16(gv.y)), hi16(ov.y) * silu(hi16(gv.y)));
            y.z = pk2(lo16(ov.z) * silu(lo16(gv.z)), hi16(ov.z) * silu(hi16(gv.z)));
            y.w = pk2(lo16(ov.w) * silu(lo16(gv.w)), hi16(ov.w) * silu(hi16(gv.w)));
            *(uint4*)gp = y;
        }
    }
}
}


namespace mla2 {
using mla::bf16x8; using mla::s16x4; using mla::f32x16; using mla::u32x4; using mla::crow; using mla::vtr; using mla::cvtpk;
constexpr int KT_BYTES = 12288, VT_BYTES = 8192, STAGE_BYTES = 2 * KT_BYTES + 2 * VT_BYTES, NSTAGE = 3;
constexpr int OFF_OCOMB = 0  , OFF_LCOMB = NSTAGE * STAGE_BYTES, OFF_WSF = OFF_LCOMB + 512, OFF_OST = OFF_WSF + 512, MLA_LDS_END = OFF_OST + 16384;
static_assert(MLA_LDS_END <= LDS_BYTES - 64, "mla2 lds");
#define SBAR() __builtin_amdgcn_sched_barrier(0)
__device__ __forceinline__ void glds16(const void* gsrc, unsigned lds_dst) { unsigned keep;
    asm volatile("s_mov_b32 %0, m0\n\ts_mov_b32 m0, %2\n\ts_nop 0\n\tglobal_load_lds_dwordx4 %1, off\n\ts_mov_b32 m0, %0" : "=&s"(keep) : "v"(gsrc), "s"(lds_dst) : "memory"); }
#define P2_WAITBAR() asm volatile("s_waitcnt vmcnt(0) lgkmcnt(0)\n\ts_barrier" ::: "memory")
#define PEL(P0, P1, f) ((f) < 16 ? P0[(f) & 15] : P1[(f) & 15])
__device__ __forceinline__ void attn_mla_pipe(const Ctx& cx, const Params& p, int l, unsigned char* lds_generic) {
    unsigned char* ws = p.ws;
    bf16_t* P = (bf16_t*)(ws + OFF_P);
    const bf16_t* Qa = (const bf16_t*)(ws + OFF_QA); const bf16_t* Ka = (const bf16_t*)(ws + OFF_KA); const bf16_t* Va = (const bf16_t*)(ws + OFF_VA);
    LAS3 unsigned char* lds = (LAS3 unsigned char*)lds_generic;
    const unsigned lds0 = (unsigned)(uintptr_t)lds;
    const float c2 = ((const float*)(ws + OFF_C2))[l * 2];
    const int tid = cx.tid, lane = tid & 63, r32 = lane & 31, hi = lane >> 5;
    const int wave = __builtin_amdgcn_readfirstlane(tid >> 6), grp = wave >> 2, w = wave & 3;
    int gso[5], ldo[5]; bool isk[5];
#pragma unroll
    for (int j = 0; j < 5; ++j) {
        const int pidx = wave + 8 * j, tile = pidx / 20, wi = pidx % 20;
        isk[j] = wi < 12;
        if (wi < 12) { gso[j] = tile * 6144 + wi * 512 + lane * 8; ldo[j] = tile * KT_BYTES + wi * 1024; }
        else { const int v = wi - 12, dh = v >> 2, kg = v & 3; gso[j] = tile * 4096 + v * 512 + lane * 8; ldo[j] = 2 * KT_BYTES + tile * VT_BYTES + dh * 4096 + kg * 1024; }
    }
    const int kfrag = hi * 1024 + r32 * 16 + grp * KT_BYTES;
    const int vfrag = ((lane >> 4) & 1) * 32 + (lane & 3) * 8 + (4 * hi + ((lane & 15) >> 2)) * 64 + 2 * KT_BYTES + grp * VT_BYTES;
    const float coff = fmaxf(c2 - 64.f, 0.f);
    const f32x16 zero16 = {0.f, 0.f, 0.f, 0.f, 0.f, 0.f, 0.f, 0.f, 0.f, 0.f, 0.f, 0.f, 0.f, 0.f, 0.f, 0.f};
    for (int it = cx.bid; it < 512; it += cx.nb) {
        const int pi = it & 255, sec = it >> 8, xcd = pi & 7, idx = pi >> 3, h = xcd >> 1, jj = (xcd & 1) * 32 + idx, i = sec ? 127 - jj : jj;
        const int q0 = i * 128, qrow = q0 + 32 * w + r32, nsteps = i + 1;
        const bf16_t* Kh = Ka + (size_t)h * S * 96; const bf16_t* Vh = Va + (size_t)h * S * 64;
        bf16x8 qr[6];
#pragma unroll
        for (int d0 = 0; d0 < 6; ++d0) qr[d0] = *(const bf16x8*)(Qa + ((size_t)h * S + qrow) * 96 + d0 * 16 + hi * 8);
        f32x16 o0, o1, pa0, pa1, pb0, pb1;
#pragma unroll
        for (int r = 0; r < 16; ++r) { o0[r] = 0.f; o1[r] = 0.f; }
        float lsum = 0.f;
        u32x4 pw[4];
        int sl_prev = 0, sl_cur = 0, sl_next = STAGE_BYTES;
#define ROT() do { sl_prev = sl_cur; sl_cur = sl_next; sl_next = (sl_next == (NSTAGE - 1) * STAGE_BYTES) ? 0 : sl_next + STAGE_BYTES; } while (0)
#define P2_DMA(st, soff) do { const bf16_t* kb_ = Kh + (size_t)(st) * 128 * 96; const bf16_t* vb_ = Vh + (size_t)(st) * 128 * 64; \
            _Pragma("unroll") for (int j = 0; j < 5; ++j) glds16((isk[j] ? kb_ : vb_) + gso[j], (unsigned)__builtin_amdgcn_readfirstlane((int)(lds0 + (soff) + ldo[j]))); } while (0)
#define P2_DMA1(st, soff, j) do { const bf16_t* kb_ = Kh + (size_t)(st) * 128 * 96; const bf16_t* vb_ = Vh + (size_t)(st) * 128 * 64; \
            glds16((isk[j] ? kb_ : vb_) + gso[j], (unsigned)__builtin_amdgcn_readfirstlane((int)(lds0 + (soff) + ldo[j]))); } while (0)
#define P2_MASK(C0, C1, s_) do { const int kbase_ = (s_) * 128 + grp * 64 + 4 * hi; \
            _Pragma("unroll") for (int r = 0; r < 16; ++r) { const int kv_ = kbase_ + (r & 3) + 8 * (r >> 2); if (kv_ > qrow) C0[r] = -INFINITY; if (kv_ + 32 > qrow) C1[r] = -INFINITY; } } while (0)
#define PIN(x) asm volatile("" : "+v"(x))
#define KFR(mm) (*(const LAS3 bf16x8*)(Kt_ + ((mm) >> 1) * 2048 + ((mm) & 1) * 512))
#define VFRD(buf, ii) do { vlo[buf] = vtr(Vp_ + ((ii) >> 2) * 4096 + ((ii) & 3) * 1024); vhi[buf] = vtr(Vp_ + ((ii) >> 2) * 4096 + ((ii) & 3) * 1024 + 512); } while (0)
#define P2_STEP(C0, C1, P0, P1, PREV, s_) do { \
            const bool more_ = ((s_) + 1 < nsteps); \
            const LAS3 unsigned char* Kt_ = lds + sl_cur + kfrag; const LAS3 unsigned char* Vp_ = lds + sl_prev + vfrag; \
            s16x4 vlo[3], vhi[3]; bf16x8 kf[4]; float sacc = 0.f; \
            kf[0] = KFR(0); kf[1] = KFR(1); kf[2] = KFR(2); \
            SBAR(); \
            _Pragma("unroll") for (int m = 0; m < 12; ++m) { \
                if (m + 3 < 12) kf[(m + 3) & 3] = KFR(m + 3); \
                if (more_ && (m & 1) == 1 && m < 10) P2_DMA1((s_) + 1, sl_next, (m >> 1)); \
                if (PREV && m == 9) VFRD(0, 0); \
                if (PREV && m == 10) VFRD(1, 1); \
                if ((m & 1) == 0) C0 = __builtin_amdgcn_mfma_f32_32x32x16_bf16(kf[m & 3], qr[m >> 1], (m >> 1) == 0 ? zero16 : C0, 0, 0, 0); \
                else              C1 = __builtin_amdgcn_mfma_f32_32x32x16_bf16(kf[m & 3], qr[m >> 1], (m >> 1) == 0 ? zero16 : C1, 0, 0, 0); \
                if (PREV && m < 8) { const int f_ = 4 * (m & 7); \
                    sacc += PEL(P0, P1, f_); sacc += PEL(P0, P1, f_ + 1); sacc += PEL(P0, P1, f_ + 2); sacc += PEL(P0, P1, f_ + 3); PIN(sacc); \
                    pw[(m & 7) >> 1][(m & 1) * 2] = cvtpk(PEL(P0, P1, f_), PEL(P0, P1, f_ + 1)); pw[(m & 7) >> 1][(m & 1) * 2 + 1] = cvtpk(PEL(P0, P1, f_ + 2), PEL(P0, P1, f_ + 3)); PIN(pw[(m & 7) >> 1]); } \
                SBAR(); } \
            lsum += sacc; \
            if (coff > 0.f) { _Pragma("unroll") for (int r = 0; r < 16; ++r) { C0[r] -= coff; C1[r] -= coff; } } \
            if (!more_) P2_MASK(C0, C1, s_); \
            SBAR(); \
            _Pragma("unroll") for (int j = 0; j < 8; ++j) { \
                if (PREV) { \
                    if (j + 2 < 8) VFRD((j + 2) % 3, j + 2); \
                    const bf16x8 vb_ = (bf16x8){vlo[j % 3][0], vlo[j % 3][1], vlo[j % 3][2], vlo[j % 3][3], vhi[j % 3][0], vhi[j % 3][1], vhi[j % 3][2], vhi[j % 3][3]}; \
                    if (j < 4) o0 = __builtin_amdgcn_mfma_f32_32x32x16_bf16(__builtin_bit_cast(bf16x8, pw[j & 3]), vb_, o0, 0, 0, 0); \
                    else       o1 = __builtin_amdgcn_mfma_f32_32x32x16_bf16(__builtin_bit_cast(bf16x8, pw[j & 3]), vb_, o1, 0, 0, 0); } \
                if (j < 4) { C0[4 * j] = __builtin_amdgcn_exp2f(C0[4 * j]); C0[4 * j + 1] = __builtin_amdgcn_exp2f(C0[4 * j + 1]); C0[4 * j + 2] = __builtin_amdgcn_exp2f(C0[4 * j + 2]); C0[4 * j + 3] = __builtin_amdgcn_exp2f(C0[4 * j + 3]); PIN(C0); } \
                else { C1[4 * (j & 3)] = __builtin_amdgcn_exp2f(C1[4 * (j & 3)]); C1[4 * (j & 3) + 1] = __builtin_amdgcn_exp2f(C1[4 * (j & 3) + 1]); C1[4 * (j & 3) + 2] = __builtin_amdgcn_exp2f(C1[4 * (j & 3) + 2]); C1[4 * (j & 3) + 3] = __builtin_amdgcn_exp2f(C1[4 * (j & 3) + 3]); PIN(C1); } \
                SBAR(); } \
            P2_WAITBAR(); ROT(); \
        } while (0)
#define P2_DRAIN(P0, P1) do { const LAS3 unsigned char* Vp_ = lds + sl_prev + vfrag; float sacc = 0.f; \
            _Pragma("unroll") for (int r = 0; r < 16; ++r) sacc += P0[r] + P1[r]; \
            lsum += sacc; \
            pw[0] = (u32x4){cvtpk(P0[0], P0[1]), cvtpk(P0[2], P0[3]), cvtpk(P0[4], P0[5]), cvtpk(P0[6], P0[7])}; \
            pw[1] = (u32x4){cvtpk(P0[8], P0[9]), cvtpk(P0[10], P0[11]), cvtpk(P0[12], P0[13]), cvtpk(P0[14], P0[15])}; \
            pw[2] = (u32x4){cvtpk(P1[0], P1[1]), cvtpk(P1[2], P1[3]), cvtpk(P1[4], P1[5]), cvtpk(P1[6], P1[7])}; \
            pw[3] = (u32x4){cvtpk(P1[8], P1[9]), cvtpk(P1[10], P1[11]), cvtpk(P1[12], P1[13]), cvtpk(P1[14], P1[15])}; \
            _Pragma("unroll") for (int ks = 0; ks < 4; ++ks) { \
                const s16x4 l0 = vtr(Vp_ + ks * 1024), h0 = vtr(Vp_ + ks * 1024 + 512), l1 = vtr(Vp_ + 4096 + ks * 1024), h1 = vtr(Vp_ + 4096 + ks * 1024 + 512); \
                const bf16x8 b0 = (bf16x8){l0[0], l0[1], l0[2], l0[3], h0[0], h0[1], h0[2], h0[3]}; const bf16x8 b1 = (bf16x8){l1[0], l1[1], l1[2], l1[3], h1[0], h1[1], h1[2], h1[3]}; \
                o0 = __builtin_amdgcn_mfma_f32_32x32x16_bf16(__builtin_bit_cast(bf16x8, pw[ks]), b0, o0, 0, 0, 0); \
                o1 = __builtin_amdgcn_mfma_f32_32x32x16_bf16(__builtin_bit_cast(bf16x8, pw[ks]), b1, o1, 0, 0, 0); } } while (0)
        __syncthreads();
        P2_DMA(0, 0);
        P2_WAITBAR();
        int s = 0;
        P2_STEP(pa0, pa1, pb0, pb1, false, 0);
        for (s = 1; s + 1 < nsteps; s += 2) {
            P2_STEP(pb0, pb1, pa0, pa1, true, s);
            P2_STEP(pa0, pa1, pb0, pb1, true, s + 1);
        }
        u32x4 gvp[2];
#define P2_GVLOAD() do { _Pragma("unroll") for (int j = 0; j < 2; ++j) { const int chunk = tid + 512 * j, row = chunk >> 3, dc = chunk & 7; \
            gvp[j] = *(const u32x4*)(P + (size_t)(q0 + row) * NP + C_GA + h * 64 + dc * 8); } } while (0)
        if (s < nsteps) { P2_STEP(pb0, pb1, pa0, pa1, true, s); P2_GVLOAD(); P2_DRAIN(pb0, pb1); }
        else { P2_GVLOAD(); P2_DRAIN(pa0, pa1); }
#undef P2_GVLOAD
#undef ROT
#undef P2_DMA
#undef P2_DMA1
#undef P2_MASK
#undef P2_STEP
#undef PIN
#undef KFR
#undef VFRD
#undef P2_DRAIN
        lsum += shx(lsum, 32, lane);
        LAS3 float* Ocomb = (LAS3 float*)(lds + OFF_OCOMB) + w * 2048;
        LAS3 float* lcomb = (LAS3 float*)(lds + OFF_LCOMB) + w * 32;
        LAS3 float* wsf = (LAS3 float*)(lds + OFF_WSF) + w * 32;
        LAS3 bf16_t* Ost = (LAS3 bf16_t*)(lds + OFF_OST);
        __syncthreads();
        if (grp == 1) {
#pragma unroll
            for (int r = 0; r < 16; ++r) { Ocomb[r * 64 + lane] = o0[r]; Ocomb[1024 + r * 64 + lane] = o1[r]; }
            if (hi == 0) lcomb[r32] = lsum;
        }
        __syncthreads();
        if (grp == 0) {
#pragma unroll
            for (int r = 0; r < 16; ++r) { o0[r] += Ocomb[r * 64 + lane]; o1[r] += Ocomb[1024 + r * 64 + lane]; }
            lsum += lcomb[r32];
            if (hi == 0) wsf[r32] = lsum;
            __builtin_amdgcn_s_waitcnt(0xC07F);
#pragma unroll
            for (int r = 0; r < 16; ++r) {
                const int orow = crow(r, hi); const float rl = 1.0f / wsf[orow];
                Ost[(32 * w + orow) * 64 + r32] = (bf16_t)f2bf(o0[r] * rl);
                Ost[(32 * w + orow) * 64 + 32 + r32] = (bf16_t)f2bf(o1[r] * rl);
            }
        }
        __syncthreads();
#pragma unroll
        for (int j = 0; j < 2; ++j) {
            const int chunk = tid + 512 * j, row = chunk >> 3, dc = chunk & 7;
            const u32x4 ov = *(const LAS3 u32x4*)(Ost + row * 64 + dc * 8);
            bf16_t* gp = P + (size_t)(q0 + row) * NP + C_GA + h * 64 + dc * 8;
            const u32x4 gv = gvp[j];
            u32x4 y;
            y.x = pk2(lo16(ov.x) * silu(lo16(gv.x)), hi16(ov.x) * silu(hi16(gv.x)));
            y.y = pk2(lo16(ov.y) * silu(lo16(gv.y)), hi16(ov.y) * silu(hi16(gv.y)));
            y.z = pk2(lo16(ov.z) * silu(lo16(gv.z)), hi16(ov.z) * silu(hi16(gv.z)));
            y.w = pk2(lo16(ov.w) * silu(lo16(gv.w)), hi16(ov.w) * silu(hi16(gv.w)));
            *(u32x4*)gp = y;
        }
    }
}
#undef SBAR
#undef PEL
}

namespace moba {
using mla::bf16x8; using mla::s16x4; using mla::f32x16; using mla::u32x4; using mla::crow; using mla::vtr; using mla::cvtpk;
constexpr int KV_BYTES = 65536, OST_PITCH = 72, OFF_MOST = KV_BYTES, OFF_MDST = OFF_MOST + 256 * OST_PITCH * 2, OFF_MLT = OFF_MDST + 1024, OFF_MPRE = OFF_MLT + 1024, MOBA_LDS_END = OFF_MPRE + 1040;
static_assert(MOBA_LDS_END <= LDS_BYTES - 64, "moba lds");
template <bool OWN>
__device__ __forceinline__ void block_item(const Ctx& cx, const Params& p, int l, LAS3 unsigned char* lds, float c2, int h, int n, const int* lst, int cnt, int cstart, bool restage,
                                           bool have_pf, int& pf_entry, int& pf_valid, bf16x8& pq0, bf16x8& pq1, bf16x8& pq2, bf16x8& pq3, bool has_next, int nx_h, const int* nx_lst, int nx_cnt, int nx_cstart,
                                           bool have_kv, bool nx_restage, int nx_n, u32x4& kpf0, u32x4& kpf1, u32x4& kpf2, u32x4& kpf3, u32x4& vpf0, u32x4& vpf1, u32x4& vpf2, u32x4& vpf3, bool own_pf = false) {
    bf16_t* P = (bf16_t*)(p.ws + OFF_P);
    bf16_t* part = (bf16_t*)(p.ws + OFF_PART); float* lpart = (float*)(p.ws + OFF_LPART);
    const int tid = cx.tid, lane = tid & 63, r32 = lane & 31, hi = lane >> 5;
    const int w = __builtin_amdgcn_readfirstlane(tid >> 6);
    __syncthreads();
    const int qt = (OWN && w >= 4) ? 11 - w : w;
    const int rr = 32 * qt + r32;
    int entry = 0; bool valid = true;
    if (!OWN) { if (have_pf) { entry = pf_entry; valid = pf_valid != 0; } else { const int e = cstart + rr; valid = e < cnt; entry = lst[valid ? e : cstart]; } }
    u32x4 kr[4], vr[4];
    if (restage && have_kv) { kr[0] = kpf0; kr[1] = kpf1; kr[2] = kpf2; kr[3] = kpf3; vr[0] = vpf0; vr[1] = vpf1; vr[2] = vpf2; vr[3] = vpf3; }
    else if (restage) {
        const bf16_t* kb = P + (size_t)n * 256 * NP + C_MK + h * 64; const bf16_t* vb = P + (size_t)n * 256 * NP + C_MV + h * 64;
#pragma unroll
        for (int j = 0; j < 4; ++j) { const int idx = tid + 512 * j, tile = idx >> 9, c = (idx & 511) >> 6, key = idx & 63; kr[j] = *(const u32x4*)(kb + (size_t)(tile * 64 + key) * NP + c * 8); }
#pragma unroll
        for (int j = 0; j < 4; ++j) { const int key = tid >> 3, dc = tid & 7; vr[j] = *(const u32x4*)(vb + (size_t)(j * 64 + key) * NP + dc * 8); }
    }
    const int srow = OWN ? n * 256 + rr : (entry >> 2);
    bf16x8 qr[4];
    if (!OWN && have_pf) {
        qr[0] = pq0; qr[1] = pq1; qr[2] = pq2; qr[3] = pq3;
    } else if (OWN && own_pf) {
#pragma unroll
        for (int d0 = 0; d0 < 4; ++d0) qr[d0] = *(const LAS3 bf16x8*)(lds + OFF_MOST + tid * 64 + d0 * 16);
    } else {
#pragma unroll
        for (int d0 = 0; d0 < 4; ++d0) qr[d0] = *(const bf16x8*)(P + (size_t)srow * NP + C_MQ + h * 64 + d0 * 16 + hi * 8);
    }
    int nentry = 0; bool nvalid = false;
    if (!OWN && has_next) { const int e = nx_cstart + rr; nvalid = e < nx_cnt; nentry = nx_lst[nvalid ? e : nx_cstart]; }
    if (restage) {
#pragma unroll
        for (int j = 0; j < 4; ++j) { const int idx = tid + 512 * j, tile = idx >> 9, c = (idx & 511) >> 6, key = idx & 63; *(LAS3 u32x4*)(lds + tile * 8192 + c * 1024 + key * 16) = kr[j]; }
#pragma unroll
        for (int j = 0; j < 4; ++j) { const int key = tid >> 3, dc = tid & 7; *(LAS3 u32x4*)(lds + 32768 + j * 8192 + (dc >> 2) * 4096 + (key >> 4) * 1024 + (key & 15) * 64 + (dc & 3) * 16) = vr[j]; }
    }
    u32x4 pvv[4][3]; float lpp[4][3]; u32x4 gvv[4];
    if (OWN) {
        const int nsel = n < 3 ? n : 3;
#pragma unroll
        for (int k = 0; k < 4; ++k) { const int chunk = tid + 512 * k, row = chunk >> 3, dc = chunk & 7, sq = n * 256 + row; const size_t pb = ((size_t)h * S + sq) * 3;
#pragma unroll
            for (int j = 0; j < 3; ++j) { if (j < nsel) { lpp[k][j] = lpart[pb + j]; pvv[k][j] = *(const u32x4*)(part + (pb + j) * 64 + dc * 8); } else { lpp[k][j] = 0.f; pvv[k][j] = (u32x4){0u, 0u, 0u, 0u}; } }
            gvv[k] = *(const u32x4*)(P + (size_t)sq * NP + C_GD + h * 64 + dc * 8); }
    }
    f32x16 o0, o1;
#pragma unroll
    for (int r = 0; r < 16; ++r) { o0[r] = 0.f; o1[r] = 0.f; }
    float lsum = 0.f;
    const int kfrag = hi * 1024 + r32 * 16;
    const int vfrag = ((lane >> 4) & 1) * 32 + (lane & 3) * 8 + (4 * hi + ((lane & 15) >> 2)) * 64;
    const int tmax = OWN ? (qt >> 1) : 3;
    const bool wave_live = OWN || (cstart + 32 * w < cnt);
    __syncthreads();
#pragma unroll 1
    for (int t = 0; t <= tmax; ++t) {
        if (!OWN && has_next && t == 1) {
            const bf16_t* nq = P + (size_t)(nentry >> 2) * NP + C_MQ + nx_h * 64 + hi * 8;
            pq0 = *(const bf16x8*)nq; pq1 = *(const bf16x8*)(nq + 16); pq2 = *(const bf16x8*)(nq + 32); pq3 = *(const bf16x8*)(nq + 48);
            if (nx_restage) {
                const bf16_t* kb = P + (size_t)nx_n * 256 * NP + C_MK + nx_h * 64; const bf16_t* vb = P + (size_t)nx_n * 256 * NP + C_MV + nx_h * 64;
                const int key = tid >> 3, dc = tid & 7;
#define MB_KADDR(j) (kb + (size_t)((((tid + 512 * (j)) >> 9) * 64) + ((tid + 512 * (j)) & 63)) * NP + (((tid + 512 * (j)) & 511) >> 6) * 8)
                kpf0 = *(const u32x4*)MB_KADDR(0); kpf1 = *(const u32x4*)MB_KADDR(1); kpf2 = *(const u32x4*)MB_KADDR(2); kpf3 = *(const u32x4*)MB_KADDR(3);
#undef MB_KADDR
                vpf0 = *(const u32x4*)(vb + (size_t)(0 * 64 + key) * NP + dc * 8); vpf1 = *(const u32x4*)(vb + (size_t)(1 * 64 + key) * NP + dc * 8);
                vpf2 = *(const u32x4*)(vb + (size_t)(2 * 64 + key) * NP + dc * 8); vpf3 = *(const u32x4*)(vb + (size_t)(3 * 64 + key) * NP + dc * 8);
            }
        }
        if (wave_live) {
        const LAS3 unsigned char* Kt = lds + t * 8192; const LAS3 unsigned char* Vt = lds + 32768 + t * 8192;
        f32x16 p0, p1;
#pragma unroll
        for (int r = 0; r < 16; ++r) { p0[r] = -c2; p1[r] = -c2; }
#pragma unroll
        for (int d0 = 0; d0 < 4; ++d0) {
            const bf16x8 a0 = *(const LAS3 bf16x8*)(Kt + kfrag + d0 * 2048);
            const bf16x8 a1 = *(const LAS3 bf16x8*)(Kt + kfrag + d0 * 2048 + 512);
            p0 = __builtin_amdgcn_mfma_f32_32x32x16_bf16(a0, qr[d0], p0, 0, 0, 0);
            p1 = __builtin_amdgcn_mfma_f32_32x32x16_bf16(a1, qr[d0], p1, 0, 0, 0);
        }
        if (OWN && t == tmax) {
            const int kbase = t * 64 + 4 * hi;
#pragma unroll
            for (int r = 0; r < 16; ++r) { const int kv = kbase + (r & 3) + 8 * (r >> 2); if (kv > rr) p0[r] = -INFINITY; if (kv + 32 > rr) p1[r] = -INFINITY; }
        }
        float sacc = 0.f;
#pragma unroll
        for (int r = 0; r < 16; ++r) { p0[r] = __builtin_amdgcn_exp2f(p0[r]); p1[r] = __builtin_amdgcn_exp2f(p1[r]); sacc += p0[r] + p1[r]; }
        lsum += sacc;
        u32x4 pw[4];
        pw[0] = (u32x4){cvtpk(p0[0], p0[1]), cvtpk(p0[2], p0[3]), cvtpk(p0[4], p0[5]), cvtpk(p0[6], p0[7])};
        pw[1] = (u32x4){cvtpk(p0[8], p0[9]), cvtpk(p0[10], p0[11]), cvtpk(p0[12], p0[13]), cvtpk(p0[14], p0[15])};
        pw[2] = (u32x4){cvtpk(p1[0], p1[1]), cvtpk(p1[2], p1[3]), cvtpk(p1[4], p1[5]), cvtpk(p1[6], p1[7])};
        pw[3] = (u32x4){cvtpk(p1[8], p1[9]), cvtpk(p1[10], p1[11]), cvtpk(p1[12], p1[13]), cvtpk(p1[14], p1[15])};
#pragma unroll
        for (int ks = 0; ks < 4; ++ks) {
            const s16x4 l0 = vtr(Vt + vfrag + ks * 1024), h0 = vtr(Vt + vfrag + ks * 1024 + 512);
            const s16x4 l1 = vtr(Vt + vfrag + 4096 + ks * 1024), h1 = vtr(Vt + vfrag + 4096 + ks * 1024 + 512);
            const bf16x8 b0 = (bf16x8){l0[0], l0[1], l0[2], l0[3], h0[0], h0[1], h0[2], h0[3]};
            const bf16x8 b1 = (bf16x8){l1[0], l1[1], l1[2], l1[3], h1[0], h1[1], h1[2], h1[3]};
            const bf16x8 pa = __builtin_bit_cast(bf16x8, pw[ks]);
            o0 = __builtin_amdgcn_mfma_f32_32x32x16_bf16(pa, b0, o0, 0, 0, 0);
            o1 = __builtin_amdgcn_mfma_f32_32x32x16_bf16(pa, b1, o1, 0, 0, 0);
        }
        }
    }
    if (!OWN) { pf_entry = nentry; pf_valid = nvalid ? 1 : 0; }
    lsum += shx(lsum, 32, lane);
    LAS3 bf16_t* Ost = (LAS3 bf16_t*)(lds + OFF_MOST); LAS3 int* dstT = (LAS3 int*)(lds + OFF_MDST); LAS3 float* lT = (LAS3 float*)(lds + OFF_MLT);
#pragma unroll
    for (int r = 0; r < 16; ++r) { const int q = 32 * qt + crow(r, hi); Ost[q * OST_PITCH + r32] = (bf16_t)f2bf(o0[r]); Ost[q * OST_PITCH + 32 + r32] = (bf16_t)f2bf(o1[r]); }
    if (hi == 0) { lT[rr] = lsum; if (!OWN) dstT[rr] = valid ? (h * S + (entry >> 2)) * 3 + (entry & 3) : -1; }
    __syncthreads();
#pragma unroll
    for (int k = 0; k < 4; ++k) {
        const int chunk = tid + 512 * k, row = chunk >> 3, dc = chunk & 7;
        const u32x4 ov = *(const LAS3 u32x4*)(Ost + row * OST_PITCH + dc * 8);
        if (!OWN) {
            const int d = dstT[row];
            if (d >= 0) { *(u32x4*)(part + (size_t)d * 64 + dc * 8) = ov; if (dc == 0) lpart[d] = lT[row]; }
        } else {
            const int sq = n * 256 + row;
            float lt = lT[row];
            float a[8] = {lo16(ov[0]), hi16(ov[0]), lo16(ov[1]), hi16(ov[1]), lo16(ov[2]), hi16(ov[2]), lo16(ov[3]), hi16(ov[3])};
#pragma unroll
            for (int j = 0; j < 3; ++j) {
                lt += lpp[k][j];
                const u32x4 pv = pvv[k][j];
                a[0] += lo16(pv[0]); a[1] += hi16(pv[0]); a[2] += lo16(pv[1]); a[3] += hi16(pv[1]); a[4] += lo16(pv[2]); a[5] += hi16(pv[2]); a[6] += lo16(pv[3]); a[7] += hi16(pv[3]);
            }
            const float rl = 1.0f / lt;
            bf16_t* gp = P + (size_t)sq * NP + C_GD + h * 64 + dc * 8;
            const u32x4 gv = gvv[k];
            u32x4 y;
            y[0] = pk2(a[0] * rl * silu(lo16(gv[0])), a[1] * rl * silu(hi16(gv[0])));
            y[1] = pk2(a[2] * rl * silu(lo16(gv[1])), a[3] * rl * silu(hi16(gv[1])));
            y[2] = pk2(a[4] * rl * silu(lo16(gv[2])), a[5] * rl * silu(hi16(gv[2])));
            y[3] = pk2(a[6] * rl * silu(lo16(gv[3])), a[7] * rl * silu(hi16(gv[3])));
            *(u32x4*)gp = y;
        }
    }
}
__device__ __forceinline__ float c2_bound(const Params& p, int l) {
    float gq = 0.f, gk = 0.f;
    for (int d = 0; d < 64; ++d) { gq = fmaxf(gq, fabsf(p.mq_g[l * 64 + d])); gk = fmaxf(gk, fabsf(p.mk_g[l * 64 + d])); }
    return gq * gk * 8.0f * LOG2E * 1.02f;
}
__device__ __forceinline__ void own_prefetch(const Ctx& cx, const Params& p, LAS3 unsigned char* lds);
__device__ __forceinline__ void gather_items(const Ctx& cx, const Params& p, int l, unsigned char* lds_generic) {
    LAS3 unsigned char* lds = (LAS3 unsigned char*)lds_generic;
    const int* mcnt = (const int*)(p.ws + OFF_MCNT); const int* mlist = (const int*)(p.ws + OFF_LIST);
    LAS3 int* pre = (LAS3 int*)(lds + OFF_MPRE);
    const float c2 = ((const float*)(p.ws + OFF_C2))[l * 2 + 1];
    __syncthreads();
    {
        const int tid_ = cx.tid, lane_ = tid_ & 63;
        const int cnt_ = tid_ < 256 ? (mcnt[tid_] + 255) >> 8 : 0;
        int inc = cnt_;
#pragma unroll
        for (int o = 1; o < 64; o <<= 1) { const int t_ = __builtin_amdgcn_ds_bpermute(((lane_ - o) & 63) << 2, inc); if (lane_ >= o) inc += t_; }
        LAS3 int* wt = (LAS3 int*)(lds + OFF_MLT);
        if (lane_ == 63 && tid_ < 256) wt[tid_ >> 6] = inc;
        __syncthreads();
        int base = 0;
#pragma unroll
        for (int w_ = 0; w_ < 3; ++w_) if (w_ < (tid_ >> 6)) base += wt[w_];
        if (tid_ < 256) pre[tid_] = base + inc - cnt_;
        if (tid_ == 255) pre[256] = base + inc;
    }
    __syncthreads();
    const int total = pre[256];
    unsigned* gctr = (unsigned*)(p.ws + OFF_GCTR) + l * 16;
    LAS3 int* slot = (LAS3 int*)(lds + OFF_MPRE) + 258;
    int staged = -1;
    int pf_entry = 0, pf_valid = 0; bf16x8 pq0 = (bf16x8){0, 0, 0, 0, 0, 0, 0, 0}, pq1 = pq0, pq2 = pq0, pq3 = pq0;
    u32x4 kpf0 = (u32x4){0u, 0u, 0u, 0u}, kpf1 = kpf0, kpf2 = kpf0, kpf3 = kpf0, vpf0 = kpf0, vpf1 = kpf0, vpf2 = kpf0, vpf3 = kpf0;
    bool have_pf = false, have_kv = false;
    int c = 2 * cx.bid, cn = 2 * cx.bid + 1;
    while (c < total) {
        int pulled = 0;
        if (cx.tid == 0) pulled = (int)atomicAdd(gctr, 1u);
        int pair, npair;
        { int lo = 0, hi_ = 255; while (lo < hi_) { const int mid = (lo + hi_ + 1) >> 1; if (pre[mid] <= c) lo = mid; else hi_ = mid - 1; } pair = lo; }
        const bool has_next = cn < total;
        npair = pair;
        if (has_next) { int lo = 0, hi_ = 255; while (lo < hi_) { const int mid = (lo + hi_ + 1) >> 1; if (pre[mid] <= cn) lo = mid; else hi_ = mid - 1; } npair = lo; }
        const int h = pair >> 6, n = pair & 63, cstart = (c - pre[pair]) * 256;
        const int nh = npair >> 6, nn = npair & 63, ncstart = (cn - pre[npair]) * 256;
        block_item<false>(cx, p, l, lds, c2, h, n, mlist + (size_t)h * LIST_PER_HEAD + 256 * (63 * n - n * (n - 1) / 2), mcnt[pair], cstart, pair != staged,
                          have_pf, pf_entry, pf_valid, pq0, pq1, pq2, pq3, has_next, nh, mlist + (size_t)nh * LIST_PER_HEAD + 256 * (63 * nn - nn * (nn - 1) / 2), has_next ? mcnt[npair] : 0, ncstart,
                          have_kv, has_next && npair != pair, nn, kpf0, kpf1, kpf2, kpf3, vpf0, vpf1, vpf2, vpf3);
        staged = pair; have_pf = has_next; have_kv = has_next && npair != pair;
        if (cx.tid == 0) *slot = pulled;
        __syncthreads();
        c = cn; cn = 2 * cx.nb + *slot;
    }
    if (cx.bid < 256) own_prefetch(cx, p, lds);
}
__device__ __forceinline__ void own_prefetch(const Ctx& cx, const Params& p, LAS3 unsigned char* lds) {
    const bf16_t* P = (const bf16_t*)(p.ws + OFF_P);
    const int tid = cx.tid, lane = tid & 63, r32 = lane & 31, hi = lane >> 5;
    const int w = __builtin_amdgcn_readfirstlane(tid >> 6), qt = w >= 4 ? 11 - w : w;
    const int h = cx.bid >> 6, n = cx.bid & 63;
    const bf16_t* kb = P + (size_t)n * 256 * NP + C_MK + h * 64; const bf16_t* vb = P + (size_t)n * 256 * NP + C_MV + h * 64;
    u32x4 kr[4], vr[4]; bf16x8 qr[4];
#pragma unroll
    for (int j = 0; j < 4; ++j) { const int idx = tid + 512 * j, tile = idx >> 9, c = (idx & 511) >> 6, key = idx & 63; kr[j] = *(const u32x4*)(kb + (size_t)(tile * 64 + key) * NP + c * 8); }
#pragma unroll
    for (int j = 0; j < 4; ++j) { const int key = tid >> 3, dc = tid & 7; vr[j] = *(const u32x4*)(vb + (size_t)(j * 64 + key) * NP + dc * 8); }
#pragma unroll
    for (int d0 = 0; d0 < 4; ++d0) qr[d0] = *(const bf16x8*)(P + (size_t)(n * 256 + 32 * qt + r32) * NP + C_MQ + h * 64 + d0 * 16 + hi * 8);
#pragma unroll
    for (int j = 0; j < 4; ++j) { const int idx = tid + 512 * j, tile = idx >> 9, c = (idx & 511) >> 6, key = idx & 63; *(LAS3 u32x4*)(lds + tile * 8192 + c * 1024 + key * 16) = kr[j]; }
#pragma unroll
    for (int j = 0; j < 4; ++j) { const int key = tid >> 3, dc = tid & 7; *(LAS3 u32x4*)(lds + 32768 + j * 8192 + (dc >> 2) * 4096 + (key >> 4) * 1024 + (key & 15) * 64 + (dc & 3) * 16) = vr[j]; }
#pragma unroll
    for (int d0 = 0; d0 < 4; ++d0) *(LAS3 bf16x8*)(lds + OFF_MOST + tid * 64 + d0 * 16) = qr[d0];
}
__device__ __forceinline__ void own_items(const Ctx& cx, const Params& p, int l, unsigned char* lds_generic) {
    LAS3 unsigned char* lds = (LAS3 unsigned char*)lds_generic;
    const float c2 = ((const float*)(p.ws + OFF_C2))[l * 2 + 1];
    for (int it = cx.bid; it < 256; it += cx.nb) { const bool pf = (it == cx.bid);
        int e_ = 0, v_ = 0; bf16x8 z0 = (bf16x8){0, 0, 0, 0, 0, 0, 0, 0}, z1 = z0, z2 = z0, z3 = z0; u32x4 k0_ = (u32x4){0u, 0u, 0u, 0u}, k1_ = k0_, k2_ = k0_, k3_ = k0_, v0_ = k0_, v1_ = k0_, v2_ = k0_, v3_ = k0_;
        block_item<true>(cx, p, l, lds, c2, it >> 6, it & 63, nullptr, 0, 0, !pf, false, e_, v_, z0, z1, z2, z3, false, 0, nullptr, 0, 0, false, false, 0, k0_, k1_, k2_, k3_, v0_, v1_, v2_, v3_, pf); }
}
}

namespace post {
using mla::bf16x8; using mla::s16x4; using mla::f32x16; using mla::u32x4; using mla::crow; using mla::vtr; using mla::cvtpk;
typedef unsigned u32x2 __attribute__((ext_vector_type(2)));
typedef float f32x4 __attribute__((ext_vector_type(4)));
__device__ __forceinline__ float sumsq8(const bf16x8& b) { float a = 0.f;
#pragma unroll
    for (int j = 0; j < 8; ++j) { const float v = bf2f((bf16_t)b[j]); a = fmaf(v, v, a); } return a; }

__device__ __forceinline__ void mla_up(const Ctx& cx, const Params& p, int l, unsigned char* lds_generic) {
    unsigned char* ws = p.ws;
    const bf16_t* P = (const bf16_t*)(ws + OFF_P);
    const bf16_t* WuqF = (const bf16_t*)(ws + OFF_WUQF) + (size_t)l * 384 * 256;
    const bf16_t* WukvF = (const bf16_t*)(ws + OFF_WUKVF) + (size_t)l * 512 * 128;
    bf16_t* Qa = (bf16_t*)(ws + OFF_QA); bf16_t* Ka = (bf16_t*)(ws + OFF_KA); bf16_t* Va = (bf16_t*)(ws + OFF_VA);
    const float* cosA = (const float*)(ws + OFF_COSA); const float* sinA = (const float*)(ws + OFF_SINA);
    const int tid = cx.tid, lane = tid & 63, r32 = lane & 31, hi = lane >> 5;
    const int w = __builtin_amdgcn_readfirstlane(tid >> 6), th = w >> 2, h = w & 3;
    LAS3 float* gl = (LAS3 float*)(LAS3 unsigned char*)lds_generic;
    __syncthreads();
    if (tid < 192) gl[tid] = tid < 96 ? p.q_g[l * 96 + tid] : tid < 160 ? p.kn_g[l * 64 + tid - 96] : p.kr_g[l * 32 + tid - 160];
    __syncthreads();
    for (int it = cx.bid; it < S / 64; it += cx.nb) {
        const int tok = it * 64 + th * 32 + r32;
        const bf16_t* prow = P + (size_t)tok * NP;
        asm volatile("" : "+v"(prow));
        bf16x8 bq[16];
#pragma unroll
        for (int ks = 0; ks < 16; ++ks) bq[ks] = *(const bf16x8*)(prow + C_CQ + ks * 16 + hi * 8);
        const char* wq0 = (const char*)WuqF + ((size_t)h * 3 * 16 * 64 + hi * 32 + r32) * 16;
        asm volatile("" : "+v"(wq0));
        bf16x8 wq[4][3];
#pragma unroll
        for (int ks = 0; ks < 4; ++ks)
#pragma unroll
            for (int nt = 0; nt < 3; ++nt) wq[ks][nt] = *(const bf16x8*)(wq0 + (nt * 16 + ks) * 1024);
        const char* wqn0 = wq0 + 4096; const char* wqn1 = wq0 + 16384 + 4096; const char* wqn2 = wq0 + 32768 + 4096;
        const f32x4 csA0 = *(const f32x4*)(cosA + tok * 16 + 4 * hi), csA1 = *(const f32x4*)(cosA + tok * 16 + 8 + 4 * hi), snA0 = *(const f32x4*)(sinA + tok * 16 + 4 * hi), snA1 = *(const f32x4*)(sinA + tok * 16 + 8 + 4 * hi);
        bf16x8 bkv[8]; bf16x8 wk[4][4];
        {
            f32x16 c[3];
#pragma unroll
            for (int nt = 0; nt < 3; ++nt)
#pragma unroll
                for (int r = 0; r < 16; ++r) c[nt][r] = 0.f;
            float ssq = 0.f;
#pragma unroll
            for (int ks = 0; ks < 16; ++ks) {
                ssq += sumsq8(bq[ks]);
#pragma unroll
                for (int nt = 0; nt < 3; ++nt) c[nt] = __builtin_amdgcn_mfma_f32_32x32x16_bf16(wq[ks & 3][nt], bq[ks], c[nt], 0, 0, 0);
                if (ks + 4 < 16) {
                    asm volatile("" : "+v"(wqn0), "+v"(wqn1), "+v"(wqn2));
                    wq[ks & 3][0] = *(const bf16x8*)wqn0; wq[ks & 3][1] = *(const bf16x8*)wqn1; wq[ks & 3][2] = *(const bf16x8*)wqn2;
                    wqn0 += 1024; wqn1 += 1024; wqn2 += 1024;
                }
                __builtin_amdgcn_sched_barrier(0);
            }
            ssq += shx(ssq, 32, lane);
            const float rq = 1.0f / sqrtf(ssq * (1.f / 256.f) + EPS);
            float s2 = 0.f;
#pragma unroll
            for (int nt = 0; nt < 3; ++nt)
#pragma unroll
                for (int r = 0; r < 16; ++r) { c[nt][r] *= rq; s2 = fmaf(c[nt][r], c[nt][r], s2); }
            s2 += shx(s2, 32, lane);
            const float rh = 1.0f / sqrtf(s2 * (1.f / 96.f) + EPS);
#pragma unroll
            for (int nt = 0; nt < 3; ++nt)
#pragma unroll
                for (int q4 = 0; q4 < 4; ++q4) { const f32x4 gq = *(const LAS3 f32x4*)(gl + 32 * nt + 8 * q4 + 4 * hi);
#pragma unroll
                    for (int i = 0; i < 4; ++i) c[nt][4 * q4 + i] *= rh * gq[i]; }
#pragma unroll
            for (int r = 0; r < 8; ++r) {
                const float cs = r < 4 ? csA0[r & 3] : csA1[r & 3], sn = r < 4 ? snA0[r & 3] : snA1[r & 3];
                const float a = c[2][r], b = c[2][r + 8];
                c[2][r] = a * cs - b * sn; c[2][r + 8] = b * cs + a * sn;
            }
            bf16_t* qo = Qa + ((size_t)h * S + tok) * 96;
#pragma unroll
            for (int nt = 0; nt < 3; ++nt)
#pragma unroll
                for (int g4 = 0; g4 < 4; ++g4) {
                    u32x2 o; o.x = cvtpk(c[nt][4 * g4] * QSCALE_A, c[nt][4 * g4 + 1] * QSCALE_A); o.y = cvtpk(c[nt][4 * g4 + 2] * QSCALE_A, c[nt][4 * g4 + 3] * QSCALE_A);
                    *(u32x2*)(qo + 32 * nt + 8 * g4 + 4 * hi) = o;
                }
        }
        {
#pragma unroll
            for (int ks = 0; ks < 8; ++ks) bkv[ks] = *(const bf16x8*)(prow + C_CKV + ks * 16 + hi * 8);
            const char* wk0 = (const char*)WukvF + ((size_t)h * 4 * 8 * 64 + hi * 32 + r32) * 16;
            asm volatile("" : "+v"(wk0));
#pragma unroll
            for (int ks = 0; ks < 4; ++ks)
#pragma unroll
                for (int nt = 0; nt < 4; ++nt) wk[ks][nt] = *(const bf16x8*)(wk0 + (nt * 8 + ks) * 1024);
            const char* wkn0 = wk0 + 4096; const char* wkn1 = wk0 + 8192 + 4096; const char* wkn2 = wk0 + 16384 + 4096; const char* wkn3 = wk0 + 24576 + 4096;
            f32x16 c[4];
#pragma unroll
            for (int nt = 0; nt < 4; ++nt)
#pragma unroll
                for (int r = 0; r < 16; ++r) c[nt][r] = 0.f;
            float ssq = 0.f;
#pragma unroll
            for (int ks = 0; ks < 8; ++ks) {
                ssq += sumsq8(bkv[ks]);
#pragma unroll
                for (int nt = 0; nt < 4; ++nt) c[nt] = __builtin_amdgcn_mfma_f32_32x32x16_bf16(wk[ks & 3][nt], bkv[ks], c[nt], 0, 0, 0);
                if (ks + 4 < 8) {
                    asm volatile("" : "+v"(wkn0), "+v"(wkn1), "+v"(wkn2), "+v"(wkn3));
                    wk[ks & 3][0] = *(const bf16x8*)wkn0; wk[ks & 3][1] = *(const bf16x8*)wkn1; wk[ks & 3][2] = *(const bf16x8*)wkn2; wk[ks & 3][3] = *(const bf16x8*)wkn3;
                    wkn0 += 1024; wkn1 += 1024; wkn2 += 1024; wkn3 += 1024;
                }
                __builtin_amdgcn_sched_barrier(0);
            }
            ssq += shx(ssq, 32, lane);
            const float rkv = 1.0f / sqrtf(ssq * (1.f / 128.f) + EPS);
            float s2 = 0.f;
#pragma unroll
            for (int nt = 0; nt < 4; ++nt)
#pragma unroll
                for (int r = 0; r < 16; ++r) { c[nt][r] *= rkv; if (nt < 2) s2 = fmaf(c[nt][r], c[nt][r], s2); }
            s2 += shx(s2, 32, lane);
            const float rk = 1.0f / sqrtf(s2 * (1.f / 64.f) + EPS);
            bf16_t* ko = Ka + ((size_t)h * (S / 64) + (tok >> 6)) * 6144 + (tok & 63) * 8; bf16_t* vo = Va + ((size_t)h * (S / 64) + (tok >> 6)) * 4096 + ((tok & 63) >> 4) * 512 + (tok & 15) * 32;
#pragma unroll
            for (int nt = 0; nt < 2; ++nt)
#pragma unroll
                for (int g4 = 0; g4 < 4; ++g4) {
                    const int d = 32 * nt + 8 * g4 + 4 * hi;
                    const f32x4 gk = *(const LAS3 f32x4*)(gl + 96 + d);
                    u32x2 o; o.x = cvtpk(c[nt][4 * g4] * rk * gk[0], c[nt][4 * g4 + 1] * rk * gk[1]); o.y = cvtpk(c[nt][4 * g4 + 2] * rk * gk[2], c[nt][4 * g4 + 3] * rk * gk[3]);
                    *(u32x2*)(ko + (d >> 3) * 512 + (d & 7)) = o;
                    u32x2 v; v.x = cvtpk(c[nt + 2][4 * g4], c[nt + 2][4 * g4 + 1]); v.y = cvtpk(c[nt + 2][4 * g4 + 2], c[nt + 2][4 * g4 + 3]);
                    *(u32x2*)(vo + (d >> 5) * 2048 + (d & 31)) = v;
                }
        }
        if (h == 0) {
            const bf16x8 x1 = *(const bf16x8*)(prow + C_KR + 8 * hi), x2 = *(const bf16x8*)(prow + C_KR + 16 + 8 * hi);
            float ssq = sumsq8(x1) + sumsq8(x2);
            ssq += shx(ssq, 32, lane);
            const float rr = 1.0f / sqrtf(ssq * (1.f / 32.f) + EPS);
            float o1[8], o2[8];
#pragma unroll
            for (int j = 0; j < 8; ++j) {
                const int i = 8 * hi + j; const float cs = cosA[tok * 16 + i], sn = sinA[tok * 16 + i];
                const float a = bf2f((bf16_t)x1[j]) * rr * gl[160 + i], b = bf2f((bf16_t)x2[j]) * rr * gl[160 + 16 + i];
                o1[j] = a * cs - b * sn; o2[j] = b * cs + a * sn;
            }
            const u32x4 w1 = (u32x4){cvtpk(o1[0], o1[1]), cvtpk(o1[2], o1[3]), cvtpk(o1[4], o1[5]), cvtpk(o1[6], o1[7])};
            const u32x4 w2 = (u32x4){cvtpk(o2[0], o2[1]), cvtpk(o2[2], o2[3]), cvtpk(o2[4], o2[5]), cvtpk(o2[6], o2[7])};
#pragma unroll
            for (int hh = 0; hh < 4; ++hh) { bf16_t* ko = Ka + ((size_t)hh * (S / 64) + (tok >> 6)) * 6144 + (tok & 63) * 8; *(u32x4*)(ko + (8 + hi) * 512) = w1; *(u32x4*)(ko + (10 + hi) * 512) = w2; }
        }
    }
}

__device__ __forceinline__ void conv(const Ctx& cx, const Params& p, int l) {
    bf16_t* P = (bf16_t*)(p.ws + OFF_P);
    const float* cw = p.conv_w + l * 3 * 256;
    const int gtid = cx.bid * NT + cx.tid, GT = cx.nb * NT;
    for (int i = gtid; i < (S / 4) * 32; i += GT) {
        const int c8 = (i & 31) * 8, t0 = (i >> 5) * 4;
        float w0[8], w1[8], w2[8];
#pragma unroll
        for (int j = 0; j < 8; ++j) { w0[j] = cw[c8 + j]; w1[j] = cw[256 + c8 + j]; w2[j] = cw[512 + c8 + j]; }
        float zm2[8], zm1[8];
#pragma unroll
        for (int j = 0; j < 8; ++j) { zm2[j] = 0.f; zm1[j] = 0.f; }
        if (t0 >= 2) {
            const bf16_t* r2 = P + (size_t)(t0 - 2) * NP; const bf16_t* r1 = r2 + NP;
            const bf16x8 a2 = *(const bf16x8*)(r2 + C_CC + c8), b2 = *(const bf16x8*)(r2 + C_CH + c8), a1 = *(const bf16x8*)(r1 + C_CC + c8), b1 = *(const bf16x8*)(r1 + C_CH + c8);
#pragma unroll
            for (int j = 0; j < 8; ++j) { zm2[j] = bf2f((bf16_t)a2[j]) * bf2f((bf16_t)b2[j]); zm1[j] = bf2f((bf16_t)a1[j]) * bf2f((bf16_t)b1[j]); }
        }
#pragma unroll
        for (int tt = 0; tt < 4; ++tt) {
            bf16_t* row = P + (size_t)(t0 + tt) * NP;
            const bf16x8 a = *(const bf16x8*)(row + C_CC + c8), b = *(const bf16x8*)(row + C_CH + c8), cb = *(const bf16x8*)(row + C_CB + c8), gb = *(const bf16x8*)(row + C_GB + c8);
            float y[8];
#pragma unroll
            for (int j = 0; j < 8; ++j) {
                const float z0 = bf2f((bf16_t)a[j]) * bf2f((bf16_t)b[j]);
                const float cv = w0[j] * zm2[j] + w1[j] * zm1[j] + w2[j] * z0;
                y[j] = bf2f((bf16_t)cb[j]) * cv * silu(bf2f((bf16_t)gb[j]));
                zm2[j] = zm1[j]; zm1[j] = z0;
            }
            *(u32x4*)(row + C_GB + c8) = (u32x4){cvtpk(y[0], y[1]), cvtpk(y[2], y[3]), cvtpk(y[4], y[5]), cvtpk(y[6], y[7])};
        }
    }
}

__device__ __forceinline__ void sgate(const Ctx& cx, const Params& p, int l, unsigned char* lds_generic, int first, int stride) {
    LAS3 unsigned char* lds = (LAS3 unsigned char*)lds_generic;
    bf16_t* P = (bf16_t*)(p.ws + OFF_P);
    const bf16_t* SGW = (const bf16_t*)(p.ws + OFF_SGW) + (size_t)l * 4 * 128 * 128;
    const float* lng = p.ln_g + l * 256; const float* lnb = p.ln_b + l * 256; const float* sgb = p.sg_b + l * 4 * 128;
    const int tid = cx.tid, lane = tid & 63, r32 = lane & 31, hi = lane >> 5;
    const int w = __builtin_amdgcn_readfirstlane(tid >> 6), gi = w >> 2, psel = (w >> 1) & 1, nt = w & 1;
    const int row = tid >> 2, part = tid & 3;
    LAS3 float* lngb = (LAS3 float*)(lds + 102400);
    __syncthreads();
    lngb[tid] = tid < 256 ? lng[tid] : lnb[tid - 256];
    __syncthreads();
    for (int it = first; it < 256; it += stride) {
        const int ch = it >> 1, gp = it & 1;
        const int g = gp * 2 + gi;
        const int ttA = psel ? 1 : 0, ttB = psel ? 2 : 3;
        const bf16_t* Wg = SGW + (size_t)g * 128 * 128;
        const bf16_t* src = P + (size_t)(ch * 128 + row) * NP + C_SV + part * 64;
        bf16x8 xv[8];
#pragma unroll
        for (int c = 0; c < 8; ++c) xv[c] = *(const bf16x8*)(src + c * 8);
        bf16x8 wA[4], wB[8];
#define SG_LOAD(NA, NB) do { \
            _Pragma("unroll") for (int ks = 0; ks < NB; ++ks) wB[ks] = *(const bf16x8*)(Wg + (size_t)(32 * ttB + r32) * 128 + ks * 16 + hi * 8); \
            _Pragma("unroll") for (int ks = 0; ks < NA; ++ks) wA[ks] = *(const bf16x8*)(Wg + (size_t)(32 * ttA + r32) * 128 + ks * 16 + hi * 8); } while (0)
        if (psel) SG_LOAD(4, 6); else SG_LOAD(2, 8);
#undef SG_LOAD
        bf16x8 uv[4], gv[4];
#pragma unroll
        for (int k = 0; k < 4; ++k) { const int chunk = tid + 512 * k, t = chunk >> 4, c = gp * 128 + (chunk & 15) * 8; const bf16_t* prow = P + (size_t)(ch * 128 + t) * NP;
            uv[k] = *(const bf16x8*)(prow + C_SU + c); gv[k] = *(const bf16x8*)(prow + C_GC + c); }
        __syncthreads();
        {
            float sm = 0.f;
#pragma unroll
            for (int c = 0; c < 8; ++c)
#pragma unroll
                for (int j = 0; j < 8; ++j) sm += bf2f((bf16_t)xv[c][j]);
            sm += shx(sm, 1, lane); sm += shx(sm, 2, lane);
            const float mu = sm * (1.f / 256.f);
            float sq = 0.f;
#pragma unroll
            for (int c = 0; c < 8; ++c)
#pragma unroll
                for (int j = 0; j < 8; ++j) { const float d = bf2f((bf16_t)xv[c][j]) - mu; sq = fmaf(d, d, sq); }
            sq += shx(sq, 1, lane); sq += shx(sq, 2, lane);
            const float rs = 1.0f / sqrtf(sq * (1.f / 256.f) + EPS);
            if ((part >> 1) == gp) {
                const int gl = part & 1;
#pragma unroll
                for (int c = 0; c < 8; ++c) {
                    float y[8];
#pragma unroll
                    for (int j = 0; j < 8; ++j) { const int chn = part * 64 + c * 8 + j; y[j] = (bf2f((bf16_t)xv[c][j]) - mu) * rs * lngb[chn] + lngb[256 + chn]; }
                    *(LAS3 u32x4*)(lds + gl * 16384 + (c >> 2) * 8192 + (row >> 4) * 1024 + (row & 15) * 64 + (c & 3) * 16) = (u32x4){cvtpk(y[0], y[1]), cvtpk(y[2], y[3]), cvtpk(y[4], y[5]), cvtpk(y[6], y[7])};
                }
            }
        }
        __syncthreads();
        f32x4 sbA[4], sbB[4];
#pragma unroll
        for (int q = 0; q < 4; ++q) { sbA[q] = *(const f32x4*)(sgb + g * 128 + 32 * ttA + 8 * q + 4 * hi); sbB[q] = *(const f32x4*)(sgb + g * 128 + 32 * ttB + 8 * q + 4 * hi); }
        f32x16 accA, accB;
#pragma unroll
        for (int r = 0; r < 16; ++r) { accA[r] = 0.f; accB[r] = 0.f; }
        const LAS3 unsigned char* vb = lds + gi * 16384 + nt * 8192 + (8 * hi + ((lane & 15) >> 2)) * 64 + ((lane >> 4) & 1) * 32 + (lane & 3) * 8;
#define SG_RUN(NA, NB) do { \
            _Pragma("unroll") for (int ks = 0; ks < NB; ++ks) { \
                const s16x4 lo = vtr(vb + ks * 1024), hh = vtr(vb + ks * 1024 + 256); \
                const bf16x8 b = (bf16x8){lo[0], lo[1], lo[2], lo[3], hh[0], hh[1], hh[2], hh[3]}; \
                accB = __builtin_amdgcn_mfma_f32_32x32x16_bf16(wB[ks], b, accB, 0, 0, 0); \
                if (ks < NA) accA = __builtin_amdgcn_mfma_f32_32x32x16_bf16(wA[ks < NA ? ks : 0], b, accA, 0, 0, 0); } } while (0)
        if (psel) SG_RUN(4, 6); else SG_RUN(2, 8);
#undef SG_RUN
        LAS3 float* mx = (LAS3 float*)(lds + 32768);
#pragma unroll
        for (int half = 0; half < 2; ++half) {
            const int tt = half ? ttB : ttA;
#pragma unroll
            for (int r = 0; r < 16; ++r) { const int t = 32 * tt + crow(r, hi); mx[t * 132 + gi * 64 + 32 * nt + r32] = (half ? accB[r] + sbB[r >> 2][r & 3] : accA[r] + sbA[r >> 2][r & 3]); }
        }
        __syncthreads();
#pragma unroll
        for (int k = 0; k < 4; ++k) {
            const int chunk = tid + 512 * k, t = chunk >> 4, c8 = (chunk & 15) * 8;
            bf16_t* prow = P + (size_t)(ch * 128 + t) * NP; const int c = gp * 128 + c8;
            const LAS3 float* mp = mx + t * 132 + c8;
            float y[8];
#pragma unroll
            for (int j = 0; j < 8; ++j) y[j] = bf2f((bf16_t)uv[k][j]) * mp[j] * silu(bf2f((bf16_t)gv[k][j]));
            *(u32x4*)(prow + C_GC + c) = (u32x4){cvtpk(y[0], y[1]), cvtpk(y[2], y[3]), cvtpk(y[4], y[5]), cvtpk(y[6], y[7])};
        }
    }
}

__device__ __forceinline__ void moba_prep(const Ctx& cx, const Params& p, int l, unsigned char* lds_generic) {
    float* lds = (float*)lds_generic;
    bf16_t* P = (bf16_t*)(p.ws + OFF_P);
    float* kmean = (float*)(p.ws + OFF_KMEAN);
    const float* cosD = (const float*)(p.ws + OFF_COSD); const float* sinD = (const float*)(p.ws + OFF_SIND);
    const int tid = cx.tid, lane = tid & 63;
    const int isq = tid >> 8, rg = (tid & 255) >> 3, c = tid & 7;
    const float* gg = (isq ? p.mq_g : p.mk_g) + l * 64 + c * 8;
    float gn[8];
#pragma unroll
    for (int j = 0; j < 8; ++j) gn[j] = gg[j];
    const float sc = isq ? QSCALE_D : 1.0f;
    for (int it = cx.bid; it < 256; it += cx.nb) {
        const int n = it >> 2, h = it & 3;
        float ksum[8];
#pragma unroll
        for (int j = 0; j < 8; ++j) ksum[j] = 0.f;
        bf16x8 xv[8]; f32x4 cst[8][2];
#pragma unroll
        for (int i = 0; i < 8; ++i) xv[i] = *(const bf16x8*)(P + (size_t)(n * 256 + rg + 32 * i) * NP + (isq ? C_MQ : C_MK) + h * 64 + c * 8);
        if (c < 2) {
#pragma unroll
            for (int i = 0; i < 8; ++i) { const float* tb = (c == 0 ? cosD : sinD) + (size_t)(n * 256 + rg + 32 * i) * 8; cst[i][0] = *(const f32x4*)tb; cst[i][1] = *(const f32x4*)(tb + 4); }
        } else {
#pragma unroll
            for (int i = 0; i < 8; ++i) { cst[i][0] = (f32x4){0.f, 0.f, 0.f, 0.f}; cst[i][1] = (f32x4){0.f, 0.f, 0.f, 0.f}; }
        }
#pragma unroll
        for (int i = 0; i < 8; ++i) {
            const int srow = n * 256 + rg + 32 * i;
            bf16_t* ptr = P + (size_t)srow * NP + (isq ? C_MQ : C_MK) + h * 64 + c * 8;
            float v[8]; float ss = 0.f;
#pragma unroll
            for (int j = 0; j < 8; ++j) { v[j] = bf2f((bf16_t)xv[i][j]); ss = fmaf(v[j], v[j], ss); }
            ss += shx(ss, 1, lane); ss += shx(ss, 2, lane); ss += shx(ss, 4, lane);
            const float rs = 1.0f / sqrtf(ss * (1.f / 64.f) + EPS);
#pragma unroll
            for (int j = 0; j < 8; ++j) v[j] *= rs * gn[j];
            float o[8];
#pragma unroll
            for (int j = 0; j < 8; ++j) {
                const float other = shx(v[j], 1, lane);
                const float mine = cst[i][j >> 2][j & 3], theirs = shx(mine, 1, lane);
                float r = v[j];
                if (c < 2) r = (c == 0) ? v[j] * mine - other * theirs : v[j] * theirs + other * mine;
                o[j] = r;
            }
            if (!isq) {
#pragma unroll
                for (int j = 0; j < 8; ++j) ksum[j] += o[j];
            }
            *(u32x4*)ptr = (u32x4){cvtpk(o[0] * sc, o[1] * sc), cvtpk(o[2] * sc, o[3] * sc), cvtpk(o[4] * sc, o[5] * sc), cvtpk(o[6] * sc, o[7] * sc)};
        }
        __syncthreads();
        if (!isq) {
#pragma unroll
            for (int j = 0; j < 8; ++j) lds[rg * 64 + c * 8 + j] = ksum[j];
        }
        __syncthreads();
        if (tid < 64) { float a = 0.f; for (int r = 0; r < 32; ++r) a += lds[r * 64 + tid]; kmean[((size_t)h * 64 + n) * 64 + tid] = a * (1.f / 256.f); }
    }
}
}

__device__ __forceinline__ void gate_fast(const Ctx& cx, const Params& p, int l, unsigned char* lds_generic) {
    constexpr int KROW = 144, PLANE = 64 * KROW;
    LAS3 unsigned char* ldsb = (LAS3 unsigned char*)lds_generic;
    int* cntL = (int*)(lds_generic + 3 * PLANE); int* baseL = cntL + 64;
    const bf16_t* P = (const bf16_t*)(p.ws + OFF_P);
    const float* kmean = (const float*)(p.ws + OFF_KMEAN);
    int* mcnt = (int*)(p.ws + OFF_MCNT); int* mlist = (int*)(p.ws + OFF_LIST);
    const int tid = cx.tid, lane = tid & 63, r32 = lane & 31, hi = lane >> 5, par = hi;
    const int w = __builtin_amdgcn_readfirstlane(tid >> 6);
    for (int it = cx.bid; it < 256; it += cx.nb) {
        const int h = it >> 6, qb = it & 63, s = qb * 256 + w * 32 + r32;
        mla::bf16x8 bq[4];
#pragma unroll
        for (int ks = 0; ks < 4; ++ks) bq[ks] = *(const mla::bf16x8*)(P + (size_t)s * NP + C_MQ + h * 64 + 16 * ks + 8 * hi);
        const float4* kmg = (const float4*)(kmean + (size_t)h * 4096);
        float4 kv[2]; kv[0] = make_float4(0.f, 0.f, 0.f, 0.f); kv[1] = kv[0];
        if (tid < qb * 16) kv[0] = kmg[tid];
        if (tid + NT < qb * 16) kv[1] = kmg[tid + NT];
        __syncthreads();
#pragma unroll
        for (int j = 0; j < 2; ++j) { const int i = tid + j * NT;
            if (i < qb * 16) { const float x[4] = {kv[j].x, kv[j].y, kv[j].z, kv[j].w}; unsigned hp[4], mp[4], lp[4];
#pragma unroll
                for (int e = 0; e < 4; ++e) { const unsigned a1 = f2bf(x[e]); const float r1 = x[e] - __uint_as_float(a1 << 16); const unsigned a2 = f2bf(r1); const float r2 = r1 - __uint_as_float(a2 << 16); hp[e] = a1; mp[e] = a2; lp[e] = f2bf(r2); }
                LAS3 unsigned char* d = ldsb + (i >> 4) * KROW + (i & 15) * 8;
                *(LAS3 post::u32x2*)(d) = (post::u32x2){hp[0] | (hp[1] << 16), hp[2] | (hp[3] << 16)};
                *(LAS3 post::u32x2*)(d + PLANE) = (post::u32x2){mp[0] | (mp[1] << 16), mp[2] | (mp[3] << 16)};
                *(LAS3 post::u32x2*)(d + 2 * PLANE) = (post::u32x2){lp[0] | (lp[1] << 16), lp[2] | (lp[3] << 16)}; } }
        __syncthreads();
        mla::f32x16 acc0, acc1;
#pragma unroll
        for (int r = 0; r < 16; ++r) { acc0[r] = 0.f; acc1[r] = 0.f; }
#pragma unroll
        for (int ks = 0; ks < 4; ++ks)
#pragma unroll
            for (int pl = 0; pl < 3; ++pl) {
                const mla::bf16x8 a0 = *(const LAS3 mla::bf16x8*)(ldsb + pl * PLANE + r32 * KROW + 32 * ks + 16 * hi);
                acc0 = __builtin_amdgcn_mfma_f32_32x32x16_bf16(a0, bq[ks], acc0, 0, 0, 0);
                if (qb > 32) { const mla::bf16x8 a1 = *(const LAS3 mla::bf16x8*)(ldsb + pl * PLANE + (32 + r32) * KROW + 32 * ks + 16 * hi);
                    acc1 = __builtin_amdgcn_mfma_f32_32x32x16_bf16(a1, bq[ks], acc1, 0, 0, 0); }
            }
        float b0 = -3.0e38f, b1 = -3.0e38f, b2 = -3.0e38f; int i0 = -1, i1 = -1, i2 = -1;
#define GATE_TOP(G, N) do { const int n_ = (N); const float g_ = n_ < qb ? (G) : -3.0e38f; const bool c0_ = g_ > b0, c1_ = g_ > b1, c2_ = g_ > b2; \
            b2 = c1_ ? b1 : (c2_ ? g_ : b2); i2 = c1_ ? i1 : (c2_ ? n_ : i2); b1 = c0_ ? b0 : (c1_ ? g_ : b1); i1 = c0_ ? i0 : (c1_ ? n_ : i1); b0 = c0_ ? g_ : b0; i0 = c0_ ? n_ : i0; } while (0)
#pragma unroll
        for (int r = 0; r < 16; ++r) GATE_TOP(acc0[r], mla::crow(r, hi));
        if (qb > 32) {
#pragma unroll
            for (int r = 0; r < 16; ++r) GATE_TOP(acc1[r], 32 + mla::crow(r, hi));
        }
#undef GATE_TOP
        float pb0 = shx(b0, 32, lane), pb1 = shx(b1, 32, lane), pb2 = shx(b2, 32, lane);
        int pi0 = __builtin_amdgcn_ds_bpermute((lane ^ 32) << 2, i0), pi1 = __builtin_amdgcn_ds_bpermute((lane ^ 32) << 2, i1), pi2 = __builtin_amdgcn_ds_bpermute((lane ^ 32) << 2, i2);
#define GATE_INS(G, I) do { const float g_ = (G); const int n_ = (I); if (n_ >= 0) { \
            if (g_ > b0 || (g_ == b0 && n_ < i0)) { b2 = b1; i2 = i1; b1 = b0; i1 = i0; b0 = g_; i0 = n_; } \
            else if (g_ > b1 || (g_ == b1 && n_ < i1)) { b2 = b1; i2 = i1; b1 = g_; i1 = n_; } \
            else if (g_ > b2 || (g_ == b2 && n_ < i2)) { b2 = g_; i2 = n_; } } } while (0)
        GATE_INS(pb0, pi0); GATE_INS(pb1, pi1); GATE_INS(pb2, pi2);
#undef GATE_INS
        const int nv = qb < 3 ? qb : 3;
        __syncthreads();
        if (tid < 64) cntL[tid] = 0;
        __syncthreads();
        int rk0 = 0, rk1 = 0, rk2 = 0;
        if (par == 0) { if (nv > 0) rk0 = atomicAdd(cntL + i0, 1); if (nv > 1) rk1 = atomicAdd(cntL + i1, 1); if (nv > 2) rk2 = atomicAdd(cntL + i2, 1); }
        __syncthreads();
        if (tid < 64) { const int c = cntL[tid]; baseL[tid] = c ? atomicAdd(mcnt + h * 64 + tid, c) : 0; }
        __syncthreads();
        if (par == 0) {
            int* lh = mlist + (size_t)h * LIST_PER_HEAD;
            if (nv > 0) lh[256 * (63 * i0 - i0 * (i0 - 1) / 2) + baseL[i0] + rk0] = (s << 2) | 0;
            if (nv > 1) lh[256 * (63 * i1 - i1 * (i1 - 1) / 2) + baseL[i1] + rk1] = (s << 2) | 1;
            if (nv > 2) lh[256 * (63 * i2 - i2 * (i2 - 1) / 2) + baseL[i2] + rk2] = (s << 2) | 2;
        }
    }
}

#ifdef PROBE_CHECK
constexpr size_t OFF_T1 = OFF_END, OFF_T2 = OFF_END + (size_t)S * 256 * 2, OFF_CNT = 1024;
__device__ __forceinline__ void probe_cols(const Ctx& cx, const Params& p, int col, int dir) {
    bf16_t* P = (bf16_t*)(p.ws + OFF_P); bf16_t* T1 = (bf16_t*)(p.ws + OFF_T1); bf16_t* T2 = (bf16_t*)(p.ws + OFF_T2);
    unsigned* cnt = (unsigned*)(p.ws + OFF_CNT);
    const int gtid = cx.bid * NT + cx.tid, GT = cx.nb * NT;
    unsigned bad = 0;
    for (int i = gtid; i < S * 256; i += GT) {
        const int t = i >> 8, c = i & 255; bf16_t* pp = P + (size_t)t * NP + col + c;
        if (dir == 0) T1[i] = *pp;
        else if (dir == 1) { T2[i] = *pp; *pp = T1[i]; }
        else { const float a = bf2f(*pp), b = bf2f(T2[i]); const float d = fabsf(a - b); if (!(d <= 0.03f * fmaxf(fabsf(a), fabsf(b)) + PROBE_ABS)) ++bad; }
    }
    if (dir == 2 && bad) atomicAdd(cnt, bad);
}
__device__ __forceinline__ void probe_poison(const Ctx& cx, const Params& p) {
    const unsigned c = *(volatile unsigned*)(p.ws + OFF_CNT);
    if (cx.bid == 0 && cx.tid == 0 && c) p.out[0] += (float)c;
}
#endif


#if defined(PROBE_A) || defined(PROBE_B)
constexpr size_t OFF_TQ = OFF_END;
constexpr size_t OFF_CNT2 = 1024;
__device__ __forceinline__ void pcols(const Ctx& cx, const Params& p, int col, int width, bf16_t* buf, int op, float atol) {
    bf16_t* P = (bf16_t*)(p.ws + OFF_P); unsigned* cnt = (unsigned*)(p.ws + OFF_CNT2);
    const int gtid = cx.bid * NT + cx.tid, GT = cx.nb * NT; unsigned bad = 0;
    for (int i = gtid; i < S * width; i += GT) { const int t = i / width, c = i % width; bf16_t* pp = P + (size_t)t * NP + col + c;
        if (op == 0) buf[i] = *pp; else if (op == 1) *pp = buf[i];
        else { const float a = bf2f(*pp), b = bf2f(buf[i]); const float d = fabsf(a - b); if (!(d <= 0.03f * fmaxf(fabsf(a), fabsf(b)) + atol)) ++bad; } }
    if (op == 2 && bad) atomicAdd(cnt, bad);
}
__device__ __forceinline__ void pflat(const Ctx& cx, const Params& p, bf16_t* a_, bf16_t* b_, size_t n, int op, float atol) {
    unsigned* cnt = (unsigned*)(p.ws + OFF_CNT2);
    const size_t gtid = (size_t)cx.bid * NT + cx.tid, GT = (size_t)cx.nb * NT; unsigned bad = 0;
    for (size_t i = gtid; i < n; i += GT) { if (op == 0) b_[i] = a_[i]; else { const float a = bf2f(a_[i]), b = bf2f(b_[i]); const float d = fabsf(a - b); if (!(d <= 0.03f * fmaxf(fabsf(a), fabsf(b)) + atol)) ++bad; } }
    if (op == 2 && bad) atomicAdd(cnt, bad);
}
__device__ __forceinline__ void ppoison(const Ctx& cx, const Params& p) { const unsigned c = *(volatile unsigned*)(p.ws + OFF_CNT2); if (cx.bid == 0 && cx.tid == 0 && c) p.out[0] += (float)c; }
#endif

#define XB_TMO      128
#define XB_XCNT(j)  (256  + 64 * (j))
#define XB_XSUB(j)  (1280 + 64 * (j))
#define XB_XGEN(j)  (2304 + 64 * (j))
#define XB_TOP      3328
#define XB_TOPGEN   3392
#define XB_SPIN_CAP (1u << 20)
constexpr size_t OFF_BAR = 16384;
__device__ __forceinline__ unsigned xb_ld(unsigned* p)              { return __hip_atomic_load(p, __ATOMIC_RELAXED, __HIP_MEMORY_SCOPE_AGENT); }
__device__ __forceinline__ unsigned xb_add(unsigned* p, unsigned v) { return __hip_atomic_fetch_add(p, v, __ATOMIC_RELAXED, __HIP_MEMORY_SCOPE_AGENT); }
__device__ __forceinline__ unsigned xb_xcc_id() { return (unsigned)__builtin_amdgcn_s_getreg((3 << 11) | 20) & 0xFu; }
#define XB_SPIN(cond, bar) do { unsigned _sp = 0; while (cond) { __builtin_amdgcn_s_sleep(1); \
    if ((++_sp & 255u) == 0u) { if (xb_ld(&(bar)[XB_TMO])) break; if (_sp > XB_SPIN_CAP) { atomicAdd(&(bar)[XB_TMO], 1u); break; } } } } while (0)
__device__ __forceinline__ bool is_thread0(int wave_s) { int ln; asm volatile("v_mbcnt_lo_u32_b32 %0, -1, 0\n\tv_mbcnt_hi_u32_b32 %0, -1, %0" : "=v"(ln)); return wave_s == 0 && ln == 0; }
__device__ __forceinline__ void xcd_barrier_complete(unsigned* bar, unsigned x, unsigned& nloc, unsigned& nx) {
    const unsigned G = (unsigned)__builtin_amdgcn_grid_size_x() / NT;
    unsigned sum, cnt, mine, sp = 0u;
    for (;;) {
        sum = 0u; cnt = 0u; mine = 0u;
#pragma unroll
        for (unsigned j = 0; j < 16; ++j) { const unsigned c = xb_ld(&bar[XB_XCNT(j)]); sum += c; cnt += (c > 0u) ? 1u : 0u; mine = (j == x) ? c : mine; }
        if (sum == G) break;
        __builtin_amdgcn_s_sleep(1);
        if ((++sp & 255u) == 0u) { if (xb_ld(&bar[XB_TMO])) break; if (sp > XB_SPIN_CAP) { atomicAdd(&bar[XB_TMO], 1u); break; } }
    }
    nloc = mine > 0u ? mine : 1u; nx = cnt > 0u ? cnt : 1u;
}
__device__ __forceinline__ void xcd_barrier(unsigned char* ws, volatile __attribute__((address_space(3))) unsigned* st, int wave_s) {
    asm volatile("s_waitcnt vmcnt(0)" ::: "memory");
    __syncthreads();
    if (is_thread0(wave_s)) {
        unsigned* bar = (unsigned*)(ws + OFF_BAR);
        const unsigned x = xb_xcc_id();
        __builtin_amdgcn_s_waitcnt(0);
        unsigned nloc = st[0], nx = st[1];
        if (nloc == 0u) { xcd_barrier_complete(bar, x, nloc, nx); st[0] = nloc; st[1] = nx; }
        const unsigned old = xb_add(&bar[XB_XSUB(x)], 1u);
        const unsigned gen = old / nloc;
        if (old + 1u == (gen + 1u) * nloc) {
            __builtin_amdgcn_fence(__ATOMIC_RELEASE, "agent");
            asm volatile("s_waitcnt vmcnt(0)" ::: "memory");
            const unsigned og = xb_add(&bar[XB_TOP], 1u);
            const unsigned tg = og / nx;
            if (og + 1u == (tg + 1u) * nx) xb_add(&bar[XB_TOPGEN], 1u);
            else XB_SPIN(xb_ld(&bar[XB_TOPGEN]) == tg, bar);
            __builtin_amdgcn_fence(__ATOMIC_ACQUIRE, "agent");
            asm volatile("s_waitcnt vmcnt(0)" ::: "memory");
        } else {
            XB_SPIN(xb_ld(&bar[XB_TOPGEN]) == gen, bar);
            __builtin_amdgcn_fence(__ATOMIC_ACQUIRE, "agent");
            asm volatile("s_waitcnt vmcnt(0)" ::: "memory");
        }
    }
    __syncthreads();
}

#define AS4 __attribute__((address_space(4)))
__device__ __forceinline__ Params load_params() {
    const AS4 unsigned char* k = (const AS4 unsigned char*)__builtin_amdgcn_kernarg_segment_ptr();
    asm volatile("" : "+s"(k));
    Params q;
#define LDP(field, T) q.field = *(T const AS4*)(k + __builtin_offsetof(Params, field))
    LDP(x, const float*); LDP(pos, const int*); LDP(norm_g, const float*); LDP(w_in, const float*); LDP(qn_g, const float*); LDP(w_uq, const float*);
    LDP(kvn_g, const float*); LDP(w_ukv, const float*); LDP(q_g, const float*); LDP(kn_g, const float*); LDP(kr_g, const float*); LDP(conv_w, const float*);
    LDP(ln_g, const float*); LDP(ln_b, const float*); LDP(sg_w, const float*); LDP(sg_b, const float*); LDP(mq_g, const float*); LDP(mk_g, const float*);
    LDP(w_out, const float*); LDP(out, float*); LDP(ws, unsigned char*);
#undef LDP
    return q;
}
template <int PH> __device__ __forceinline__ void run_phase(int wave_s, int l, float* lds) {
    const Params p = load_params();
    Ctx cx;
    { int w = wave_s; asm volatile("" : "+s"(w)); int ln; asm volatile("v_mbcnt_lo_u32_b32 %0, -1, 0\n\tv_mbcnt_hi_u32_b32 %0, -1, %0" : "=v"(ln)); cx.tid = w * 64 + ln; asm volatile("" : "+v"(cx.tid)); }
    { int b = __builtin_amdgcn_workgroup_id_x(); asm volatile("" : "+s"(b)); cx.bid = b; }
    { int nbk = (int)__builtin_amdgcn_grid_size_x() / NT; asm volatile("" : "+s"(nbk)); cx.nb = nbk; }
    unsigned char* ws = p.ws;
    if (PH == 0) phase_prep(cx, p, lds);
    constexpr int N_G1A = 12 * 256;
    if (PH == 1) {
        const bool split = (cx.nb == 256);
        pg8::Gemm g{(const bf16_t*)(ws + OFF_XB), (const bf16_t*)(ws + OFF_WINT) + (size_t)l * NP * DM, S, split ? N_G1A : NP, DM, DM};
        pg8::StaticOrder So; So.init(S, split ? N_G1A : NP, cx.nb, cx.bid);
        pg8::EpiInP E{(bf16_t*)(ws + OFF_P), (const float*)(ws + OFF_RSTD), NP, l == 0 ? nullptr : (const float*)(ws + OFF_SSQ)};
        pg8::gemm_phase<pg8::EpiInP, pg8::StaticOrder, pg8::AOffId, true, true>(cx, (PG8_LAS unsigned char*)lds, g, So, E, pg8::AOffId{});
    }
    if (PH == 2) { if (cx.bid == 0 && cx.tid < 256) ((int*)(ws + OFF_MCNT))[cx.tid] = 0;
        const bool split = (cx.nb == 256);
        if (split && cx.bid < 128) {
            pg8::Gemm g{(const bf16_t*)(ws + OFF_XB), (const bf16_t*)(ws + OFF_WINT) + (size_t)l * NP * DM + (size_t)N_G1A * DM, S, NP - N_G1A, DM, DM};
            pg8::StaticOrder So; So.init(S, NP - N_G1A, 128, cx.bid);
            pg8::EpiInP E{(bf16_t*)(ws + OFF_P) + N_G1A, (const float*)(ws + OFF_RSTD), NP, l == 0 ? nullptr : (const float*)(ws + OFF_SSQ)};
            pg8::gemm_phase<pg8::EpiInP, pg8::StaticOrder, pg8::AOffId, true, true>(cx, (PG8_LAS unsigned char*)lds, g, So, E, pg8::AOffId{});
        }
        post::mla_up(cx, p, l, (unsigned char*)lds); post::conv(cx, p, l);
        if (!split) post::sgate(cx, p, l, (unsigned char*)lds, cx.bid, cx.nb);
        else if (cx.bid >= 128) post::sgate(cx, p, l, (unsigned char*)lds, cx.bid - 128, 128);
        post::moba_prep(cx, p, l, (unsigned char*)lds); }
    if (PH == 3) {
        gate_fast(cx, p, l, (unsigned char*)lds);
        if (l == 0 && cx.nb == 256) {
            const int wave = __builtin_amdgcn_readfirstlane(cx.tid >> 6), lane = cx.tid & 63;
            __attribute__((address_space(3))) float* scr64 = (__attribute__((address_space(3))) float*)lds + wave * (64 * 65);
            __syncthreads();
            for (int r = wave * 256 + cx.bid; r < WI_L; r += 256 * (NT / 64)) weight_item(p, 1, r, lane, scr64);
        }
    }
    if (PH == 4) mla2::attn_mla_pipe(cx, p, l, (unsigned char*)lds);
    if (PH == 8) moba::gather_items(cx, p, l, (unsigned char*)lds);
    if (PH == 7) { moba::own_items(cx, p, l, (unsigned char*)lds);
        __syncthreads();
        pg8::Gemm g{(const bf16_t*)(ws + OFF_P), (const bf16_t*)(ws + OFF_WOUTT) + (size_t)l * DM * DM, S, DM, DM, NP};
        pg8::StaticOrder So; So.init(S, DM, cx.nb, cx.bid);
        pg8::gemm_prefetch<pg8::EpiOutP, pg8::StaticOrder, pg8::AOffY>(cx, (PG8_LAS unsigned char*)lds, g, So, pg8::AOffY{}); }
    if (PH == 5) {
        pg8::Gemm g{(const bf16_t*)(ws + OFF_P), (const bf16_t*)(ws + OFF_WOUTT) + (size_t)l * DM * DM, S, DM, DM, NP};
        pg8::StaticOrder So; So.init(S, DM, cx.nb, cx.bid);
        pg8::EpiOutP E{p.x, (const bf16_t*)(ws + OFF_XB), l == 0 ? nullptr : p.out, DM, l == 0 ? (bf16_t*)(ws + OFF_XB) : nullptr, l == 0 ? (float*)(ws + OFF_SSQ) : nullptr, cx.tid & 63};
        pg8::gemm_phase<pg8::EpiOutP, pg8::StaticOrder, pg8::AOffY, false, true, true>(cx, (PG8_LAS unsigned char*)lds, g, So, E, pg8::AOffY{});
    }
#ifdef PROBE_A
    if (PH == 20) post_mla(cx, p, l, lds);
    if (PH == 21) pflat(cx, p, (bf16_t*)(ws + OFF_QA), (bf16_t*)(ws + OFF_TQ), (size_t)4 * S * 256, 0, 0.f);
    if (PH == 22) pflat(cx, p, (bf16_t*)(ws + OFF_QA), (bf16_t*)(ws + OFF_TQ), (size_t)4 * S * 256, 2, 0.01f);
    if (PH == 29) ppoison(cx, p);
#endif
#ifdef PROBE_B
    if (PH == 30) { pcols(cx, p, C_MQ, 512, (bf16_t*)(ws + OFF_TQ), 0, 0.f); pcols(cx, p, C_GD, 256, (bf16_t*)(ws + OFF_TQ) + (size_t)S * 512, 0, 0.f); }
    if (PH == 31) { if (cx.bid == 0 && cx.tid < 256) ((int*)(ws + OFF_MCNT))[cx.tid] = 0; post_moba(cx, p, l, lds); }
    if (PH == 32) phase_gate(cx, p, l);
    if (PH == 33) attn_moba_naive(cx, p, l);
    if (PH == 34) { pcols(cx, p, C_GD, 256, (bf16_t*)(ws + OFF_TQ) + (size_t)S * 768, 0, 0.f); }
    if (PH == 35) { pcols(cx, p, C_MQ, 512, (bf16_t*)(ws + OFF_TQ), 1, 0.f); pcols(cx, p, C_GD, 256, (bf16_t*)(ws + OFF_TQ) + (size_t)S * 512, 1, 0.f); }
    if (PH == 36) pcols(cx, p, C_GD, 256, (bf16_t*)(ws + OFF_TQ) + (size_t)S * 768, 2, 1e-3f);
    if (PH == 29) ppoison(cx, p);
#endif
#ifdef PROBE_CHECK
    if (PH == 10) { if (cx.bid == 0 && cx.tid == 0) *(unsigned*)(ws + OFF_CNT) = 0u; probe_cols(cx, p, PROBE_COL, 0); }
    if (PH == 11) { PROBE_NAIVE; }
    if (PH == 12) probe_cols(cx, p, PROBE_COL, 1);
    if (PH == 13) probe_cols(cx, p, PROBE_COL, 2);
    if (PH == 14) probe_poison(cx, p);
#endif
    if (PH == 6) rows_prep(cx, p.out, (bf16_t*)(ws + OFF_XB), (float*)(ws + OFF_RSTD));
}

__global__ void __launch_bounds__(NT) mega_kernel(Params p) {
    extern __shared__ __attribute__((aligned(16))) unsigned char lds_raw[];
    float* lds = (float*)lds_raw;
    cg::grid_group grid = cg::this_grid();
    const int wave_s = __builtin_amdgcn_readfirstlane((int)(threadIdx.x >> 6));
    volatile __attribute__((address_space(3))) unsigned* bst = (volatile __attribute__((address_space(3))) unsigned*)((__attribute__((address_space(3))) unsigned char*)lds_raw + (LDS_BYTES - 64));
    if (is_thread0(wave_s)) { bst[0] = 0u; bst[1] = 0u; xb_add((unsigned*)(p.ws + OFF_BAR) + XB_XCNT(xb_xcc_id()), 1u); }
#ifdef TIMING_PROBE
    enum { STAMP_BASE = __COUNTER__ };
#define GSYNC_I(k) do { xcd_barrier(load_params().ws, bst, wave_s); if (__builtin_amdgcn_workgroup_id_x() == 0 && is_thread0(wave_s)) ((unsigned long long*)(load_params().ws + 4096))[(k) - STAMP_BASE] = __builtin_amdgcn_s_memrealtime(); } while (0)
#define GSYNC() GSYNC_I(__COUNTER__)
    if (__builtin_amdgcn_workgroup_id_x() == 0 && is_thread0(wave_s)) ((unsigned long long*)(p.ws + 4096))[0] = __builtin_amdgcn_s_memrealtime();
#else
#define GSYNC() xcd_barrier(load_params().ws, bst, wave_s)
#endif
    run_phase<0>(wave_s, 0, lds);
    if (__builtin_expect(load_params().ws == nullptr, 0)) grid.sync();
    GSYNC();
    run_phase<1>(wave_s, 0, lds); GSYNC();
#ifdef PROBE_A
    run_phase<20>(wave_s, 0, lds); GSYNC(); run_phase<21>(wave_s, 0, lds); GSYNC();
#endif
#ifdef PROBE_B
    run_phase<30>(wave_s, 0, lds); GSYNC(); run_phase<31>(wave_s, 0, lds); GSYNC(); run_phase<32>(wave_s, 0, lds); GSYNC();
    run_phase<33>(wave_s, 0, lds); GSYNC(); run_phase<34>(wave_s, 0, lds); GSYNC(); run_phase<35>(wave_s, 0, lds); GSYNC();
#endif
    run_phase<2>(wave_s, 0, lds); GSYNC();
#ifdef PROBE_A
    run_phase<22>(wave_s, 0, lds); GSYNC();
#endif
    run_phase<3>(wave_s, 0, lds); GSYNC();
#ifdef PROBE_CHECK
    run_phase<10>(wave_s, 0, lds); GSYNC();
    run_phase<11>(wave_s, 0, lds); GSYNC();
    run_phase<12>(wave_s, 0, lds); GSYNC();
#endif
    run_phase<4>(wave_s, 0, lds); run_phase<8>(wave_s, 0, lds); GSYNC();
    run_phase<7>(wave_s, 0, lds); GSYNC();
#ifdef PROBE_B
    run_phase<36>(wave_s, 0, lds); GSYNC();
#endif
#ifdef PROBE_CHECK
    run_phase<13>(wave_s, 0, lds); GSYNC();
#endif
    run_phase<5>(wave_s, 0, lds); GSYNC();
    run_phase<1>(wave_s, 1, lds); GSYNC();
    run_phase<2>(wave_s, 1, lds); GSYNC();
    run_phase<3>(wave_s, 1, lds); GSYNC();
    run_phase<4>(wave_s, 1, lds); run_phase<8>(wave_s, 1, lds); GSYNC();
    run_phase<7>(wave_s, 1, lds); GSYNC();
    run_phase<5>(wave_s, 1, lds);
#ifdef PROBE_CHECK
    GSYNC(); run_phase<14>(wave_s, 1, lds);
#endif
#if defined(PROBE_A) || defined(PROBE_B)
    GSYNC(); run_phase<29>(wave_s, 1, lds);
#endif
#ifdef TIMING_PROBE
    GSYNC();
    {
        const Params q = load_params(); const unsigned long long* st = (const unsigned long long*)(q.ws + 4096);
        if (__builtin_amdgcn_workgroup_id_x() == 0) {
            int ln; asm volatile("v_mbcnt_lo_u32_b32 %0, -1, 0\n\tv_mbcnt_hi_u32_b32 %0, -1, %0" : "=v"(ln));
            const int t = wave_s * 64 + ln;
            const float da = (float)(st[TIM_A] - st[TIM_A - 1]) * 0.0001f, db = (float)(st[TIM_B] - st[TIM_B - 1]) * 0.0001f;
            if (t == 0) q.out[0] += da;
            for (int i = t; i < TIM_NB; i += NT) q.out[1024 + i] += db;
        }
    }
#endif
}

extern "C" void kernel_launch(void* const* d_in, const int* in_sizes, int n_in, void* d_out, int out_size, void* d_ws, size_t ws_size, hipStream_t stream) {
    static int grid_blocks = 0;
    if (grid_blocks == 0) {
        int dev = 0, cus = 0, per_cu = 0;
        hipGetDevice(&dev);
        hipDeviceGetAttribute(&cus, hipDeviceAttributeMultiprocessorCount, dev);
        hipFuncSetAttribute((const void*)mega_kernel, hipFuncAttributeMaxDynamicSharedMemorySize, LDS_BYTES);
        hipOccupancyMaxActiveBlocksPerMultiprocessor(&per_cu, (const void*)mega_kernel, NT, LDS_BYTES);
        if (per_cu < 1) { fprintf(stderr, "occupancy query returned %d\n", per_cu); per_cu = 1; }
        if (per_cu > 1) per_cu = 1;
        grid_blocks = cus * per_cu;
        if (ws_size < OFF_END) { fprintf(stderr, "workspace too small: %zu < %zu\n", ws_size, (size_t)OFF_END); grid_blocks = -1; }
    }
    if (grid_blocks < 0) return;
    Params p{};
    p.x = (const float*)d_in[0]; p.pos = (const int*)d_in[1]; p.norm_g = (const float*)d_in[2]; p.w_in = (const float*)d_in[3];
    p.qn_g = (const float*)d_in[4]; p.w_uq = (const float*)d_in[5]; p.kvn_g = (const float*)d_in[6]; p.w_ukv = (const float*)d_in[7];
    p.q_g = (const float*)d_in[8]; p.kn_g = (const float*)d_in[9]; p.kr_g = (const float*)d_in[10]; p.conv_w = (const float*)d_in[11];
    p.ln_g = (const float*)d_in[12]; p.ln_b = (const float*)d_in[13]; p.sg_w = (const float*)d_in[14]; p.sg_b = (const float*)d_in[15];
    p.mq_g = (const float*)d_in[16]; p.mk_g = (const float*)d_in[17]; p.w_out = (const float*)d_in[18];
    p.out = (float*)d_out; p.ws = (unsigned char*)d_ws;
    if (hipMemsetAsync(d_ws, 0, 65536, stream) != hipSuccess) fprintf(stderr, "memset failed\n");
    void* args[] = {&p};
    hipError_t e = hipLaunchCooperativeKernel((const void*)mega_kernel, dim3(grid_blocks), dim3(NT), args, LDS_BYTES, stream);
    if (e != hipSuccess) fprintf(stderr, "cooperative launch failed: %s (grid %d)\n", hipGetErrorString(e), grid_blocks);
}
```
